# Optimizing an MI355X kernel written in HIP

```python
import jax, jax.numpy as jnp
from jax import lax
import numpy as np

D_MODEL = 1024
BATCH = 8
SEQ = 2048
DEPTH = 1

N_MEM = 256
D_MIX = D_MODEL
HEAD_DIM = 64
RET_WIDTH = D_MIX // 2
RWKV_WIDTH = D_MIX - RET_WIDTH
RET_HEADS = RET_WIDTH // HEAD_DIM
RWKV_HEADS = RWKV_WIDTH // HEAD_DIM
RET_CHUNK = 128
ROPE_BASE = 10000.0
DECAY_LORA = 64
AAA_LORA = 64
GATE_LORA = 160
RET_PROJ = 4 * RET_WIDTH
RWKV_PROJ = 3 * RWKV_WIDTH + DECAY_LORA + AAA_LORA + GATE_LORA
D_IN_PROJ = RET_PROJ + RWKV_PROJ
XATTN_HEADS = 4
XATTN_HEAD_DIM = D_MODEL // XATTN_HEADS
D_FF = 4 * D_MODEL
RMS_EPS = 1e-6
GN_EPS_RET = 1e-5
GN_EPS_RWKV = 64e-5

kernel_name = "hybrid_retention_rwkv7_memxattn_block"


def rmsnorm(x, g):
    xf = x.astype(jnp.float32)
    y = xf * lax.rsqrt(jnp.mean(jnp.square(xf), axis=-1, keepdims=True) + RMS_EPS)
    return (y * g.astype(jnp.float32)).astype(x.dtype)


def head_group_norm(y, w, b, eps):
    B, S, H, d = y.shape
    yf = y.astype(jnp.float32)
    mu = jnp.mean(yf, axis=-1, keepdims=True)
    var = jnp.mean(jnp.square(yf - mu), axis=-1, keepdims=True)
    yn = ((yf - mu) * lax.rsqrt(var + eps)).reshape(B, S, H * d)
    return yn * w.astype(jnp.float32) + b.astype(jnp.float32)


def rope(x, positions):
    d = x.shape[-1]
    half = d // 2
    inv_freq = ROPE_BASE ** (-jnp.arange(half, dtype=jnp.float32) / half)
    ang = positions.astype(jnp.float32)[..., None] * inv_freq
    cos = jnp.cos(ang)[:, :, None, :]
    sin = jnp.sin(ang)[:, :, None, :]
    xf = x.astype(jnp.float32)
    x1, x2 = xf[..., :half], xf[..., half:]
    return jnp.concatenate([x1 * cos - x2 * sin, x2 * cos + x1 * sin], axis=-1)


def retention_chunkwise(q, k, v):
    B, S, H, d = q.shape
    C = RET_CHUNK
    N = S // C
    log_g = jnp.log(1.0 - 2.0 ** (-5.0 - jnp.arange(H, dtype=jnp.float32)))
    idx = jnp.arange(C, dtype=jnp.float32)
    diff = idx[:, None] - idx[None, :]
    causal = diff >= 0
    dmask = jnp.where(causal[None], jnp.exp(log_g[:, None, None] * jnp.where(causal, diff, 0.0)[None]), 0.0)
    xi = jnp.exp(log_g[:, None] * (idx + 1.0)[None])
    zeta = jnp.exp(log_g[:, None] * (C - 1.0 - idx)[None])
    g_chunk = jnp.exp(log_g * C)
    qc = q.reshape(B, N, C, H, d)
    kc = k.reshape(B, N, C, H, d)
    vc = v.reshape(B, N, C, H, d)
    s = jnp.einsum('bnihd,bnjhd->bnhij', qc, kc) * dmask[None, None]
    intra = jnp.einsum('bnhij,bnjhe->bnihe', s, vc)
    kv = jnp.einsum('bnjhd,hj,bnjhe->bnhde', kc, zeta, vc)

    def step(R, kv_n):
        return R * g_chunk[None, :, None, None] + kv_n, R

    _, R_prev = lax.scan(step, jnp.zeros((B, H, d, d), jnp.float32), jnp.moveaxis(kv, 1, 0))
    R_prev = jnp.moveaxis(R_prev, 0, 1)
    inter = jnp.einsum('bnihd,hi,bnhde->bnihe', qc, xi, R_prev)
    return (intra + inter).reshape(B, S, H, d)


def retention_mixer(p, positions, gn_w, gn_b):
    B, S, _ = p.shape
    q, k, v, g = jnp.split(p, 4, axis=-1)
    q = rope(q.reshape(B, S, RET_HEADS, HEAD_DIM), positions)
    k = rope(k.reshape(B, S, RET_HEADS, HEAD_DIM), positions) * (HEAD_DIM ** -0.5)
    v = v.reshape(B, S, RET_HEADS, HEAD_DIM).astype(jnp.float32)
    y = retention_chunkwise(q, k, v)
    return jax.nn.silu(g.astype(jnp.float32)) * head_group_norm(y, gn_w, gn_b, GN_EPS_RET)


def token_shift(p, mu):
    prev = jnp.pad(p, ((0, 0), (1, 0), (0, 0)))[:, :-1]
    return p + (prev - p) * mu


def wkv7_scan(r, w, k, v, a_vec, b_vec):
    B, S, H, d = r.shape

    def step(state, inp):
        r_t, w_t, k_t, v_t, a_t, b_t = inp
        sa = jnp.einsum('bhvk,bhk->bhv', state, a_t)
        state = (state * w_t[:, :, None, :] + sa[..., None] * b_t[:, :, None, :]
                 + v_t[..., None] * k_t[:, :, None, :])
        return state, jnp.einsum('bhvk,bhk->bhv', state, r_t)

    xs = (jnp.moveaxis(r, 1, 0), jnp.moveaxis(w, 1, 0), jnp.moveaxis(k, 1, 0),
          jnp.moveaxis(v, 1, 0), jnp.moveaxis(a_vec, 1, 0), jnp.moveaxis(b_vec, 1, 0))
    _, y = lax.scan(step, jnp.zeros((B, H, d, d), jnp.float32), xs)
    return jnp.moveaxis(y, 0, 1)


def rwkv7_mixer(p, mu, w0, w_up, a0, a_up, g_up, k_k, k_a, r_k, gn_w, gn_b):
    B, S, _ = p.shape
    H, d, W = RWKV_HEADS, HEAD_DIM, RWKV_WIDTH
    p = token_shift(p.astype(jnp.float32), mu.astype(jnp.float32))
    r, k, v, w_lr, a_lr, g_lr = jnp.split(
        p, [W, 2 * W, 3 * W, 3 * W + DECAY_LORA, 3 * W + DECAY_LORA + AAA_LORA], axis=-1)
    w_log = -jax.nn.softplus(-(w0 + jnp.tanh(w_lr) @ w_up)) - 0.5
    decay = jnp.exp(-jnp.exp(w_log))
    a = jax.nn.sigmoid(a0 + a_lr @ a_up)
    g = jax.nn.sigmoid(g_lr) @ g_up
    kk = (k * k_k).reshape(B, S, H, d)
    kk = kk / jnp.maximum(jnp.sqrt(jnp.sum(jnp.square(kk), axis=-1, keepdims=True)), 1e-12)
    k = k * (1.0 + (a - 1.0) * k_a)
    rh = r.reshape(B, S, H, d)
    kh = k.reshape(B, S, H, d)
    vh = v.reshape(B, S, H, d)
    ah = a.reshape(B, S, H, d)
    y = wkv7_scan(rh, decay.reshape(B, S, H, d), kh, vh, -kk, kk * ah)
    y = head_group_norm(y, gn_w, gn_b, GN_EPS_RWKV)
    bonus = jnp.sum(rh * kh * r_k.astype(jnp.float32), axis=-1, keepdims=True) * vh
    return (y + bonus.reshape(B, S, W)) * g


def memory_cross_attention(h, mem_n, w_q, w_kv, w_o):
    B, S, _ = h.shape
    M = mem_n.shape[1]
    q = (h @ w_q).reshape(B, S, XATTN_HEADS, XATTN_HEAD_DIM)
    k, v = jnp.split(mem_n @ w_kv, 2, axis=-1)
    k = k.reshape(B, M, XATTN_HEADS, XATTN_HEAD_DIM)
    v = v.reshape(B, M, XATTN_HEADS, XATTN_HEAD_DIM)
    s = jnp.einsum('bshd,bmhd->bhsm', q.astype(jnp.float32), k.astype(jnp.float32)) * (XATTN_HEAD_DIM ** -0.5)
    prob = jax.nn.softmax(s, axis=-1).astype(v.dtype)
    o = jnp.einsum('bhsm,bmhd->bshd', prob, v).reshape(B, S, D_MODEL)
    return o @ w_o


def setup_inputs(seed: int = 0) -> dict:
    key = jax.random.key(seed)
    ks = jax.random.split(key, 32)
    f32 = jnp.float32
    L = DEPTH

    def nrm(k, shape, scale):
        return jax.random.normal(k, shape, f32) * scale

    def gain(k, shape):
        return 1.0 + 0.05 * jax.random.normal(k, shape, f32)

    x = jax.random.normal(ks[0], (BATCH, SEQ, D_MODEL), f32)
    mem = jax.random.normal(ks[1], (BATCH, N_MEM, D_MODEL), f32)
    positions = jnp.broadcast_to(jnp.arange(SEQ, dtype=jnp.int32)[None], (BATCH, SEQ))
    return {
        "x": x,
        "mem": mem,
        "positions": positions,
        "norm_mix": gain(ks[2], (L, D_MODEL)),
        "w_in": nrm(ks[3], (L, D_MODEL, D_IN_PROJ), D_MODEL ** -0.5),
        "ret_gn_w": gain(ks[4], (L, RET_WIDTH)),
        "ret_gn_b": nrm(ks[5], (L, RET_WIDTH), 0.02),
        "rwkv_mu": jax.random.uniform(ks[6], (L, RWKV_PROJ), f32),
        "rwkv_w0": jax.random.uniform(ks[7], (L, RWKV_WIDTH), f32, -6.5, -1.5),
        "rwkv_w_up": nrm(ks[8], (L, DECAY_LORA, RWKV_WIDTH), 0.1 * DECAY_LORA ** -0.5),
        "rwkv_a0": nrm(ks[9], (L, RWKV_WIDTH), 0.1),
        "rwkv_a_up": nrm(ks[10], (L, AAA_LORA, RWKV_WIDTH), 0.1 * AAA_LORA ** -0.5),
        "rwkv_g_up": nrm(ks[11], (L, GATE_LORA, RWKV_WIDTH), GATE_LORA ** -0.5),
        "rwkv_k_k": 0.85 + 0.05 * jax.random.normal(ks[12], (L, RWKV_WIDTH), f32),
        "rwkv_k_a": gain(ks[13], (L, RWKV_WIDTH)),
        "rwkv_r_k": nrm(ks[14], (L, RWKV_HEADS, HEAD_DIM), 0.1),
        "rwkv_gn_w": gain(ks[15], (L, RWKV_WIDTH)),
        "rwkv_gn_b": nrm(ks[16], (L, RWKV_WIDTH), 0.02),
        "w_out": nrm(ks[17], (L, D_MIX, D_MODEL), D_MIX ** -0.5),
        "norm_xattn": gain(ks[18], (L, D_MODEL)),
        "norm_mem": gain(ks[19], (L, D_MODEL)),
        "xattn_w_q": nrm(ks[20], (L, D_MODEL, D_MODEL), D_MODEL ** -0.5),
        "xattn_w_kv": nrm(ks[21], (L, D_MODEL, 2 * D_MODEL), D_MODEL ** -0.5),
        "xattn_w_o": nrm(ks[22], (L, D_MODEL, D_MODEL), D_MODEL ** -0.5),
        "norm_mlp": gain(ks[23], (L, D_MODEL)),
        "mlp_w_up": nrm(ks[24], (L, D_MODEL, D_FF), D_MODEL ** -0.5),
        "mlp_w_down": nrm(ks[25], (L, D_FF, D_MODEL), D_FF ** -0.5),
        "norm_final": gain(ks[26], (D_MODEL,)),
    }


def reference(x, mem, positions, norm_mix, w_in, ret_gn_w, ret_gn_b, rwkv_mu, rwkv_w0,
              rwkv_w_up, rwkv_a0, rwkv_a_up, rwkv_g_up, rwkv_k_k, rwkv_k_a, rwkv_r_k,
              rwkv_gn_w, rwkv_gn_b, w_out, norm_xattn, norm_mem, xattn_w_q, xattn_w_kv,
              xattn_w_o, norm_mlp, mlp_w_up, mlp_w_down, norm_final):
    dt = x.dtype
    for l in range(DEPTH):
        h = rmsnorm(x, norm_mix[l])
        p = h @ w_in[l]
        y_ret = retention_mixer(p[..., :RET_PROJ], positions, ret_gn_w[l], ret_gn_b[l])
        y_rwkv = rwkv7_mixer(p[..., RET_PROJ:], rwkv_mu[l], rwkv_w0[l], rwkv_w_up[l], rwkv_a0[l],
                             rwkv_a_up[l], rwkv_g_up[l], rwkv_k_k[l], rwkv_k_a[l], rwkv_r_k[l],
                             rwkv_gn_w[l], rwkv_gn_b[l])
        y = jnp.concatenate([y_ret, y_rwkv], axis=-1).astype(dt)
        x = x + y @ w_out[l]
        x = x + memory_cross_attention(rmsnorm(x, norm_xattn[l]), rmsnorm(mem, norm_mem[l]),
                                       xattn_w_q[l], xattn_w_kv[l], xattn_w_o[l])
        h = rmsnorm(x, norm_mlp[l])
        x = x + jnp.square(jax.nn.relu(h @ mlp_w_up[l])) @ mlp_w_down[l]
    return rmsnorm(x, norm_final)
```

```cpp
#include <hip/hip_runtime.h>
#include <hip/hip_cooperative_groups.h>
#include <cstdio>
#include <cstdint>
namespace cg = cooperative_groups;
#define REPMASK 0
#define NSYNC_EXTRA 0
#define REP_SCAN 1
#define REP_RET 1

#define LAS __attribute__((address_space(3)))
typedef unsigned short bf16_t;
typedef short bf16x8 __attribute__((ext_vector_type(8)));
typedef float f32x4 __attribute__((ext_vector_type(4)));
typedef float f32x2 __attribute__((ext_vector_type(2)));
typedef unsigned u32x4 __attribute__((ext_vector_type(4)));
typedef unsigned u32x2 __attribute__((ext_vector_type(2)));

typedef __bf16 bf16x2_t __attribute__((ext_vector_type(2)));
__device__ __forceinline__ unsigned cvt_pk_bf16(float lo, float hi) { f32x2 v = {lo, hi}; bf16x2_t b = __builtin_convertvector(v, bf16x2_t); return __builtin_bit_cast(unsigned, b); }
__device__ __forceinline__ float bf2f(unsigned short b) { return __uint_as_float(((unsigned)b) << 16); }
__device__ __forceinline__ float bflo(unsigned w) { return __uint_as_float(w << 16); }
__device__ __forceinline__ float bfhi(unsigned w) { return __uint_as_float(w & 0xffff0000u); }
__device__ __forceinline__ float sigmoidf_(float x) { return __builtin_amdgcn_rcpf(1.0f + __expf(-x)); }
__device__ __forceinline__ float wave_sum(float v) {
#pragma unroll
    for (int o = 1; o < 64; o <<= 1) v += __shfl_xor(v, o);
    return v;
}

namespace pg8 {
constexpr int BM = 256, BK = 64, HALF = 128, HTB = HALF * BK * 2, STAGE_BYTES = 8 * HTB, NXCD = 8, WGM = 8;
__host__ __device__ __forceinline__ int lds_byte(int r, int c) { const int st = (r >> 4) * 2 + (c >> 5), rr = r & 15, cc = c & 31, ob = rr * 64 + cc * 2; return st * 1024 + (ob ^ (((ob >> 9) & 1) << 5)); }
__host__ __device__ __forceinline__ void stage_rc(int b, int& R, int& C) { const int st = b / 1024, sb = b % 1024, swz = sb ^ (((sb >> 9) & 1) << 5); R = (st >> 1) * 16 + swz / 64; C = (st & 1) * 32 + (swz % 64) / 2; }
__host__ __device__ __forceinline__ int perm32(int rho) { const int n = rho >> 4, i = rho & 15; return 8 * (i >> 2) + 4 * n + (i & 3); }

struct Unit { int pm, pn; };
struct Gemm { const bf16_t* A; const bf16_t* Bt; int lda, ldb, K; };

struct StaticOrder {
    int nM, nN, nwg, G, c;
    __device__ void init(int M, int N, int G_, int c_) { nM = M / BM; nN = N / BM; nwg = nM * nN; G = G_; c = c_; }
    __device__ bool next(int i, Unit& u) const {
        const long L = (long)i * G + c; if (L >= nwg) return false;
        int wgid = (int)L; { const int q = nwg / NXCD, r = nwg % NXCD, xcd = wgid % NXCD, off = wgid / NXCD; wgid = (xcd < r ? xcd * (q + 1) : r * (q + 1) + (xcd - r) * q) + off; }
        const int nig = WGM * nN, gid = wgid / nig, fm = gid * WGM, gsz = (nM - fm) < WGM ? (nM - fm) : WGM;
        u.pm = fm + ((wgid % nig) % gsz); u.pn = (wgid % nig) / gsz; return true;
    }
};
struct OneUnit {
    int pm, pn;
    __device__ bool next(int i, Unit& u) const { if (i) return false; u.pm = pm; u.pn = pn; return true; }
};


template <int ACT, bool RS> struct EpiStore {
    static constexpr bool PERM = true, AFTER_DRAIN = false;
    bf16_t* O; int ldc; int om, on; const float* sq; float cs;
    __device__ __forceinline__ void operator()(const f32x4 (&acc)[2][2][4][2], const Unit& u, int wr, int wc, int fr, int fq) const {
        int rl0 = wr * 64 + fr, cl0 = wc * 32 + 8 * fq; asm volatile("" : "+v"(rl0), "+v"(cl0));
        bf16_t* base = O + (size_t)(om * u.pm * BM) * ldc + on * u.pn * BM + cl0;
#pragma unroll
        for (int ai = 0; ai < 2; ++ai)
#pragma unroll
            for (int m = 0; m < 4; ++m) {
                const int rl = rl0 + ai * HALF + m * 16;
                float sc = cs;
                if (RS) { const f32x4* q4 = (const f32x4*)(sq + (size_t)(u.pm * BM + rl) * 16); f32x4 s = q4[0] + q4[1] + q4[2] + q4[3];
                    sc *= __builtin_amdgcn_rsqf((s[0] + s[1] + s[2] + s[3]) * (1.0f / 1024.0f) + 1e-6f); }
                bf16_t* rowp = base + (size_t)rl * ldc;
#pragma unroll
                for (int bj = 0; bj < 2; ++bj) { f32x4 v0 = acc[ai][bj][m][0] * sc, v1 = acc[ai][bj][m][1] * sc;
                    if (ACT == 2) {
#pragma unroll
                        for (int j = 0; j < 4; ++j) { float x = fmaxf(v0[j], 0.f); v0[j] = x * x; float y = fmaxf(v1[j], 0.f); v1[j] = y * y; } }
                    u32x4 w; w.x = cvt_pk_bf16(v0[0], v0[1]); w.y = cvt_pk_bf16(v0[2], v0[3]); w.z = cvt_pk_bf16(v1[0], v1[1]); w.w = cvt_pk_bf16(v1[2], v1[3]);
                    *(u32x4*)(rowp + bj * HALF) = w; } }
    }
};

struct EpiLora {
    static constexpr bool PERM = true, AFTER_DRAIN = false;
    float* LW; bf16_t* ASIG; bf16_t* GG; const float* w0; const float* a0;
    template <int SECT> __device__ __forceinline__ void run(const f32x4 (&acc)[2][2][4][2], int rl0, int c0) const {
        const float* cvec = SECT == 0 ? w0 : a0; bf16_t* ob = SECT == 1 ? ASIG : GG;
#pragma unroll
        for (int ai = 0; ai < 2; ++ai)
#pragma unroll
            for (int m = 0; m < 4; ++m) {
                const size_t row = (size_t)(rl0 + ai * HALF + m * 16);
#pragma unroll
                for (int bj = 0; bj < 2; ++bj) { const int c = c0 + bj * HALF; f32x4 v0 = acc[ai][bj][m][0], v1 = acc[ai][bj][m][1];
                    if (SECT < 2) { v0 += *(const f32x4*)(cvec + c); v1 += *(const f32x4*)(cvec + c + 4); }
                    if (SECT == 0) {
#pragma unroll
                        for (int j = 0; j < 4; ++j) { v0[j] = -0.60653065971f * sigmoidf_(v0[j]); v1[j] = -0.60653065971f * sigmoidf_(v1[j]); }
                        *(f32x4*)(LW + row * 512 + c) = v0; *(f32x4*)(LW + row * 512 + c + 4) = v1;
                    } else {
                        if (SECT == 1) {
#pragma unroll
                            for (int j = 0; j < 4; ++j) { v0[j] = sigmoidf_(v0[j]); v1[j] = sigmoidf_(v1[j]); } }
                        u32x4 w; w.x = cvt_pk_bf16(v0[0], v0[1]); w.y = cvt_pk_bf16(v0[2], v0[3]); w.z = cvt_pk_bf16(v1[0], v1[1]); w.w = cvt_pk_bf16(v1[2], v1[3]);
                        *(u32x4*)(ob + row * 512 + c) = w; } }
                asm volatile("" ::: "memory"); }
    }
    __device__ __forceinline__ void operator()(const f32x4 (&acc)[2][2][4][2], const Unit& u, int wr, int wc, int fr, int fq) const {
        int rl0 = u.pm * BM + wr * 64 + fr, c0 = (u.pn & 1) * BM + wc * 32 + 8 * fq; const int sect = u.pn >> 1; asm volatile("" : "+v"(rl0), "+v"(c0));
        if (sect == 0) run<0>(acc, rl0, c0); else if (sect == 1) run<1>(acc, rl0, c0); else run<2>(acc, rl0, c0);
    }
};

struct EpiRes {
    static constexpr bool PERM = true, AFTER_DRAIN = false;
    const float* base; float* out; bf16_t* xb; float* sq;
    __device__ __forceinline__ void operator()(const f32x4 (&acc)[2][2][4][2], const Unit& u, int wr, int wc, int fr, int fq) const {
        int rl0 = u.pm * BM + wr * 64 + fr, c0 = u.pn * BM + wc * 32 + 8 * fq; asm volatile("" : "+v"(rl0), "+v"(c0));
#pragma unroll
        for (int ai = 0; ai < 2; ++ai)
#pragma unroll
            for (int m = 0; m < 4; ++m) {
                const size_t row = (size_t)(rl0 + ai * HALF + m * 16); float ss = 0.f;
#pragma unroll
                for (int bj = 0; bj < 2; ++bj) { const size_t off = row * 1024 + c0 + bj * HALF;
                    const f32x4 b0 = *(const f32x4*)(base + off), b1 = *(const f32x4*)(base + off + 4);
                    const f32x4 o0 = b0 + acc[ai][bj][m][0], o1 = b1 + acc[ai][bj][m][1];
                    *(f32x4*)(out + off) = o0; *(f32x4*)(out + off + 4) = o1;
                    if (xb) { u32x4 w; w.x = cvt_pk_bf16(o0[0], o0[1]); w.y = cvt_pk_bf16(o0[2], o0[3]); w.z = cvt_pk_bf16(o1[0], o1[1]); w.w = cvt_pk_bf16(o1[2], o1[3]); *(u32x4*)(xb + off) = w; }
                    ss += (o0[0] * o0[0] + o0[1] * o0[1]) + (o0[2] * o0[2] + o0[3] * o0[3]) + (o1[0] * o1[0] + o1[1] * o1[1]) + (o1[2] * o1[2] + o1[3] * o1[3]); }
                ss += __shfl_xor(ss, 16); ss += __shfl_xor(ss, 32);
                if (fq == 0) sq[row * 16 + u.pn * 4 + wc] = ss;
                if (m & 1) asm volatile("" ::: "memory"); }
    }
};

struct EpiSoftmax {
    static constexpr bool PERM = true, AFTER_DRAIN = true;
    bf16_t* Pout;
    __device__ __forceinline__ void fused(f32x4 (&acc)[2][2][4][2], const Unit& u, int wr, int wc, int fr, int fq, LAS unsigned char* lds, int wid, int lane) const {
        LAS float* PM = (LAS float*)lds;
        LAS float* PS = (LAS float*)(lds + 4096);
        int rl0 = wr * 64 + fr; asm volatile("" : "+v"(rl0));
#pragma unroll
        for (int ai = 0; ai < 2; ++ai)
#pragma unroll
            for (int m = 0; m < 4; ++m) { float v = -3.0e38f;
#pragma unroll
                for (int bj = 0; bj < 2; ++bj)
#pragma unroll
                    for (int n = 0; n < 2; ++n) { const f32x4 x = acc[ai][bj][m][n]; v = fmaxf(v, fmaxf(fmaxf(x[0], x[1]), fmaxf(x[2], x[3]))); }
                v = fmaxf(v, __shfl_xor(v, 16)); v = fmaxf(v, __shfl_xor(v, 32));
                if (fq == 0) PM[(rl0 + ai * HALF + m * 16) * 4 + wc] = v; }
        asm volatile("s_waitcnt lgkmcnt(0)" ::: "memory"); __builtin_amdgcn_s_barrier(); asm volatile("" ::: "memory");
#pragma unroll
        for (int ai = 0; ai < 2; ++ai)
#pragma unroll
            for (int m = 0; m < 4; ++m) { const f32x4 p = *(const LAS f32x4*)(PM + (rl0 + ai * HALF + m * 16) * 4);
                const float rm = fmaxf(fmaxf(p[0], p[1]), fmaxf(p[2], p[3])) * 1.44269504089f; float s = 0.f;
#pragma unroll
                for (int bj = 0; bj < 2; ++bj)
#pragma unroll
                    for (int n = 0; n < 2; ++n) {
#pragma unroll
                        for (int j = 0; j < 4; ++j) { const float e = __builtin_amdgcn_exp2f(acc[ai][bj][m][n][j] * 1.44269504089f - rm); acc[ai][bj][m][n][j] = e; s += e; } }
                s += __shfl_xor(s, 16); s += __shfl_xor(s, 32);
                if (fq == 0) PS[(rl0 + ai * HALF + m * 16) * 4 + wc] = s; }
        asm volatile("s_waitcnt lgkmcnt(0)" ::: "memory"); __builtin_amdgcn_s_barrier(); asm volatile("" ::: "memory");
#pragma unroll
        for (int ai = 0; ai < 2; ++ai)
#pragma unroll
            for (int m = 0; m < 4; ++m) { const int rl = rl0 + ai * HALF + m * 16; const f32x4 p = *(const LAS f32x4*)(PS + rl * 4);
                const float inv = __builtin_amdgcn_rcpf((p[0] + p[1]) + (p[2] + p[3]));
#pragma unroll
                for (int bj = 0; bj < 2; ++bj) { const f32x4 v0 = acc[ai][bj][m][0] * inv, v1 = acc[ai][bj][m][1] * inv;
                    u32x4 w; w.x = cvt_pk_bf16(v0[0], v0[1]); w.y = cvt_pk_bf16(v0[2], v0[3]); w.z = cvt_pk_bf16(v1[0], v1[1]); w.w = cvt_pk_bf16(v1[2], v1[3]);
                    *(u32x4*)(Pout + (size_t)rl * 256 + wc * 32 + 8 * fq + bj * HALF) = w; } }
    }
};

template <class Epi, class Sched, bool ALIGN_EPI = false, bool SP2 = true>
__device__ __forceinline__ void gemm_phase(LAS unsigned char* lds, const Gemm g, const Sched& S, const Epi& E) {
    int tid = threadIdx.x; asm volatile("" : "+v"(tid));
    const int wid = __builtin_amdgcn_readfirstlane(tid >> 6), lane = tid & 63, wr = wid >> 2, wc = wid & 3, fr = lane & 15, fq = lane >> 4;
    const int K = g.K, nt = K / BK;
    unsigned voffA[2], voffB[2];
#pragma unroll
    for (int i = 0; i < 2; ++i) { int R, C; stage_rc(tid * 16 + i * 8192, R, C); const int Rb = Epi::PERM ? ((R & ~31) + perm32(R & 31)) : R;
        voffA[i] = (unsigned)(R * g.lda + C) * 2u; voffB[i] = (unsigned)(Rb * g.ldb + C) * 2u; }
    const size_t kstep = (size_t)(BK * 2);
    const size_t hstepA = (size_t)HALF * g.lda * 2, hstepB = (size_t)HALF * g.ldb * 2;
    const size_t tstepA = 2 * hstepA, tstepB = 2 * hstepB;
    const unsigned ldsw = (unsigned)wid * 1024u;
    const int aoff = lds_byte(wr * 64 + fr, fq * 8), boff = lds_byte(wc * 32 + fr, fq * 8);
#define PG8_SA(b, h) (((b) * 2 + (h)) * HTB)
#define PG8_SB(b, h) ((4 + (b) * 2 + (h)) * HTB)
#define PG8_STAGE(bufoff, gbase, voff) do { _Pragma("unroll") for (int _i = 0; _i < 2; ++_i) \
        __builtin_amdgcn_global_load_lds((const unsigned*)((const char*)(gbase) + (voff)[_i]), (LAS unsigned*)(lds + (bufoff) + ldsw + _i * 8192), 16, 0, 0); } while (0)
#define PG8_LDA(dst, b, h) do { _Pragma("unroll") for (int m = 0; m < 4; ++m) _Pragma("unroll") for (int k = 0; k < 2; ++k) dst[m][k] = *(const LAS bf16x8*)(lds + PG8_SA(b, h) + aoff + m * 2048 + k * 1024); } while (0)
#define PG8_LDB(dst, b, h) do { _Pragma("unroll") for (int n = 0; n < 2; ++n) _Pragma("unroll") for (int k = 0; k < 2; ++k) dst[n][k] = *(const LAS bf16x8*)(lds + PG8_SB(b, h) + boff + n * 2048 + k * 1024); } while (0)
#define PG8_MMA(ai, bj, At, Bt) do { __builtin_amdgcn_s_setprio(1); _Pragma("unroll") for (int m = 0; m < 4; ++m) _Pragma("unroll") for (int n = 0; n < 2; ++n) _Pragma("unroll") for (int k = 0; k < 2; ++k) \
        acc[ai][bj][m][n] = __builtin_amdgcn_mfma_f32_16x16x32_bf16(Bt[n][k], At[m][k], acc[ai][bj][m][n], 0, 0, 0); __builtin_amdgcn_s_setprio(0); } while (0)
#define PG8_WAIT_V(n) asm volatile("s_waitcnt vmcnt(" #n ")" ::: "memory")
#define PG8_WAIT_L(n) asm volatile("s_waitcnt lgkmcnt(" #n ")" ::: "memory")
#define PG8_BAR __builtin_amdgcn_s_barrier()
#define PG8_SCHED __builtin_amdgcn_sched_barrier(0)
    Unit cur, nxt; int ui = 0;
    if (!S.next(0, cur)) return;
    f32x4 acc[2][2][4][2];
#pragma unroll
    for (int a = 0; a < 2; ++a)
#pragma unroll
        for (int b = 0; b < 2; ++b)
#pragma unroll
            for (int m = 0; m < 4; ++m)
#pragma unroll
                for (int n = 0; n < 2; ++n) acc[a][b][m][n] = (f32x4){0.f, 0.f, 0.f, 0.f};
    bf16x8 At[4][2], B0[2][2], B1[2][2];
    const char* cA = (const char*)g.A + (size_t)cur.pm * tstepA; const char* cB = (const char*)g.Bt + (size_t)cur.pn * tstepB;
    static_assert(SP2, "only the two-super-phase loop is kept here");
    PG8_STAGE(PG8_SB(0, 0), cB, voffB); PG8_STAGE(PG8_SB(0, 1), cB + hstepB, voffB); PG8_STAGE(PG8_SA(0, 0), cA, voffA); PG8_STAGE(PG8_SA(0, 1), cA + hstepA, voffA);
    if (wr == 1) PG8_BAR;
    PG8_WAIT_V(2); PG8_BAR;
    PG8_STAGE(PG8_SB(1, 0), cB + kstep, voffB); PG8_STAGE(PG8_SA(1, 0), cA + kstep, voffA); PG8_STAGE(PG8_SB(1, 1), cB + hstepB + kstep, voffB);
    PG8_WAIT_V(6); PG8_BAR;
    for (;;) {
        const bool has_next = S.next(ui + 1, nxt);
        const char* nA = has_next ? (const char*)g.A + (size_t)nxt.pm * tstepA : cA; const char* nB = has_next ? (const char*)g.Bt + (size_t)nxt.pn * tstepB : cB;
        for (int t = 0; t < nt; t += 2) {
            const bool last = (t == nt - 2);
            const char* a1 = cA + (size_t)(t + 1) * kstep;
            const char* a2 = last ? nA : cA + (size_t)(t + 2) * kstep; const char* b2 = last ? nB : cB + (size_t)(t + 2) * kstep;
            const char* a3 = a2 + kstep; const char* b3 = b2 + kstep;
            PG8_LDB(B0, 0, 0); PG8_LDB(B1, 0, 1); PG8_SCHED; PG8_LDA(At, 0, 0); PG8_STAGE(PG8_SA(1, 1), a1 + hstepA, voffA);
            PG8_WAIT_V(8); PG8_WAIT_L(0); PG8_BAR; PG8_MMA(0, 0, At, B0); PG8_MMA(0, 1, At, B1); PG8_BAR; PG8_SCHED;
            PG8_LDA(At, 0, 1); PG8_STAGE(PG8_SB(0, 0), b2, voffB); PG8_STAGE(PG8_SB(0, 1), b2 + hstepB, voffB); PG8_STAGE(PG8_SA(0, 0), a2, voffA);
            PG8_WAIT_V(8); PG8_WAIT_L(0); PG8_BAR; PG8_MMA(1, 0, At, B0); PG8_MMA(1, 1, At, B1); PG8_BAR; PG8_SCHED;
            PG8_LDB(B0, 1, 0); PG8_LDB(B1, 1, 1); PG8_SCHED; PG8_LDA(At, 1, 0); PG8_STAGE(PG8_SA(0, 1), a2 + hstepA, voffA);
            PG8_WAIT_V(8); PG8_WAIT_L(0); PG8_BAR; PG8_MMA(0, 0, At, B0); PG8_MMA(0, 1, At, B1); PG8_BAR; PG8_SCHED;
            PG8_LDA(At, 1, 1); PG8_STAGE(PG8_SB(1, 0), b3, voffB); PG8_STAGE(PG8_SB(1, 1), b3 + hstepB, voffB); PG8_STAGE(PG8_SA(1, 0), a3, voffA);
            PG8_WAIT_V(8); PG8_WAIT_L(0); PG8_BAR; PG8_MMA(1, 0, At, B0); PG8_MMA(1, 1, At, B1); PG8_BAR; PG8_SCHED;
        }
        if constexpr (ALIGN_EPI) { if (wr == 0) PG8_BAR; }
        if constexpr (!Epi::AFTER_DRAIN) { E(acc, cur, wr, wc, fr, fq); }
        if (!has_next) break;
#pragma unroll
        for (int a = 0; a < 2; ++a)
#pragma unroll
            for (int b = 0; b < 2; ++b)
#pragma unroll
                for (int m = 0; m < 4; ++m)
#pragma unroll
                    for (int n = 0; n < 2; ++n) acc[a][b][m][n] = (f32x4){0.f, 0.f, 0.f, 0.f};
        cur = nxt; cA = nA; cB = nB; ++ui;
        if constexpr (ALIGN_EPI) { if (wr == 1) PG8_BAR; }
    }
    PG8_WAIT_V(0);
    if constexpr (!ALIGN_EPI) { if (wr == 0) PG8_BAR; }
    PG8_BAR;
    if constexpr (Epi::AFTER_DRAIN) { E.fused(acc, cur, wr, wc, fr, fq, lds, wid, lane); }
#undef PG8_SA
#undef PG8_SB
#undef PG8_STAGE
#undef PG8_LDA
#undef PG8_LDB
#undef PG8_MMA
#undef PG8_WAIT_V
#undef PG8_WAIT_L
#undef PG8_BAR
#undef PG8_SCHED
}
}

constexpr int BATCH = 8, SEQ = 2048, D = 1024, M = BATCH * SEQ, NMEM = 256, MM = BATCH * NMEM;
constexpr int NIN = 3872, NP = 4096, FF = 4096, LK = 384, LN = 1536;
constexpr int C_RK = 2048, C_LORA = 3584;
constexpr int NWAVES = 8, LDS_BYTES = 147456;
constexpr size_t MiB = 1u << 20;
constexpr size_t WS_WIN = 1 * MiB, WS_WOUT = 9 * MiB, WS_WQ = 11 * MiB, WS_WKV = 13 * MiB, WS_WO = 17 * MiB, WS_WUP = 19 * MiB, WS_WDN = 27 * MiB, WS_LORA = 35 * MiB;
constexpr size_t WS_MEMN = 37 * MiB, WS_KM = 41 * MiB, WS_VT = 45 * MiB, WS_ROPE = 49 * MiB, WS_SQ1 = 53 * MiB, WS_SQ2 = 54 * MiB, WS_SQ3 = 55 * MiB;
constexpr size_t WS_ACTA = 56 * MiB, WS_ACTB = 88 * MiB, WS_P = 120 * MiB, WS_END = 248 * MiB;
constexpr size_t DO_LW = 0, DO_ASIG = 32 * MiB, DO_GG = 48 * MiB;

struct Args { const void* in[28]; float* out; unsigned char* ws; int ph_lo, ph_hi; };
typedef const __attribute__((address_space(4))) unsigned long long* CArgs;
__device__ __forceinline__ Args load_args() { CArgs p = (CArgs)__builtin_amdgcn_kernarg_segment_ptr(); asm volatile("" : "+s"(p)); Args a;
#pragma unroll
    for (int i = 0; i < 28; ++i) a.in[i] = (const void*)(const __attribute__((address_space(1))) void*)p[i];
    a.out = (float*)(__attribute__((address_space(1))) float*)p[28]; a.ws = (unsigned char*)(__attribute__((address_space(1))) unsigned char*)p[29]; a.ph_lo = (int)p[30]; a.ph_hi = (int)(p[30] >> 32); return a; }
#define TIDS() int tid = threadIdx.x; asm volatile("" : "+v"(tid)); const int lane = tid & 63, wave = __builtin_amdgcn_readfirstlane(tid >> 6); (void)lane; (void)wave
enum { I_X = 0, I_MEM, I_POS, I_NMIX, I_WIN, I_RGNW, I_RGNB, I_MU, I_W0, I_WUP, I_A0, I_AUP, I_GUP, I_KK, I_KA, I_RK, I_WGNW, I_WGNB, I_WOUT, I_NXA, I_NMEM, I_WQ, I_WKV, I_WO, I_NMLP, I_MUP, I_MDN, I_NFIN };

__device__ __forceinline__ void p0_transpose_item(const float* W, int K, int N, const float* gain, bf16_t* WT, int row_off, LAS float* scr, int item, int lane) {
    const int nblk = N / 32, kb = item / nblk, nb = item % nblk, k0 = 64 * kb, n0 = 32 * nb;
#pragma unroll 8
    for (int i = 0; i < 32; ++i) { const int kk = 2 * i + (lane >> 5); float v = W[(size_t)(k0 + kk) * N + n0 + (lane & 31)]; if (gain) v *= gain[k0 + kk]; scr[kk * 33 + (lane & 31)] = v; }
    asm volatile("s_waitcnt lgkmcnt(0)" ::: "memory");
    const int c = lane & 7;
#pragma unroll
    for (int j = 0; j < 4; ++j) { const int n = (lane >> 3) + 8 * j; const LAS float* s = scr + (8 * c) * 33 + n;
        u32x4 o; o.x = cvt_pk_bf16(s[0 * 33], s[1 * 33]); o.y = cvt_pk_bf16(s[2 * 33], s[3 * 33]); o.z = cvt_pk_bf16(s[4 * 33], s[5 * 33]); o.w = cvt_pk_bf16(s[6 * 33], s[7 * 33]);
        *(u32x4*)(WT + (size_t)(row_off + n0 + n) * K + k0 + 8 * c) = o; }
    asm volatile("s_waitcnt lgkmcnt(0)" ::: "memory");
}
__device__ __forceinline__ void rms_row_to_bf16(const float* xrow, bf16_t* orow, int lane) {
    const f32x4* xr = (const f32x4*)xrow + lane;
    f32x4 v[4]; float s = 0.f;
#pragma unroll
    for (int j = 0; j < 4; ++j) { v[j] = xr[64 * j]; s += (v[j][0] * v[j][0] + v[j][1] * v[j][1]) + (v[j][2] * v[j][2] + v[j][3] * v[j][3]); }
    const float rstd = 1.0f / sqrtf(wave_sum(s) * (1.f / 1024.f) + 1e-6f);
    u32x2* o8 = (u32x2*)orow + lane;
#pragma unroll
    for (int j = 0; j < 4; ++j) { u32x2 w; w.x = cvt_pk_bf16(v[j][0] * rstd, v[j][1] * rstd); w.y = cvt_pk_bf16(v[j][2] * rstd, v[j][3] * rstd); o8[64 * j] = w; }
}

__device__ __forceinline__ void phase0(LAS unsigned char* lds) {
    const Args a = load_args(); TIDS();
    unsigned char* ws = a.ws;
    LAS float* scr = (LAS float*)(lds + wave * 16384);
    const int gw = blockIdx.x * NWAVES + wave, NGW = gridDim.x * NWAVES;
    const int gt = blockIdx.x * 512 + tid, NGT = gridDim.x * 512;
    constexpr int I_IN = 16 * 121, I_SQ = 16 * 32, I_KV = 16 * 64, I_UP = 16 * 128, I_DN = 64 * 32;
    constexpr int NITEMS = I_IN + 3 * I_SQ + I_KV + I_UP + I_DN;
    for (int it = gw; it < NITEMS; it += NGW) {
        int r = it;
        if (r < I_IN) { p0_transpose_item((const float*)a.in[I_WIN], D, NIN, (const float*)a.in[I_NMIX], (bf16_t*)(ws + WS_WIN), 0, scr, r, lane); continue; } r -= I_IN;
        if (r < I_UP) { p0_transpose_item((const float*)a.in[I_MUP], D, FF, (const float*)a.in[I_NMLP], (bf16_t*)(ws + WS_WUP), 0, scr, r, lane); continue; } r -= I_UP;
        if (r < I_DN) { p0_transpose_item((const float*)a.in[I_MDN], FF, D, nullptr, (bf16_t*)(ws + WS_WDN), 0, scr, r, lane); continue; } r -= I_DN;
        if (r < I_KV) { p0_transpose_item((const float*)a.in[I_WKV], D, 2 * D, (const float*)a.in[I_NMEM], (bf16_t*)(ws + WS_WKV), 0, scr, r, lane); continue; } r -= I_KV;
        if (r < I_SQ) { p0_transpose_item((const float*)a.in[I_WOUT], D, D, nullptr, (bf16_t*)(ws + WS_WOUT), 0, scr, r, lane); continue; } r -= I_SQ;
        if (r < I_SQ) { p0_transpose_item((const float*)a.in[I_WQ], D, D, (const float*)a.in[I_NXA], (bf16_t*)(ws + WS_WQ), 0, scr, r, lane); continue; } r -= I_SQ;
        p0_transpose_item((const float*)a.in[I_WO], D, D, nullptr, (bf16_t*)(ws + WS_WO), 0, scr, r, lane);
    }
    { u32x4* z = (u32x4*)(ws + WS_WIN + (size_t)NIN * D * 2); const int nz = (NP - NIN) * D * 2 / 16; for (int i = gt; i < nz; i += NGT) z[i] = (u32x4){0u, 0u, 0u, 0u}; }
    { const float* wup = (const float*)a.in[I_WUP]; const float* aup = (const float*)a.in[I_AUP]; const float* gup = (const float*)a.in[I_GUP]; u32x4* LT = (u32x4*)(ws + WS_LORA);
      for (int i = gt; i < LN * (LK / 8); i += NGT) { const int n = i / (LK / 8), k0 = (i % (LK / 8)) * 8; float v[8];
#pragma unroll
          for (int j = 0; j < 8; ++j) { const int k = k0 + j; float x = 0.f;
              if (n < 512) { if (k < 64) x = wup[k * 512 + n]; }
              else if (n < 1024) { if (k >= 64 && k < 128) x = aup[(k - 64) * 512 + (n - 512)]; }
              else { if (k >= 128 && k < 288) x = gup[(k - 128) * 512 + (n - 1024)]; }
              v[j] = x; }
          u32x4 o; o.x = cvt_pk_bf16(v[0], v[1]); o.y = cvt_pk_bf16(v[2], v[3]); o.z = cvt_pk_bf16(v[4], v[5]); o.w = cvt_pk_bf16(v[6], v[7]); LT[i] = o; } }
    for (int m = gw; m < M + MM; m += NGW) {
        if (m < M) rms_row_to_bf16((const float*)a.in[I_X] + (size_t)m * D, (bf16_t*)(ws + WS_ACTA) + (size_t)m * D, lane);
        else rms_row_to_bf16((const float*)a.in[I_MEM] + (size_t)(m - M) * D, (bf16_t*)(ws + WS_MEMN) + (size_t)(m - M) * D, lane);
    }
    { const int* pos = (const int*)a.in[I_POS]; f32x2* T = (f32x2*)(ws + WS_ROPE);
      for (int i = gt; i < M * 32; i += NGT) { const int m = i >> 5, f = i & 31;
          const float inv = (float)exp2(-(double)f * (13.287712379549449 / 32.0));
          const float ang = (float)pos[m] * inv;
          double rev = (double)ang * 0.15915494309189535; rev -= rint(rev);
          const float rv = (float)rev;
          T[i] = (f32x2){__builtin_amdgcn_cosf(rv), __builtin_amdgcn_sinf(rv)}; } }
}

__device__ __forceinline__ void phase_lora_in() {
    const Args a = load_args(); TIDS();
    const bf16_t* P = (const bf16_t*)(a.ws + WS_P); bf16_t* L = (bf16_t*)(a.ws + WS_ACTB); const float* mu = (const float*)a.in[I_MU] + 1536;
    const int gt = blockIdx.x * 512 + tid, NGT = gridDim.x * 512;
    for (int i = gt; i < M * (LK / 8); i += NGT) { const int m = i / (LK / 8), c8 = i % (LK / 8), c = 8 * c8; u32x4 o = (u32x4){0u, 0u, 0u, 0u};
        if (c < 288) { const u32x4 cur = *(const u32x4*)(P + (size_t)m * NP + C_LORA + c); u32x4 prv = (u32x4){0u, 0u, 0u, 0u}; if ((m & (SEQ - 1)) != 0) prv = *(const u32x4*)(P + (size_t)(m - 1) * NP + C_LORA + c);
            const f32x4 mu0 = *(const f32x4*)(mu + c), mu1 = *(const f32x4*)(mu + c + 4); float v[8];
#pragma unroll
            for (int j = 0; j < 4; ++j) { const float c0 = bflo(cur[j]), c1 = bfhi(cur[j]), p0 = bflo(prv[j]), p1 = bfhi(prv[j]); const float m0 = j < 2 ? mu0[2 * j] : mu1[2 * j - 4], m1 = j < 2 ? mu0[2 * j + 1] : mu1[2 * j - 3];
                v[2 * j] = c0 + (p0 - c0) * m0; v[2 * j + 1] = c1 + (p1 - c1) * m1; }
            if (c < 64) {
#pragma unroll
                for (int j = 0; j < 8; ++j) v[j] = tanhf(v[j]); }
            else if (c >= 128) {
#pragma unroll
                for (int j = 0; j < 8; ++j) v[j] = sigmoidf_(v[j]); }
            o.x = cvt_pk_bf16(v[0], v[1]); o.y = cvt_pk_bf16(v[2], v[3]); o.z = cvt_pk_bf16(v[4], v[5]); o.w = cvt_pk_bf16(v[6], v[7]); }
        *(u32x4*)(L + (size_t)m * LK + c) = o; }
}

typedef short bf16x4 __attribute__((ext_vector_type(4)));
template <int CTRL> __device__ __forceinline__ float dpp_add(float v) { return v + __builtin_bit_cast(float, __builtin_amdgcn_update_dpp(0, __builtin_bit_cast(int, v), CTRL, 0xf, 0xf, false)); }
__device__ __forceinline__ float red16(float v) { v = dpp_add<0xB1>(v); v = dpp_add<0x4E>(v); v = dpp_add<0x141>(v); v = dpp_add<0x140>(v); return v; }
__device__ __forceinline__ float wave_sum_fast(float v) { v = red16(v);
    const int iv = __builtin_bit_cast(int, v);
    return (__builtin_bit_cast(float, __builtin_amdgcn_readlane(iv, 0)) + __builtin_bit_cast(float, __builtin_amdgcn_readlane(iv, 16))) + (__builtin_bit_cast(float, __builtin_amdgcn_readlane(iv, 32)) + __builtin_bit_cast(float, __builtin_amdgcn_readlane(iv, 48))); }
__device__ __forceinline__ bf16x4 pack4(const f32x4 v) { u32x2 w; w.x = cvt_pk_bf16(v[0], v[1]); w.y = cvt_pk_bf16(v[2], v[3]); return __builtin_bit_cast(bf16x4, w); }
__device__ __forceinline__ bf16x8 pack8(const f32x4 a, const f32x4 b) { u32x4 w; w.x = cvt_pk_bf16(a[0], a[1]); w.y = cvt_pk_bf16(a[2], a[3]); w.z = cvt_pk_bf16(b[0], b[1]); w.w = cvt_pk_bf16(b[2], b[3]); return __builtin_bit_cast(bf16x8, w); }
__device__ __forceinline__ unsigned short f2bf(float v) { return (unsigned short)(cvt_pk_bf16(v, 0.f) & 0xffffu); }

__device__ __forceinline__ void rwkv_chunk_wg(LAS unsigned char* lds, int bh) {
    const Args a = load_args(); TIDS();
    const int b = bh >> 3, h = bh & 7;
    constexpr int RS = 144;
    constexpr int SLOT = 13120, O_AT = 0, O_RT = 2304, O_BHT = 4608, O_KHT = 6656, O_VT = 8704, O_CAK = 10752, O_TT = 11264, O_CBR = 11776, O_CKR = 12288, O_PL = 12800, O_RKB = 13056;
    constexpr int SCR0 = 8 * SLOT, SCR = 5632, O_BT = 0, O_KT = 2304, O_NF = 4608, O_RK = 0  ;
    constexpr int STAT0 = SCR0 + 4 * SCR;
    static_assert(STAT0 + 4096 <= 131072 + 512, "rwkv LDS map (the barrier set-up words sit at 131072 + 512)");
    constexpr int NCH = SEQ / 16, NST = NCH / 4;
    const size_t m0 = (size_t)b * SEQ;
    const int li = lane & 15, lq = lane >> 4;
    if (wave < 4) {
        const int rt = wave, vch = 64 * h + 16 * rt + li;
        const bf16_t* GG = (const bf16_t*)((const unsigned char*)a.out + DO_GG); bf16_t* Y = (bf16_t*)(a.ws + WS_ACTA);
        const float gw = ((const float*)a.in[I_WGNW])[vch], gb = ((const float*)a.in[I_WGNB])[vch];
        f32x4 S[4];
#pragma unroll
        for (int kt = 0; kt < 4; ++kt) S[kt] = (f32x4){0.f, 0.f, 0.f, 0.f};
        const f32x4 zero4 = (f32x4){0.f, 0.f, 0.f, 0.f};
        f32x4 ys[4], rkbs[4]; bf16x4 vts[4];
        for (int g = 0; g <= NST + 1; ++g) {
            if (g >= 2) {
#pragma unroll
                for (int q = 0; q < 4; ++q) { const int c = 4 * (g - 2) + q; const LAS float* st = (const LAS float*)(lds + STAT0 + ((g - 1) & 1) * 2048 + q * 512);
#pragma unroll
                    for (int r = 0; r < 4; ++r) { const int t = 4 * lq + r; const f32x4 p0 = *(const LAS f32x4*)(st + t * 8), p1 = *(const LAS f32x4*)(st + t * 8 + 4);
                        const float mean = ((p0[0] + p0[2]) + (p1[0] + p1[2])) * (1.f / 64.f), ex2 = ((p0[1] + p0[3]) + (p1[1] + p1[3])) * (1.f / 64.f);
                        const float rstd = __builtin_amdgcn_rsqf(fmaxf(ex2 - mean * mean, 0.f) + 64e-5f);
                        const float vv = bf2f((unsigned short)vts[q][r]);
                        const float o = ((ys[q][r] - mean) * rstd * gw + gb + rkbs[q][r] * vv) * bf2f(GG[(m0 + 16 * c + t) * 512 + vch]);
                        Y[(m0 + 16 * c + t) * D + 512 + vch] = f2bf(o); } }
            }
            if (g >= 1 && g <= NST) {
#pragma unroll
                for (int q = 0; q < 4; ++q) {
                    const int c = 4 * (g - 1) + q; LAS unsigned char* sl = lds + (((g - 1) & 1) * 4 + q) * SLOT;
                    const bf16x8 sf0 = pack8(S[0], S[1]), sf1 = pack8(S[2], S[3]);
                    const bf16x8 a0 = *(const LAS bf16x8*)(sl + O_AT + li * RS + 16 * lq), a1 = *(const LAS bf16x8*)(sl + O_AT + li * RS + 64 + 16 * lq);
                    const bf16x8 r0 = *(const LAS bf16x8*)(sl + O_RT + li * RS + 16 * lq), r1 = *(const LAS bf16x8*)(sl + O_RT + li * RS + 64 + 16 * lq);
                    const bf16x4 cak = *(const LAS bf16x4*)(sl + O_CAK + li * 32 + 8 * lq), tt = *(const LAS bf16x4*)(sl + O_TT + li * 32 + 8 * lq);
                    const bf16x4 cbr = *(const LAS bf16x4*)(sl + O_CBR + li * 32 + 8 * lq), ckr = *(const LAS bf16x4*)(sl + O_CKR + li * 32 + 8 * lq);
                    const bf16x4 vt = *(const LAS bf16x4*)(sl + O_VT + (16 * rt + li) * 32 + 8 * lq);
                    rkbs[q] = *(const LAS f32x4*)(sl + O_RKB + 16 * lq);
                    f32x4 z = __builtin_amdgcn_mfma_f32_16x16x32_bf16(a0, sf0, zero4, 0, 0, 0); z = __builtin_amdgcn_mfma_f32_16x16x32_bf16(a1, sf1, z, 0, 0, 0);
                    z = __builtin_amdgcn_mfma_f32_16x16x16bf16_1k(cak, vt, z, 0, 0, 0);
                    const bf16x4 zf = pack4(z);
                    const f32x4 u = __builtin_amdgcn_mfma_f32_16x16x16bf16_1k(tt, zf, zero4, 0, 0, 0);
                    const bf16x4 uf = pack4(u);
                    f32x4 y = __builtin_amdgcn_mfma_f32_16x16x32_bf16(r0, sf0, zero4, 0, 0, 0); y = __builtin_amdgcn_mfma_f32_16x16x32_bf16(r1, sf1, y, 0, 0, 0);
                    y = __builtin_amdgcn_mfma_f32_16x16x16bf16_1k(ckr, vt, y, 0, 0, 0); y = __builtin_amdgcn_mfma_f32_16x16x16bf16_1k(cbr, uf, y, 0, 0, 0);
#pragma unroll
                    for (int kt = 0; kt < 4; ++kt) { const f32x4 pl = *(const LAS f32x4*)(sl + O_PL + (16 * kt + 4 * lq) * 4);
                        const bf16x4 bhf = *(const LAS bf16x4*)(sl + O_BHT + (16 * kt + li) * 32 + 8 * lq), khf = *(const LAS bf16x4*)(sl + O_KHT + (16 * kt + li) * 32 + 8 * lq);
                        f32x4 acc = S[kt] * pl; acc = __builtin_amdgcn_mfma_f32_16x16x16bf16_1k(khf, vt, acc, 0, 0, 0); acc = __builtin_amdgcn_mfma_f32_16x16x16bf16_1k(bhf, uf, acc, 0, 0, 0); S[kt] = acc; }
                    ys[q] = y; vts[q] = vt;
                    LAS float* st = (LAS float*)(lds + STAT0 + (g & 1) * 2048 + q * 512);
#pragma unroll
                    for (int r = 0; r < 4; ++r) { const float s1 = red16(y[r]), s2 = red16(y[r] * y[r]); if (li == 0) { f32x2 w2 = {s1, s2}; *(LAS f32x2*)(st + (4 * lq + r) * 8 + 2 * rt) = w2; } }
                }
            }
            __syncthreads();
        }
    } else {
        const int pw = wave - 4, ci = 64 * h + lane;
        const bf16_t* P = (const bf16_t*)(a.ws + WS_P);
        const float* LW = (const float*)((const unsigned char*)a.out + DO_LW); const bf16_t* ASIG = (const bf16_t*)((const unsigned char*)a.out + DO_ASIG);
        const float* mu = (const float*)a.in[I_MU];
        const float mu_r = mu[ci], mu_k = mu[512 + ci], mu_v = mu[1024 + ci], kkc = ((const float*)a.in[I_KK])[ci], kac = ((const float*)a.in[I_KA])[ci], rkc = ((const float*)a.in[I_RK])[ci];
        const int kpos = (lane & 32) + 8 * ((lane >> 2) & 3) + 4 * ((lane >> 4) & 1) + (lane & 3);
        LAS unsigned char* scr = lds + SCR0 + pw * SCR;
        unsigned short x_r[16], x_k[16], x_v[16], x_a[16]; float x_w[16]; unsigned short p_r, p_k, p_v;
#define RW_LOAD(c) do { const size_t mb = m0 + 16 * (c); const bf16_t* pc = P + mb * NP + C_RK + ci; \
        _Pragma("unroll") for (int t = 0; t < 16; ++t) { x_r[t] = pc[(size_t)t * NP]; x_k[t] = pc[(size_t)t * NP + 512]; x_v[t] = pc[(size_t)t * NP + 1024]; x_a[t] = ASIG[(mb + t) * 512 + ci]; x_w[t] = LW[(mb + t) * 512 + ci]; } \
        if ((c) > 0) { p_r = pc[-NP]; p_k = pc[512 - NP]; p_v = pc[1024 - NP]; } else { p_r = 0; p_k = 0; p_v = 0; } } while (0)
        RW_LOAD(pw);
        for (int g = 0; g <= NST + 1; ++g) {
            if (g < NST) {
                const int c = 4 * g + pw; LAS unsigned char* sl = lds + ((g & 1) * 4 + pw) * SLOT;
                float Bt[16], Kt[16], Vv[16], Rk[16];
                float cum = 0.f, ecp = 1.f, prr = bf2f(p_r), prk = bf2f(p_k), prv = bf2f(p_v);
#pragma unroll
                for (int t = 0; t < 16; ++t) {
                    const float cr = bf2f(x_r[t]), ck = bf2f(x_k[t]), cv = bf2f(x_v[t]);
                    const float r = cr + (prr - cr) * mu_r, k0 = ck + (prk - ck) * mu_k, v = cv + (prv - cv) * mu_v; prr = cr; prk = ck; prv = cv;
                    const float asg = bf2f(x_a[t]); const float kkr = k0 * kkc; const float kk = kkr * __builtin_amdgcn_rsqf(fmaxf(wave_sum_fast(kkr * kkr), 1e-24f));
                    const float kx = k0 * (1.0f + (asg - 1.0f) * kac), bb = kk * asg;
                    cum += x_w[t]; const float ec = __expf(cum), eci = __builtin_amdgcn_rcpf(ec);
                    const float at = -kk * ecp, bt = bb * eci, kt = kx * eci, rtl = r * ec; ecp = ec;
                    *(LAS unsigned short*)(sl + O_AT + t * RS + 2 * kpos) = f2bf(at); *(LAS unsigned short*)(sl + O_RT + t * RS + 2 * kpos) = f2bf(rtl);
                    *(LAS unsigned short*)(scr + O_BT + t * RS + 2 * kpos) = f2bf(bt); *(LAS unsigned short*)(scr + O_KT + t * RS + 2 * kpos) = f2bf(kt);
                    Bt[t] = bt; Kt[t] = kt; Vv[t] = v; Rk[t] = rtl * rkc;
                }
                const float pl = ecp;
                *(LAS float*)(sl + O_PL + 4 * lane) = pl;
                { u32x4 w0, w1;
                  w0.x = cvt_pk_bf16(Bt[0] * pl, Bt[1] * pl); w0.y = cvt_pk_bf16(Bt[2] * pl, Bt[3] * pl); w0.z = cvt_pk_bf16(Bt[4] * pl, Bt[5] * pl); w0.w = cvt_pk_bf16(Bt[6] * pl, Bt[7] * pl);
                  w1.x = cvt_pk_bf16(Bt[8] * pl, Bt[9] * pl); w1.y = cvt_pk_bf16(Bt[10] * pl, Bt[11] * pl); w1.z = cvt_pk_bf16(Bt[12] * pl, Bt[13] * pl); w1.w = cvt_pk_bf16(Bt[14] * pl, Bt[15] * pl);
                  *(LAS u32x4*)(sl + O_BHT + lane * 32) = w0; *(LAS u32x4*)(sl + O_BHT + lane * 32 + 16) = w1;
                  w0.x = cvt_pk_bf16(Kt[0] * pl, Kt[1] * pl); w0.y = cvt_pk_bf16(Kt[2] * pl, Kt[3] * pl); w0.z = cvt_pk_bf16(Kt[4] * pl, Kt[5] * pl); w0.w = cvt_pk_bf16(Kt[6] * pl, Kt[7] * pl);
                  w1.x = cvt_pk_bf16(Kt[8] * pl, Kt[9] * pl); w1.y = cvt_pk_bf16(Kt[10] * pl, Kt[11] * pl); w1.z = cvt_pk_bf16(Kt[12] * pl, Kt[13] * pl); w1.w = cvt_pk_bf16(Kt[14] * pl, Kt[15] * pl);
                  *(LAS u32x4*)(sl + O_KHT + lane * 32) = w0; *(LAS u32x4*)(sl + O_KHT + lane * 32 + 16) = w1;
                  w0.x = cvt_pk_bf16(Vv[0], Vv[1]); w0.y = cvt_pk_bf16(Vv[2], Vv[3]); w0.z = cvt_pk_bf16(Vv[4], Vv[5]); w0.w = cvt_pk_bf16(Vv[6], Vv[7]);
                  w1.x = cvt_pk_bf16(Vv[8], Vv[9]); w1.y = cvt_pk_bf16(Vv[10], Vv[11]); w1.z = cvt_pk_bf16(Vv[12], Vv[13]); w1.w = cvt_pk_bf16(Vv[14], Vv[15]);
                  *(LAS u32x4*)(sl + O_VT + lane * 32) = w0; *(LAS u32x4*)(sl + O_VT + lane * 32 + 16) = w1; }
                if (g + 1 < NST) RW_LOAD(c + 4);
                const bf16x8 af0 = *(const LAS bf16x8*)(sl + O_AT + li * RS + 16 * lq), af1 = *(const LAS bf16x8*)(sl + O_AT + li * RS + 64 + 16 * lq);
                const bf16x8 rf0 = *(const LAS bf16x8*)(sl + O_RT + li * RS + 16 * lq), rf1 = *(const LAS bf16x8*)(sl + O_RT + li * RS + 64 + 16 * lq);
                const bf16x8 bf0 = *(const LAS bf16x8*)(scr + O_BT + li * RS + 16 * lq), bf1 = *(const LAS bf16x8*)(scr + O_BT + li * RS + 64 + 16 * lq);
                const bf16x8 kf0 = *(const LAS bf16x8*)(scr + O_KT + li * RS + 16 * lq), kf1 = *(const LAS bf16x8*)(scr + O_KT + li * RS + 64 + 16 * lq);
                const f32x4 zero4 = (f32x4){0.f, 0.f, 0.f, 0.f};
                f32x4 nn = __builtin_amdgcn_mfma_f32_16x16x32_bf16(bf0, af0, zero4, 0, 0, 0); nn = __builtin_amdgcn_mfma_f32_16x16x32_bf16(bf1, af1, nn, 0, 0, 0);
                f32x4 ca = __builtin_amdgcn_mfma_f32_16x16x32_bf16(kf0, af0, zero4, 0, 0, 0); ca = __builtin_amdgcn_mfma_f32_16x16x32_bf16(kf1, af1, ca, 0, 0, 0);
                f32x4 cb = __builtin_amdgcn_mfma_f32_16x16x32_bf16(bf0, rf0, zero4, 0, 0, 0); cb = __builtin_amdgcn_mfma_f32_16x16x32_bf16(bf1, rf1, cb, 0, 0, 0);
                f32x4 ck = __builtin_amdgcn_mfma_f32_16x16x32_bf16(kf0, rf0, zero4, 0, 0, 0); ck = __builtin_amdgcn_mfma_f32_16x16x32_bf16(kf1, rf1, ck, 0, 0, 0);
#pragma unroll
                for (int t = 0; t < 16; ++t) *(LAS unsigned short*)(scr + O_RK + t * RS + 2 * kpos) = f2bf(Rk[t]);
                const bf16x8 qf0 = *(const LAS bf16x8*)(scr + O_RK + li * RS + 16 * lq), qf1 = *(const LAS bf16x8*)(scr + O_RK + li * RS + 64 + 16 * lq);
                f32x4 dk = __builtin_amdgcn_mfma_f32_16x16x32_bf16(kf0, qf0, zero4, 0, 0, 0); dk = __builtin_amdgcn_mfma_f32_16x16x32_bf16(kf1, qf1, dk, 0, 0, 0);
                if (lq == (li >> 2)) { const int e = li & 3; *(LAS float*)(sl + O_RKB + 4 * li) = e == 0 ? dk[0] : (e == 1 ? dk[1] : (e == 2 ? dk[2] : dk[3])); }
#pragma unroll
                for (int r = 0; r < 4; ++r) { const int i = 4 * lq + r; const bool lt = i < li, le = i <= li;
                    nn[r] = lt ? nn[r] : 0.f; ca[r] = lt ? ca[r] : 0.f; cb[r] = le ? cb[r] : 0.f; ck[r] = le ? ck[r] : 0.f;
                    *(LAS float*)(scr + O_NF + (i * 16 + li) * 4) = nn[r]; }
                *(LAS bf16x4*)(sl + O_CAK + li * 32 + 8 * lq) = pack4(ca); *(LAS bf16x4*)(sl + O_CBR + li * 32 + 8 * lq) = pack4(cb); *(LAS bf16x4*)(sl + O_CKR + li * 32 + 8 * lq) = pack4(ck);
                { float T[16]; int li2 = li; asm volatile("" : "+v"(li2));
#pragma unroll
                  for (int t = 0; t < 16; ++t) T[t] = (t == li2) ? 1.f : 0.f;
#pragma unroll
                  for (int j = 0; j < 15; ++j) {
#pragma unroll
                      for (int t4 = (j + 1) / 4; t4 < 4; ++t4) { const f32x4 nr = *(const LAS f32x4*)(scr + O_NF + (j * 16 + 4 * t4) * 4);
#pragma unroll
                          for (int e = 0; e < 4; ++e) { const int t = 4 * t4 + e; if (t > j) T[t] += T[j] * nr[e]; } } }
                  if (lane < 16) {
#pragma unroll
                      for (int t = 0; t < 16; ++t) *(LAS unsigned short*)(sl + O_TT + (t * 16 + lane) * 2) = f2bf(T[t]); } }
            }
            __syncthreads();
        }
#undef RW_LOAD
    }
}

__device__ __forceinline__ void retention_wg(LAS unsigned char* lds, int bh) {
    const Args a = load_args(); TIDS();
    const int b = bh >> 3, h = bh & 7;
    constexpr int QS_ = 72, TS_ = 136;
    LAS bf16_t* Qs = (LAS bf16_t*)lds;
    LAS bf16_t* Ks = Qs + 128 * QS_;
    LAS bf16_t* KzT = Ks + 128 * QS_;
    LAS bf16_t* VT = KzT + 64 * TS_;
    LAS bf16_t* Ps = VT + 64 * TS_;
    LAS bf16_t* RT = Ps + 128 * TS_;
    const bf16_t* P = (const bf16_t*)(a.ws + WS_P); const f32x2* ROPE = (const f32x2*)(a.ws + WS_ROPE); bf16_t* Y = (bf16_t*)(a.ws + WS_ACTA);
    const float* gnw = (const float*)a.in[I_RGNW]; const float* gnb = (const float*)a.in[I_RGNB];
    const float lg2 = log2f(1.0f - exp2f(-5.0f - (float)h));
    const float gch = exp2f(128.0f * lg2);
    for (int i = tid; i < 64 * QS_ / 2; i += 512) ((LAS unsigned*)RT)[i] = 0u;
    const int tk = tid >> 2, qd = tid & 3;
    const float zeta = exp2f((float)(127 - tk) * lg2);
    const int li = lane & 15, lq = lane >> 4, i0 = 16 * wave;
    const float xi = exp2f((float)(i0 + li + 1) * lg2);
    f32x4 Rst[2]; Rst[0] = (f32x4){0.f, 0.f, 0.f, 0.f}; Rst[1] = Rst[0];
    u32x4 gq1, gq2, gk1, gk2, gv1, gv2; f32x4 gr[4];
#define RT_LOAD(n) do { const size_t m = (size_t)b * SEQ + (n) * 128 + tk; const bf16_t* pr = P + m * NP + 64 * h; \
        gq1 = *(const u32x4*)(pr + 8 * qd); gq2 = *(const u32x4*)(pr + 32 + 8 * qd); gk1 = *(const u32x4*)(pr + 512 + 8 * qd); gk2 = *(const u32x4*)(pr + 544 + 8 * qd); \
        gv1 = *(const u32x4*)(pr + 1024 + 16 * qd); gv2 = *(const u32x4*)(pr + 1032 + 16 * qd); \
        const f32x4* rp = (const f32x4*)(ROPE + m * 32 + 8 * qd); gr[0] = rp[0]; gr[1] = rp[1]; gr[2] = rp[2]; gr[3] = rp[3]; } while (0)
    RT_LOAD(0);
    for (int n = 0; n < SEQ / 128; ++n) {
        { float q1[8], q2[8], k1[8], k2[8];
#pragma unroll
          for (int j = 0; j < 4; ++j) { q1[2 * j] = bflo(gq1[j]); q1[2 * j + 1] = bfhi(gq1[j]); q2[2 * j] = bflo(gq2[j]); q2[2 * j + 1] = bfhi(gq2[j]);
              k1[2 * j] = bflo(gk1[j]); k1[2 * j + 1] = bfhi(gk1[j]); k2[2 * j] = bflo(gk2[j]); k2[2 * j + 1] = bfhi(gk2[j]); }
          float oq1[8], oq2[8], ok1[8], ok2[8];
#pragma unroll
          for (int j = 0; j < 8; ++j) { const float cs = gr[j >> 1][2 * (j & 1)], sn = gr[j >> 1][2 * (j & 1) + 1];
              oq1[j] = q1[j] * cs - q2[j] * sn; oq2[j] = q2[j] * cs + q1[j] * sn;
              ok1[j] = (k1[j] * cs - k2[j] * sn) * 0.125f; ok2[j] = (k2[j] * cs + k1[j] * sn) * 0.125f; }
          u32x4 w;
          w.x = cvt_pk_bf16(oq1[0], oq1[1]); w.y = cvt_pk_bf16(oq1[2], oq1[3]); w.z = cvt_pk_bf16(oq1[4], oq1[5]); w.w = cvt_pk_bf16(oq1[6], oq1[7]); *(LAS u32x4*)(Qs + tk * QS_ + 8 * qd) = w;
          w.x = cvt_pk_bf16(oq2[0], oq2[1]); w.y = cvt_pk_bf16(oq2[2], oq2[3]); w.z = cvt_pk_bf16(oq2[4], oq2[5]); w.w = cvt_pk_bf16(oq2[6], oq2[7]); *(LAS u32x4*)(Qs + tk * QS_ + 32 + 8 * qd) = w;
          w.x = cvt_pk_bf16(ok1[0], ok1[1]); w.y = cvt_pk_bf16(ok1[2], ok1[3]); w.z = cvt_pk_bf16(ok1[4], ok1[5]); w.w = cvt_pk_bf16(ok1[6], ok1[7]); *(LAS u32x4*)(Ks + tk * QS_ + 8 * qd) = w;
          w.x = cvt_pk_bf16(ok2[0], ok2[1]); w.y = cvt_pk_bf16(ok2[2], ok2[3]); w.z = cvt_pk_bf16(ok2[4], ok2[5]); w.w = cvt_pk_bf16(ok2[6], ok2[7]); *(LAS u32x4*)(Ks + tk * QS_ + 32 + 8 * qd) = w;
#pragma unroll
          for (int j = 0; j < 8; ++j) { KzT[(8 * qd + j) * TS_ + tk] = (bf16_t)(cvt_pk_bf16(ok1[j] * zeta, 0.f) & 0xffffu); KzT[(32 + 8 * qd + j) * TS_ + tk] = (bf16_t)(cvt_pk_bf16(ok2[j] * zeta, 0.f) & 0xffffu); }
#pragma unroll
          for (int j = 0; j < 4; ++j) { VT[(16 * qd + 2 * j) * TS_ + tk] = (bf16_t)(gv1[j] & 0xffffu); VT[(16 * qd + 2 * j + 1) * TS_ + tk] = (bf16_t)(gv1[j] >> 16);
              VT[(16 * qd + 8 + 2 * j) * TS_ + tk] = (bf16_t)(gv2[j] & 0xffffu); VT[(16 * qd + 8 + 2 * j + 1) * TS_ + tk] = (bf16_t)(gv2[j] >> 16); } }
        if (n + 1 < SEQ / 128) RT_LOAD(n + 1);
        __syncthreads();
        bf16x8 qf[2];
        qf[0] = *(const LAS bf16x8*)(Qs + (i0 + li) * QS_ + 8 * lq); qf[1] = *(const LAS bf16x8*)(Qs + (i0 + li) * QS_ + 32 + 8 * lq);
        const int nks = (wave + 2) >> 1;
        for (int jt = 0; jt < 2 * nks; ++jt) {
            f32x4 s = (f32x4){0.f, 0.f, 0.f, 0.f};
            if (jt <= wave) {
                const bf16x8 kf0 = *(const LAS bf16x8*)(Ks + (16 * jt + li) * QS_ + 8 * lq), kf1 = *(const LAS bf16x8*)(Ks + (16 * jt + li) * QS_ + 32 + 8 * lq);
                s = __builtin_amdgcn_mfma_f32_16x16x32_bf16(kf0, qf[0], s, 0, 0, 0); s = __builtin_amdgcn_mfma_f32_16x16x32_bf16(kf1, qf[1], s, 0, 0, 0);
#pragma unroll
                for (int r = 0; r < 4; ++r) { const int dj = (i0 + li) - (16 * jt + 4 * lq + r); s[r] = dj >= 0 ? s[r] * exp2f((float)dj * lg2) : 0.f; }
            }
            u32x2 w; w.x = cvt_pk_bf16(s[0], s[1]); w.y = cvt_pk_bf16(s[2], s[3]);
            *(LAS u32x2*)(Ps + (i0 + li) * TS_ + 16 * jt + 4 * lq) = w;
        }
        f32x4 ai_[4], ax_[4];
#pragma unroll
        for (int et = 0; et < 4; ++et) { ai_[et] = (f32x4){0.f, 0.f, 0.f, 0.f}; ax_[et] = (f32x4){0.f, 0.f, 0.f, 0.f}; }
        for (int kk = 0; kk < nks; ++kk) { const bf16x8 pf = *(const LAS bf16x8*)(Ps + (i0 + li) * TS_ + 32 * kk + 8 * lq);
#pragma unroll
            for (int et = 0; et < 4; ++et) { const bf16x8 vf = *(const LAS bf16x8*)(VT + (16 * et + li) * TS_ + 32 * kk + 8 * lq); ai_[et] = __builtin_amdgcn_mfma_f32_16x16x32_bf16(vf, pf, ai_[et], 0, 0, 0); } }
#pragma unroll
        for (int kk = 0; kk < 2; ++kk)
#pragma unroll
            for (int et = 0; et < 4; ++et) { const bf16x8 rf = *(const LAS bf16x8*)(RT + (16 * et + li) * QS_ + 32 * kk + 8 * lq); ax_[et] = __builtin_amdgcn_mfma_f32_16x16x32_bf16(rf, qf[kk], ax_[et], 0, 0, 0); }
#pragma unroll
        for (int t2 = 0; t2 < 2; ++t2) { const int id = 2 * wave + t2, dt = id >> 2, et = id & 3; f32x4 kv = (f32x4){0.f, 0.f, 0.f, 0.f};
#pragma unroll
            for (int kk = 0; kk < 4; ++kk) { const bf16x8 kz = *(const LAS bf16x8*)(KzT + (16 * dt + li) * TS_ + 32 * kk + 8 * lq), vf = *(const LAS bf16x8*)(VT + (16 * et + li) * TS_ + 32 * kk + 8 * lq);
                kv = __builtin_amdgcn_mfma_f32_16x16x32_bf16(kz, vf, kv, 0, 0, 0); }
            Rst[t2] = Rst[t2] * gch + kv; }
        __syncthreads();
#pragma unroll
        for (int t2 = 0; t2 < 2; ++t2) { const int id = 2 * wave + t2, dt = id >> 2, et = id & 3; u32x2 w; w.x = cvt_pk_bf16(Rst[t2][0], Rst[t2][1]); w.y = cvt_pk_bf16(Rst[t2][2], Rst[t2][3]);
            *(LAS u32x2*)(RT + (16 * et + li) * QS_ + 16 * dt + 4 * lq) = w; }
        { float y[4][4]; float s = 0.f;
#pragma unroll
          for (int et = 0; et < 4; ++et)
#pragma unroll
              for (int r = 0; r < 4; ++r) { y[et][r] = ai_[et][r] + xi * ax_[et][r]; s += y[et][r]; }
          s += __shfl_xor(s, 16); s += __shfl_xor(s, 32); const float mean = s * (1.f / 64.f); float q = 0.f;
#pragma unroll
          for (int et = 0; et < 4; ++et)
#pragma unroll
              for (int r = 0; r < 4; ++r) { const float d = y[et][r] - mean; q += d * d; }
          q += __shfl_xor(q, 16); q += __shfl_xor(q, 32); const float rstd = 1.0f / sqrtf(q * (1.f / 64.f) + 1e-5f);
          const size_t m = (size_t)b * SEQ + n * 128 + i0 + li;
#pragma unroll
          for (int et = 0; et < 4; ++et) { const int e0 = 64 * h + 16 * et + 4 * lq; const u32x2 g2 = *(const u32x2*)(P + m * NP + 1536 + e0);
              const f32x4 gw4 = *(const f32x4*)(gnw + e0), gb4 = *(const f32x4*)(gnb + e0); float o[4];
              const float gg[4] = {bflo(g2.x), bfhi(g2.x), bflo(g2.y), bfhi(g2.y)};
#pragma unroll
              for (int r = 0; r < 4; ++r) { const float gn = (y[et][r] - mean) * rstd * gw4[r] + gb4[r]; o[r] = gg[r] * sigmoidf_(gg[r]) * gn; }
              u32x2 w; w.x = cvt_pk_bf16(o[0], o[1]); w.y = cvt_pk_bf16(o[2], o[3]); *(u32x2*)(Y + m * D + e0) = w; } }
    }
#undef RT_LOAD
}

__device__ __forceinline__ void phase_rwkv_fin() {
    const Args a = load_args(); TIDS();
    const bf16_t* P = (const bf16_t*)(a.ws + WS_P); const float* YRAW = (const float*)(a.ws + WS_ACTB); bf16_t* Y = (bf16_t*)(a.ws + WS_ACTA);
    const bf16_t* ASIG = (const bf16_t*)((const unsigned char*)a.out + DO_ASIG); const bf16_t* GG = (const bf16_t*)((const unsigned char*)a.out + DO_GG);
    const float* mu = (const float*)a.in[I_MU]; const float* ka = (const float*)a.in[I_KA]; const float* rk = (const float*)a.in[I_RK];
    const float* gnw = (const float*)a.in[I_WGNW]; const float* gnb = (const float*)a.in[I_WGNB];
    const int gw = blockIdx.x * NWAVES + wave, NGW = gridDim.x * NWAVES;
    for (int it = gw; it < M * 8; it += NGW) { const int m = it >> 3, h = it & 7, ci = 64 * h + lane;
        const float y = YRAW[(size_t)m * 512 + ci];
        const float mean = wave_sum(y) * (1.f / 64.f); const float d = y - mean; const float var = wave_sum(d * d) * (1.f / 64.f);
        const float yn = d * (1.0f / sqrtf(var + 64e-5f)) * gnw[ci] + gnb[ci];
        const bf16_t* pc = P + (size_t)m * NP + C_RK + ci;
        const float cr = bf2f(pc[0]), ck = bf2f(pc[512]), cv = bf2f(pc[1024]); float pr = 0.f, pk = 0.f, pv = 0.f;
        if ((m & (SEQ - 1)) != 0) { pr = bf2f(pc[-NP]); pk = bf2f(pc[512 - NP]); pv = bf2f(pc[1024 - NP]); }
        const float r = cr + (pr - cr) * mu[ci], k0 = ck + (pk - ck) * mu[512 + ci], v = cv + (pv - cv) * mu[1024 + ci];
        const float asg = bf2f(ASIG[(size_t)m * 512 + ci]); const float kx = k0 * (1.0f + (asg - 1.0f) * ka[ci]);
        const float bonus = wave_sum(r * kx * rk[ci]) * v;
        const float g = bf2f(GG[(size_t)m * 512 + ci]);
        Y[(size_t)m * D + 512 + ci] = (bf16_t)(cvt_pk_bf16((yn + bonus) * g, 0.f) & 0xffffu); }
}

#define XB_TMO      128
#define XB_XCNT(j)  (256  + 64 * (j))
#define XB_XSUB(j)  (1280 + 64 * (j))
#define XB_XGEN(j)  (2304 + 64 * (j))
#define XB_TOP      3328
#define XB_TOPGEN   3392
#define XCD_BAR_WORDS 3456
#define XB_SPIN_CAP (1u << 18)
__device__ __forceinline__ unsigned xb_ld(unsigned* p)              { return __hip_atomic_load(p, __ATOMIC_RELAXED, __HIP_MEMORY_SCOPE_AGENT); }
__device__ __forceinline__ unsigned xb_add(unsigned* p, unsigned v) { return __hip_atomic_fetch_add(p, v, __ATOMIC_RELAXED, __HIP_MEMORY_SCOPE_AGENT); }
__device__ __forceinline__ unsigned xb_xcc_id() { return (unsigned)__builtin_amdgcn_s_getreg((3 << 11) | 20) & 0xFu; }
#define XB_SPIN(cond, bar) do { unsigned _sp = 0; while (cond) { __builtin_amdgcn_s_sleep(1); \
    if ((++_sp & 255u) == 0u) { if (xb_ld(&(bar)[XB_TMO])) break; if (_sp > XB_SPIN_CAP) { atomicAdd(&(bar)[XB_TMO], 1u); break; } } } } while (0)
struct XcdBarrier { unsigned* bar; unsigned x; volatile LAS unsigned* st; };
__device__ __forceinline__ XcdBarrier xcd_barrier_post(unsigned* bar, volatile LAS unsigned* st) {
    XcdBarrier b; b.bar = bar; b.x = xb_xcc_id(); b.st = st;
    if (threadIdx.x == 0) (void)xb_add(&bar[XB_XCNT(b.x)], 1u);
    return b;
}
__device__ __forceinline__ void xcd_barrier_complete(unsigned* bar, unsigned x, unsigned& nloc, unsigned& nx) {
    const unsigned G = gridDim.x * gridDim.y * gridDim.z;
    unsigned sum, cnt, mine, sp = 0u;
    for (;;) {
        sum = 0u; cnt = 0u; mine = 0u;
#pragma unroll
        for (unsigned j = 0; j < 16; ++j) { const unsigned c = xb_ld(&bar[XB_XCNT(j)]); sum += c; cnt += (c > 0u) ? 1u : 0u; mine = (j == x) ? c : mine; }
        if (sum == G) break;
        __builtin_amdgcn_s_sleep(1);
        if ((++sp & 255u) == 0u) { if (xb_ld(&bar[XB_TMO])) break; if (sp > XB_SPIN_CAP) { atomicAdd(&bar[XB_TMO], 1u); break; } }
    }
    nloc = mine > 0u ? mine : 1u; nx = cnt > 0u ? cnt : 1u;
}
__device__ __forceinline__ void xcd_barrier(const XcdBarrier& b) {
    asm volatile("s_waitcnt vmcnt(0)" ::: "memory");
    __syncthreads();
    if (threadIdx.x == 0) {
        unsigned* bar = b.bar;
        __builtin_amdgcn_s_waitcnt(0);
        unsigned nloc = b.st[0], nx = b.st[1];
        if (nloc == 0u) { xcd_barrier_complete(bar, b.x, nloc, nx); b.st[0] = nloc; b.st[1] = nx; }
        const unsigned old = xb_add(&bar[XB_XSUB(b.x)], 1u);
        const unsigned gen = old / nloc;
        if (old + 1u == (gen + 1u) * nloc) {
            __builtin_amdgcn_fence(__ATOMIC_RELEASE, "agent");
            asm volatile("s_waitcnt vmcnt(0)" ::: "memory");
            const unsigned og = xb_add(&bar[XB_TOP], 1u);
            const unsigned tg = og / nx;
            if (og + 1u == (tg + 1u) * nx) xb_add(&bar[XB_TOPGEN], 1u);
            else XB_SPIN(xb_ld(&bar[XB_TOPGEN]) == tg, bar);
            __builtin_amdgcn_fence(__ATOMIC_ACQUIRE, "agent");
            xb_add(&bar[XB_XGEN(b.x)], 1u);
            asm volatile("s_waitcnt vmcnt(0)" ::: "memory");
        } else {
            XB_SPIN(xb_ld(&bar[XB_XGEN(b.x)]) == gen, bar);
            __builtin_amdgcn_fence(__ATOMIC_ACQUIRE, "agent");
            asm volatile("s_waitcnt vmcnt(0)" ::: "memory");
        }
    }
    __syncthreads();
}

__global__ void __launch_bounds__(NWAVES * 64, 2) mega(Args a_) {
    extern __shared__ __attribute__((aligned(16))) unsigned char lds_raw[];
    LAS unsigned char* lds = (LAS unsigned char*)lds_raw;
    cg::grid_group grid = cg::this_grid();
    const int G = gridDim.x, bx = blockIdx.x;
    volatile LAS unsigned* MISC = (volatile LAS unsigned*)(lds + 131072 + 512);
    if (threadIdx.x < 16) MISC[threadIdx.x] = 0u;
    __syncthreads();
    (void)xcd_barrier_post((unsigned*)a_.ws + 4096, MISC + 8);
#ifndef PHMASK
#define PHMASK 0xfff
#endif
#define IN(k) ((PHMASK >> (k)) & 1)
#define GSYNC() do { XcdBarrier xb_; xb_.bar = (unsigned*)load_args().ws + 4096; xb_.x = xb_xcc_id(); xb_.st = (volatile LAS unsigned*)(lds + 131072 + 512) + 8; xcd_barrier(xb_); } while (0)
#define SEAM(k) do { if (IN(k) && IN((k) + 1)) { if ((k) == 0) grid.sync(); else GSYNC(); } } while (0)
#define ARGS() const Args a = load_args(); unsigned char* ws = a.ws; (void)ws
#ifndef REPMASK
#define REPMASK 0
#endif
#ifndef NSYNC_EXTRA
#define NSYNC_EXTRA 0
#endif
#define REPS(k) (((REPMASK >> (k)) & 1) ? 2 : 1)
#define REPSYNC() do { if (rep) GSYNC(); } while (0)

    for (int i = 0; i < NSYNC_EXTRA; ++i) GSYNC();
    if (IN(0)) for (int rep = 0; rep < REPS(0); ++rep) { REPSYNC(); phase0(lds); }
    SEAM(0);
    if (IN(1)) for (int rep = 0; rep < REPS(1); ++rep) {   REPSYNC();
        ARGS();
        pg8::Gemm g{(const bf16_t*)(ws + WS_ACTA), (const bf16_t*)(ws + WS_WIN), D, D, D}; pg8::StaticOrder S; S.init(M, NP, G, bx);
        pg8::EpiStore<0, false> E{(bf16_t*)(ws + WS_P), NP, 1, 1, nullptr, 1.0f};
        pg8::gemm_phase<pg8::EpiStore<0, false>, pg8::StaticOrder, true>(lds, g, S, E);
    }
    SEAM(1);
    if (IN(2)) for (int rep = 0; rep < REPS(2); ++rep) { REPSYNC(); phase_lora_in(); }
    SEAM(2);
    if (IN(3)) for (int rep = 0; rep < REPS(3); ++rep) {   REPSYNC();
        ARGS();
        pg8::Gemm g{(const bf16_t*)(ws + WS_ACTB), (const bf16_t*)(ws + WS_LORA), LK, LK, LK}; pg8::StaticOrder S; S.init(M, LN, G, bx);
        pg8::EpiLora E{(float*)((unsigned char*)a.out + DO_LW), (bf16_t*)((unsigned char*)a.out + DO_ASIG), (bf16_t*)((unsigned char*)a.out + DO_GG), (const float*)a.in[I_W0], (const float*)a.in[I_A0]};
        pg8::gemm_phase<pg8::EpiLora, pg8::StaticOrder, true>(lds, g, S, E);
    }
    SEAM(3);
    if (IN(4)) for (int rep = 0; rep < REPS(4); ++rep) {   REPSYNC();
#ifndef REP_SCAN
#define REP_SCAN 1
#endif
#ifndef REP_RET
#define REP_RET 1
#endif
        if (bx < 64) { for (int r2 = 0; r2 < REP_SCAN; ++r2) { if (r2) __syncthreads(); rwkv_chunk_wg(lds, bx); } }
        else if (bx < 128) { for (int r2 = 0; r2 < REP_RET; ++r2) { if (r2) __syncthreads(); retention_wg(lds, bx - 64); } }
        else if (bx < 192) { ARGS(); const int idx = bx - 128;
            if (idx < 32) { pg8::Gemm g{(const bf16_t*)(ws + WS_MEMN), (const bf16_t*)(ws + WS_WKV), D, D, D}; pg8::OneUnit S{idx >> 2, idx & 3};
                pg8::EpiStore<0, false> E{(bf16_t*)(ws + WS_KM), D, 1, 1, nullptr, 1.0f}; pg8::gemm_phase<pg8::EpiStore<0, false>, pg8::OneUnit, true>(lds, g, S, E); }
            else { const int j = idx - 32; pg8::Gemm g{(const bf16_t*)(ws + WS_WKV) + (size_t)D * D, (const bf16_t*)(ws + WS_MEMN), D, D, D}; pg8::OneUnit S{j >> 3, j & 7};
                pg8::EpiStore<0, false> E{(bf16_t*)(ws + WS_VT), MM, 1, 1, nullptr, 1.0f}; pg8::gemm_phase<pg8::EpiStore<0, false>, pg8::OneUnit, true>(lds, g, S, E); } }
    }
    SEAM(4);
    if (IN(6)) for (int rep = 0; rep < REPS(6); ++rep) {   REPSYNC();
        ARGS();
        pg8::Gemm g{(const bf16_t*)(ws + WS_ACTA), (const bf16_t*)(ws + WS_WOUT), D, D, D}; pg8::StaticOrder S; S.init(M, D, G, bx);
        pg8::EpiRes E{(const float*)a.in[I_X], a.out, (bf16_t*)(ws + WS_ACTB), (float*)(ws + WS_SQ1)};
        pg8::gemm_phase<pg8::EpiRes, pg8::StaticOrder, true>(lds, g, S, E);
    }
    SEAM(6);
    if (IN(7)) for (int rep = 0; rep < REPS(7); ++rep) {   REPSYNC();
        if (bx < 256) { ARGS(); const int u = bx; const int b = u >> 5, h4 = (u >> 3) & 3, qt = u & 7; const int pm = b * 8 + qt;
            bf16_t* QS = (bf16_t*)(ws + WS_P) + (size_t)u * 131072; bf16_t* PSb = QS + 65536;
            { pg8::Gemm g{(const bf16_t*)(ws + WS_ACTB), (const bf16_t*)(ws + WS_WQ), D, D, D}; pg8::OneUnit S{pm, h4};
              pg8::EpiStore<0, true> E{QS, 256, 0, 0, (const float*)(ws + WS_SQ1), 0.0625f}; pg8::gemm_phase<pg8::EpiStore<0, true>, pg8::OneUnit, true>(lds, g, S, E); }
            asm volatile("s_waitcnt vmcnt(0)" ::: "memory"); __syncthreads(); __builtin_amdgcn_fence(__ATOMIC_ACQUIRE, "agent"); asm volatile("s_waitcnt vmcnt(0)" ::: "memory"); __syncthreads();
            { pg8::Gemm g{QS, (const bf16_t*)(ws + WS_KM) + (size_t)(b * 256) * D + h4 * 256, 256, D, 256}; pg8::OneUnit S{0, 0};
              pg8::EpiSoftmax E{PSb}; pg8::gemm_phase<pg8::EpiSoftmax, pg8::OneUnit, false>(lds, g, S, E); }
            asm volatile("s_waitcnt vmcnt(0)" ::: "memory"); __syncthreads(); __builtin_amdgcn_fence(__ATOMIC_ACQUIRE, "agent"); asm volatile("s_waitcnt vmcnt(0)" ::: "memory"); __syncthreads();
            { pg8::Gemm g{PSb, (const bf16_t*)(ws + WS_VT) + (size_t)(h4 * 256) * MM + b * 256, 256, MM, 256}; pg8::OneUnit S{0, 0};
              pg8::EpiStore<0, false> E{(bf16_t*)(ws + WS_ACTA) + (size_t)(pm * 256) * D + h4 * 256, D, 0, 0, nullptr, 1.0f}; pg8::gemm_phase<pg8::EpiStore<0, false>, pg8::OneUnit, true>(lds, g, S, E); }
            __syncthreads();
        }
    }
    SEAM(7);
    if (IN(8)) {
        ARGS();
        pg8::Gemm g{(const bf16_t*)(ws + WS_ACTA), (const bf16_t*)(ws + WS_WO), D, D, D}; pg8::StaticOrder S; S.init(M, D, G, bx);
        pg8::EpiRes E{a.out, a.out, (bf16_t*)(ws + WS_ACTB), (float*)(ws + WS_SQ2)};
        pg8::gemm_phase<pg8::EpiRes, pg8::StaticOrder, true>(lds, g, S, E);
    }
    SEAM(8);
    if (IN(9)) for (int rep = 0; rep < REPS(9); ++rep) {   REPSYNC();
        ARGS();
        pg8::Gemm g{(const bf16_t*)(ws + WS_ACTB), (const bf16_t*)(ws + WS_WUP), D, D, D}; pg8::StaticOrder S; S.init(M, FF, G, bx);
        pg8::EpiStore<2, true> E{(bf16_t*)(ws + WS_P), FF, 1, 1, (const float*)(ws + WS_SQ2), 1.0f};
        pg8::gemm_phase<pg8::EpiStore<2, true>, pg8::StaticOrder, true>(lds, g, S, E);
    }
    SEAM(9);
    if (IN(10)) {
        ARGS();
        pg8::Gemm g{(const bf16_t*)(ws + WS_P), (const bf16_t*)(ws + WS_WDN), FF, FF, FF}; pg8::StaticOrder S; S.init(M, D, G, bx);
        pg8::EpiRes E{a.out, a.out, nullptr, (float*)(ws + WS_SQ3)};
        pg8::gemm_phase<pg8::EpiRes, pg8::StaticOrder, true>(lds, g, S, E);
    }
    SEAM(10);
    if (IN(11)) {
        ARGS(); TIDS();
        const float* sq = (const float*)(ws + WS_SQ3); const float* gf = (const float*)a.in[I_NFIN];
        const int gw = bx * NWAVES + wave, NGW = G * NWAVES;
        f32x4 gv[4];
#pragma unroll
        for (int j = 0; j < 4; ++j) gv[j] = ((const f32x4*)gf)[lane + 64 * j];
        for (int m = gw; m < M; m += NGW) { const f32x4* q4 = (const f32x4*)(sq + (size_t)m * 16); const f32x4 s = q4[0] + q4[1] + q4[2] + q4[3];
            const float rstd = 1.0f / sqrtf((s[0] + s[1] + s[2] + s[3]) * (1.f / 1024.f) + 1e-6f);
            f32x4* xr = (f32x4*)(a.out + (size_t)m * D) + lane;
#pragma unroll
            for (int j = 0; j < 4; ++j) xr[64 * j] = xr[64 * j] * rstd * gv[j]; }
    }
#undef IN
#undef SEAM
#undef ARGS
}

extern "C" void kernel_launch(void* const* d_in, const int* in_sizes, int n_in, void* d_out, int out_size, void* d_ws, size_t ws_size, hipStream_t stream) {
    static int grid = 0;
    if (grid == 0) {
        if (n_in != 28 || out_size != M * D || ws_size < WS_END) { fprintf(stderr, "kernel_launch: unexpected shapes (n_in %d out %d ws %zu)\n", n_in, out_size, ws_size); grid = -1; return; }
        int dev = 0, cus = 0, per_cu = 0;
        if (hipGetDevice(&dev) != hipSuccess || hipDeviceGetAttribute(&cus, hipDeviceAttributeMultiprocessorCount, dev) != hipSuccess) { grid = -1; return; }
        if (hipFuncSetAttribute((const void*)mega, hipFuncAttributeMaxDynamicSharedMemorySize, LDS_BYTES) != hipSuccess) { fprintf(stderr, "kernel_launch: hipFuncSetAttribute failed\n"); grid = -1; return; }
        if (hipOccupancyMaxActiveBlocksPerMultiprocessor(&per_cu, (const void*)mega, NWAVES * 64, LDS_BYTES) != hipSuccess || per_cu < 1) { fprintf(stderr, "kernel_launch: occupancy query says %d\n", per_cu); (void)hipGetLastError(); }
        grid = cus;
        if (grid != 256) fprintf(stderr, "kernel_launch: %d CUs (built for 256)\n", grid);
    }
    if (grid < 0) return;
    if (hipMemsetAsync(d_ws, 0, 65536, stream) != hipSuccess) { fprintf(stderr, "kernel_launch: memset failed\n"); return; }
    Args a{};
    for (int i = 0; i < 28; ++i) a.in[i] = d_in[i];
    a.out = (float*)d_out; a.ws = (unsigned char*)d_ws; a.ph_lo = 0; a.ph_hi = 12;
    void* args[] = {&a};
    hipError_t e = hipLaunchCooperativeKernel((const void*)mega, dim3(grid), dim3(NWAVES * 64), args, LDS_BYTES, stream);
    if (e != hipSuccess) fprintf(stderr, "cooperative launch failed: %s (grid %d)\n", hipGetErrorString(e), grid);
}
```

```cpp
#include <hip/hip_runtime.h>
#include <hip/hip_cooperative_groups.h>
#include <cstdio>
#include <cstdint>
namespace cg = cooperative_groups;
#define REPMASK 0
#define NSYNC_EXTRA 0
#define REP_SCAN 1
#define REP_RET 1

#define LAS __attribute__((address_space(3)))
typedef unsigned short bf16_t;
typedef short bf16x8 __attribute__((ext_vector_type(8)));
typedef float f32x4 __attribute__((ext_vector_type(4)));
typedef float f32x2 __attribute__((ext_vector_type(2)));
typedef unsigned u32x4 __attribute__((ext_vector_type(4)));
typedef unsigned u32x2 __attribute__((ext_vector_type(2)));

typedef __bf16 bf16x2_t __attribute__((ext_vector_type(2)));
__device__ __forceinline__ unsigned cvt_pk_bf16(float lo, float hi) { f32x2 v = {lo, hi}; bf16x2_t b = __builtin_convertvector(v, bf16x2_t); return __builtin_bit_cast(unsigned, b); }
__device__ __forceinline__ float bf2f(unsigned short b) { return __uint_as_float(((unsigned)b) << 16); }
__device__ __forceinline__ float bflo(unsigned w) { return __uint_as_float(w << 16); }
__device__ __forceinline__ float bfhi(unsigned w) { return __uint_as_float(w & 0xffff0000u); }
__device__ __forceinline__ float sigmoidf_(float x) { return __builtin_amdgcn_rcpf(1.0f + __expf(-x)); }
__device__ __forceinline__ float wave_sum(float v) {
#pragma unroll
    for (int o = 1; o < 64; o <<= 1) v += __shfl_xor(v, o);
    return v;
}

namespace pg8 {
constexpr int BM = 256, BK = 64, HALF = 128, HTB = HALF * BK * 2, STAGE_BYTES = 8 * HTB, NXCD = 8, WGM = 8;
__host__ __device__ __forceinline__ int lds_byte(int r, int c) { const int st = (r >> 4) * 2 + (c >> 5), rr = r & 15, cc = c & 31, ob = rr * 64 + cc * 2; return st * 1024 + (ob ^ (((ob >> 9) & 1) << 5)); }
__host__ __device__ __forceinline__ void stage_rc(int b, int& R, int& C) { const int st = b / 1024, sb = b % 1024, swz = sb ^ (((sb >> 9) & 1) << 5); R = (st >> 1) * 16 + swz / 64; C = (st & 1) * 32 + (swz % 64) / 2; }
__host__ __device__ __forceinline__ int perm32(int rho) { const int n = rho >> 4, i = rho & 15; return 8 * (i >> 2) + 4 * n + (i & 3); }

struct Unit { int pm, pn; };
struct Gemm { const bf16_t* A; const bf16_t* Bt; int lda, ldb, K; };

struct StaticOrder {
    int nM, nN, nwg, G, c;
    __device__ void init(int M, int N, int G_, int c_) { nM = M / BM; nN = N / BM; nwg = nM * nN; G = G_; c = c_; }
    __device__ bool next(int i, Unit& u) const {
        const long L = (long)i * G + c; if (L >= nwg) return false;
        int wgid = (int)L; { const int q = nwg / NXCD, r = nwg % NXCD, xcd = wgid % NXCD, off = wgid / NXCD; wgid = (xcd < r ? xcd * (q + 1) : r * (q + 1) + (xcd - r) * q) + off; }
        const int nig = WGM * nN, gid = wgid / nig, fm = gid * WGM, gsz = (nM - fm) < WGM ? (nM - fm) : WGM;
        u.pm = fm + ((wgid % nig) % gsz); u.pn = (wgid % nig) / gsz; return true;
    }
};
struct OneUnit {
    int pm, pn;
    __device__ bool next(int i, Unit& u) const { if (i) return false; u.pm = pm; u.pn = pn; return true; }
};


template <int ACT, bool RS> struct EpiStore {
    static constexpr bool PERM = true, AFTER_DRAIN = false;
    bf16_t* O; int ldc; int om, on; const float* sq; float cs;
    __device__ __forceinline__ void operator()(const f32x4 (&acc)[2][2][4][2], const Unit& u, int wr, int wc, int fr, int fq) const {
        int rl0 = wr * 64 + fr, cl0 = wc * 32 + 8 * fq; asm volatile("" : "+v"(rl0), "+v"(cl0));
        bf16_t* base = O + (size_t)(om * u.pm * BM) * ldc + on * u.pn * BM + cl0;
#pragma unroll
        for (int ai = 0; ai < 2; ++ai)
#pragma unroll
            for (int m = 0; m < 4; ++m) {
                const int rl = rl0 + ai * HALF + m * 16;
                float sc = cs;
                if (RS) { const f32x4* q4 = (const f32x4*)(sq + (size_t)(u.pm * BM + rl) * 16); f32x4 s = q4[0] + q4[1] + q4[2] + q4[3];
                    sc *= __builtin_amdgcn_rsqf((s[0] + s[1] + s[2] + s[3]) * (1.0f / 1024.0f) + 1e-6f); }
                bf16_t* rowp = base + (size_t)rl * ldc;
#pragma unroll
                for (int bj = 0; bj < 2; ++bj) { f32x4 v0 = acc[ai][bj][m][0] * sc, v1 = acc[ai][bj][m][1] * sc;
                    if (ACT == 2) {
#pragma unroll
                        for (int j = 0; j < 4; ++j) { float x = fmaxf(v0[j], 0.f); v0[j] = x * x; float y = fmaxf(v1[j], 0.f); v1[j] = y * y; } }
                    u32x4 w; w.x = cvt_pk_bf16(v0[0], v0[1]); w.y = cvt_pk_bf16(v0[2], v0[3]); w.z = cvt_pk_bf16(v1[0], v1[1]); w.w = cvt_pk_bf16(v1[2], v1[3]);
                    *(u32x4*)(rowp + bj * HALF) = w; } }
    }
};

struct EpiLora {
    static constexpr bool PERM = true, AFTER_DRAIN = false;
    float* LW; bf16_t* ASIG; bf16_t* GG; const float* w0; const float* a0;
    template <int SECT> __device__ __forceinline__ void run(const f32x4 (&acc)[2][2][4][2], int rl0, int c0) const {
        const float* cvec = SECT == 0 ? w0 : a0; bf16_t* ob = SECT == 1 ? ASIG : GG;
#pragma unroll
        for (int ai = 0; ai < 2; ++ai)
#pragma unroll
            for (int m = 0; m < 4; ++m) {
                const size_t row = (size_t)(rl0 + ai * HALF + m * 16);
#pragma unroll
                for (int bj = 0; bj < 2; ++bj) { const int c = c0 + bj * HALF; f32x4 v0 = acc[ai][bj][m][0], v1 = acc[ai][bj][m][1];
                    if (SECT < 2) { v0 += *(const f32x4*)(cvec + c); v1 += *(const f32x4*)(cvec + c + 4); }
                    if (SECT == 0) {
#pragma unroll
                        for (int j = 0; j < 4; ++j) { v0[j] = -0.60653065971f * sigmoidf_(v0[j]); v1[j] = -0.60653065971f * sigmoidf_(v1[j]); }
                        *(f32x4*)(LW + row * 512 + c) = v0; *(f32x4*)(LW + row * 512 + c + 4) = v1;
                    } else {
                        if (SECT == 1) {
#pragma unroll
                            for (int j = 0; j < 4; ++j) { v0[j] = sigmoidf_(v0[j]); v1[j] = sigmoidf_(v1[j]); } }
                        u32x4 w; w.x = cvt_pk_bf16(v0[0], v0[1]); w.y = cvt_pk_bf16(v0[2], v0[3]); w.z = cvt_pk_bf16(v1[0], v1[1]); w.w = cvt_pk_bf16(v1[2], v1[3]);
                        *(u32x4*)(ob + row * 512 + c) = w; } }
                asm volatile("" ::: "memory"); }
    }
    __device__ __forceinline__ void operator()(const f32x4 (&acc)[2][2][4][2], const Unit& u, int wr, int wc, int fr, int fq) const {
        int rl0 = u.pm * BM + wr * 64 + fr, c0 = (u.pn & 1) * BM + wc * 32 + 8 * fq; const int sect = u.pn >> 1; asm volatile("" : "+v"(rl0), "+v"(c0));
        if (sect == 0) run<0>(acc, rl0, c0); else if (sect == 1) run<1>(acc, rl0, c0); else run<2>(acc, rl0, c0);
    }
};

struct EpiRes {
    static constexpr bool PERM = true, AFTER_DRAIN = false;
    const float* base; float* out; bf16_t* xb; float* sq;
    __device__ __forceinline__ void operator()(const f32x4 (&acc)[2][2][4][2], const Unit& u, int wr, int wc, int fr, int fq) const {
        int rl0 = u.pm * BM + wr * 64 + fr, c0 = u.pn * BM + wc * 32 + 8 * fq; asm volatile("" : "+v"(rl0), "+v"(c0));
#pragma unroll
        for (int ai = 0; ai < 2; ++ai)
#pragma unroll
            for (int m = 0; m < 4; ++m) {
                const size_t row = (size_t)(rl0 + ai * HALF + m * 16); float ss = 0.f;
#pragma unroll
                for (int bj = 0; bj < 2; ++bj) { const size_t off = row * 1024 + c0 + bj * HALF;
                    const f32x4 b0 = *(const f32x4*)(base + off), b1 = *(const f32x4*)(base + off + 4);
                    const f32x4 o0 = b0 + acc[ai][bj][m][0], o1 = b1 + acc[ai][bj][m][1];
                    *(f32x4*)(out + off) = o0; *(f32x4*)(out + off + 4) = o1;
                    if (xb) { u32x4 w; w.x = cvt_pk_bf16(o0[0], o0[1]); w.y = cvt_pk_bf16(o0[2], o0[3]); w.z = cvt_pk_bf16(o1[0], o1[1]); w.w = cvt_pk_bf16(o1[2], o1[3]); *(u32x4*)(xb + off) = w; }
                    ss += (o0[0] * o0[0] + o0[1] * o0[1]) + (o0[2] * o0[2] + o0[3] * o0[3]) + (o1[0] * o1[0] + o1[1] * o1[1]) + (o1[2] * o1[2] + o1[3] * o1[3]); }
                ss += __shfl_xor(ss, 16); ss += __shfl_xor(ss, 32);
                if (fq == 0) sq[row * 16 + u.pn * 4 + wc] = ss;
                if (m & 1) asm volatile("" ::: "memory"); }
    }
};

struct EpiSoftmax {
    static constexpr bool PERM = true, AFTER_DRAIN = true;
    bf16_t* Pout;
    __device__ __forceinline__ void fused(f32x4 (&acc)[2][2][4][2], const Unit& u, int wr, int wc, int fr, int fq, LAS unsigned char* lds, int wid, int lane) const {
        LAS float* PM = (LAS float*)lds;
        LAS float* PS = (LAS float*)(lds + 4096);
        int rl0 = wr * 64 + fr; asm volatile("" : "+v"(rl0));
#pragma unroll
        for (int ai = 0; ai < 2; ++ai)
#pragma unroll
            for (int m = 0; m < 4; ++m) { float v = -3.0e38f;
#pragma unroll
                for (int bj = 0; bj < 2; ++bj)
#pragma unroll
                    for (int n = 0; n < 2; ++n) { const f32x4 x = acc[ai][bj][m][n]; v = fmaxf(v, fmaxf(fmaxf(x[0], x[1]), fmaxf(x[2], x[3]))); }
                v = fmaxf(v, __shfl_xor(v, 16)); v = fmaxf(v, __shfl_xor(v, 32));
                if (fq == 0) PM[(rl0 + ai * HALF + m * 16) * 4 + wc] = v; }
        asm volatile("s_waitcnt lgkmcnt(0)" ::: "memory"); __builtin_amdgcn_s_barrier(); asm volatile("" ::: "memory");
#pragma unroll
        for (int ai = 0; ai < 2; ++ai)
#pragma unroll
            for (int m = 0; m < 4; ++m) { const f32x4 p = *(const LAS f32x4*)(PM + (rl0 + ai * HALF + m * 16) * 4);
                const float rm = fmaxf(fmaxf(p[0], p[1]), fmaxf(p[2], p[3])) * 1.44269504089f; float s = 0.f;
#pragma unroll
                for (int bj = 0; bj < 2; ++bj)
#pragma unroll
                    for (int n = 0; n < 2; ++n) {
#pragma unroll
                        for (int j = 0; j < 4; ++j) { const float e = __builtin_amdgcn_exp2f(acc[ai][bj][m][n][j] * 1.44269504089f - rm); acc[ai][bj][m][n][j] = e; s += e; } }
                s += __shfl_xor(s, 16); s += __shfl_xor(s, 32);
                if (fq == 0) PS[(rl0 + ai * HALF + m * 16) * 4 + wc] = s; }
        asm volatile("s_waitcnt lgkmcnt(0)" ::: "memory"); __builtin_amdgcn_s_barrier(); asm volatile("" ::: "memory");
#pragma unroll
        for (int ai = 0; ai < 2; ++ai)
#pragma unroll
            for (int m = 0; m < 4; ++m) { const int rl = rl0 + ai * HALF + m * 16; const f32x4 p = *(const LAS f32x4*)(PS + rl * 4);
                const float inv = __builtin_amdgcn_rcpf((p[0] + p[1]) + (p[2] + p[3]));
#pragma unroll
                for (int bj = 0; bj < 2; ++bj) { const f32x4 v0 = acc[ai][bj][m][0] * inv, v1 = acc[ai][bj][m][1] * inv;
                    u32x4 w; w.x = cvt_pk_bf16(v0[0], v0[1]); w.y = cvt_pk_bf16(v0[2], v0[3]); w.z = cvt_pk_bf16(v1[0], v1[1]); w.w = cvt_pk_bf16(v1[2], v1[3]);
                    *(u32x4*)(Pout + (size_t)rl * 256 + wc * 32 + 8 * fq + bj * HALF) = w; } }
    }
};

template <class Epi, class Sched, bool ALIGN_EPI = false, bool SP2 = true>
__device__ __forceinline__ void gemm_phase(LAS unsigned char* lds, const Gemm g, const Sched& S, const Epi& E) {
    int tid = threadIdx.x; asm volatile("" : "+v"(tid));
    const int wid = __builtin_amdgcn_readfirstlane(tid >> 6), lane = tid & 63, wr = wid >> 2, wc = wid & 3, fr = lane & 15, fq = lane >> 4;
    const int K = g.K, nt = K / BK;
    unsigned voffA[2], voffB[2];
#pragma unroll
    for (int i = 0; i < 2; ++i) { int R, C; stage_rc(tid * 16 + i * 8192, R, C); const int Rb = Epi::PERM ? ((R & ~31) + perm32(R & 31)) : R;
        voffA[i] = (unsigned)(R * g.lda + C) * 2u; voffB[i] = (unsigned)(Rb * g.ldb + C) * 2u; }
    const size_t kstep = (size_t)(BK * 2);
    const size_t hstepA = (size_t)HALF * g.lda * 2, hstepB = (size_t)HALF * g.ldb * 2;
    const size_t tstepA = 2 * hstepA, tstepB = 2 * hstepB;
    const unsigned ldsw = (unsigned)wid * 1024u;
    const int aoff = lds_byte(wr * 64 + fr, fq * 8), boff = lds_byte(wc * 32 + fr, fq * 8);
#define PG8_SA(b, h) (((b) * 2 + (h)) * HTB)
#define PG8_SB(b, h) ((4 + (b) * 2 + (h)) * HTB)
#define PG8_STAGE(bufoff, gbase, voff) do { _Pragma("unroll") for (int _i = 0; _i < 2; ++_i) \
        __builtin_amdgcn_global_load_lds((const unsigned*)((const char*)(gbase) + (voff)[_i]), (LAS unsigned*)(lds + (bufoff) + ldsw + _i * 8192), 16, 0, 0); } while (0)
#define PG8_LDA(dst, b, h) do { _Pragma("unroll") for (int m = 0; m < 4; ++m) _Pragma("unroll") for (int k = 0; k < 2; ++k) dst[m][k] = *(const LAS bf16x8*)(lds + PG8_SA(b, h) + aoff + m * 2048 + k * 1024); } while (0)
#define PG8_LDB(dst, b, h) do { _Pragma("unroll") for (int n = 0; n < 2; ++n) _Pragma("unroll") for (int k = 0; k < 2; ++k) dst[n][k] = *(const LAS bf16x8*)(lds + PG8_SB(b, h) + boff + n * 2048 + k * 1024); } while (0)
#define PG8_MMA(ai, bj, At, Bt) do { __builtin_amdgcn_s_setprio(1); _Pragma("unroll") for (int m = 0; m < 4; ++m) _Pragma("unroll") for (int n = 0; n < 2; ++n) _Pragma("unroll") for (int k = 0; k < 2; ++k) \
        acc[ai][bj][m][n] = __builtin_amdgcn_mfma_f32_16x16x32_bf16(Bt[n][k], At[m][k], acc[ai][bj][m][n], 0, 0, 0); __builtin_amdgcn_s_setprio(0); } while (0)
#define PG8_WAIT_V(n) asm volatile("s_waitcnt vmcnt(" #n ")" ::: "memory")
#define PG8_WAIT_L(n) asm volatile("s_waitcnt lgkmcnt(" #n ")" ::: "memory")
#define PG8_BAR __builtin_amdgcn_s_barrier()
#define PG8_SCHED __builtin_amdgcn_sched_barrier(0)
    Unit cur, nxt; int ui = 0;
    if (!S.next(0, cur)) return;
    f32x4 acc[2][2][4][2];
#pragma unroll
    for (int a = 0; a < 2; ++a)
#pragma unroll
        for (int b = 0; b < 2; ++b)
#pragma unroll
            for (int m = 0; m < 4; ++m)
#pragma unroll
                for (int n = 0; n < 2; ++n) acc[a][b][m][n] = (f32x4){0.f, 0.f, 0.f, 0.f};
    bf16x8 At[4][2], B0[2][2], B1[2][2];
    const char* cA = (const char*)g.A + (size_t)cur.pm * tstepA; const char* cB = (const char*)g.Bt + (size_t)cur.pn * tstepB;
    static_assert(SP2, "only the two-super-phase loop is kept here");
    PG8_STAGE(PG8_SB(0, 0), cB, voffB); PG8_STAGE(PG8_SB(0, 1), cB + hstepB, voffB); PG8_STAGE(PG8_SA(0, 0), cA, voffA); PG8_STAGE(PG8_SA(0, 1), cA + hstepA, voffA);
    if (wr == 1) PG8_BAR;
    PG8_WAIT_V(2); PG8_BAR;
    PG8_STAGE(PG8_SB(1, 0), cB + kstep, voffB); PG8_STAGE(PG8_SA(1, 0), cA + kstep, voffA); PG8_STAGE(PG8_SB(1, 1), cB + hstepB + kstep, voffB);
    PG8_WAIT_V(6); PG8_BAR;
    for (;;) {
        const bool has_next = S.next(ui + 1, nxt);
        const char* nA = has_next ? (const char*)g.A + (size_t)nxt.pm * tstepA : cA; const char* nB = has_next ? (const char*)g.Bt + (size_t)nxt.pn * tstepB : cB;
        for (int t = 0; t < nt; t += 2) {
            const bool last = (t == nt - 2);
            const char* a1 = cA + (size_t)(t + 1) * kstep;
            const char* a2 = last ? nA : cA + (size_t)(t + 2) * kstep; const char* b2 = last ? nB : cB + (size_t)(t + 2) * kstep;
            const char* a3 = a2 + kstep; const char* b3 = b2 + kstep;
            PG8_LDB(B0, 0, 0); PG8_LDB(B1, 0, 1); PG8_SCHED; PG8_LDA(At, 0, 0); PG8_STAGE(PG8_SA(1, 1), a1 + hstepA, voffA);
            PG8_WAIT_V(8); PG8_WAIT_L(0); PG8_BAR; PG8_MMA(0, 0, At, B0); PG8_MMA(0, 1, At, B1); PG8_BAR; PG8_SCHED;
            PG8_LDA(At, 0, 1); PG8_STAGE(PG8_SB(0, 0), b2, voffB); PG8_STAGE(PG8_SB(0, 1), b2 + hstepB, voffB); PG8_STAGE(PG8_SA(0, 0), a2, voffA);
            PG8_WAIT_V(8); PG8_WAIT_L(0); PG8_BAR; PG8_MMA(1, 0, At, B0); PG8_MMA(1, 1, At, B1); PG8_BAR; PG8_SCHED;
            PG8_LDB(B0, 1, 0); PG8_LDB(B1, 1, 1); PG8_SCHED; PG8_LDA(At, 1, 0); PG8_STAGE(PG8_SA(0, 1), a2 + hstepA, voffA);
            PG8_WAIT_V(8); PG8_WAIT_L(0); PG8_BAR; PG8_MMA(0, 0, At, B0); PG8_MMA(0, 1, At, B1); PG8_BAR; PG8_SCHED;
            PG8_LDA(At, 1, 1); PG8_STAGE(PG8_SB(1, 0), b3, voffB); PG8_STAGE(PG8_SB(1, 1), b3 + hstepB, voffB); PG8_STAGE(PG8_SA(1, 0), a3, voffA);
            PG8_WAIT_V(8); PG8_WAIT_L(0); PG8_BAR; PG8_MMA(1, 0, At, B0); PG8_MMA(1, 1, At, B1); PG8_BAR; PG8_SCHED;
        }
        if constexpr (ALIGN_EPI) { if (wr == 0) PG8_BAR; }
        if constexpr (!Epi::AFTER_DRAIN) { E(acc, cur, wr, wc, fr, fq); }
        if (!has_next) break;
#pragma unroll
        for (int a = 0; a < 2; ++a)
#pragma unroll
            for (int b = 0; b < 2; ++b)
#pragma unroll
                for (int m = 0; m < 4; ++m)
#pragma unroll
                    for (int n = 0; n < 2; ++n) acc[a][b][m][n] = (f32x4){0.f, 0.f, 0.f, 0.f};
        cur = nxt; cA = nA; cB = nB; ++ui;
        if constexpr (ALIGN_EPI) { if (wr == 1) PG8_BAR; }
    }
    PG8_WAIT_V(0);
    if constexpr (!ALIGN_EPI) { if (wr == 0) PG8_BAR; }
    PG8_BAR;
    if constexpr (Epi::AFTER_DRAIN) { E.fused(acc, cur, wr, wc, fr, fq, lds, wid, lane); }
#undef PG8_SA
#undef PG8_SB
#undef PG8_STAGE
#undef PG8_LDA
#undef PG8_LDB
#undef PG8_MMA
#undef PG8_WAIT_V
#undef PG8_WAIT_L
#undef PG8_BAR
#undef PG8_SCHED
}
}

constexpr int BATCH = 8, SEQ = 2048, D = 1024, M = BATCH * SEQ, NMEM = 256, MM = BATCH * NMEM;
constexpr int NIN = 3872, NP = 4096, FF = 4096, LK = 384, LN = 1536;
constexpr int C_RK = 2048, C_LORA = 3584;
constexpr int NWAVES = 8, LDS_BYTES = 147456;
constexpr size_t MiB = 1u << 20;
constexpr size_t WS_WIN = 1 * MiB, WS_WOUT = 9 * MiB, WS_WQ = 11 * MiB, WS_WKV = 13 * MiB, WS_WO = 17 * MiB, WS_WUP = 19 * MiB, WS_WDN = 27 * MiB, WS_LORA = 35 * MiB;
constexpr size_t WS_MEMN = 37 * MiB, WS_KM = 41 * MiB, WS_VT = 45 * MiB, WS_ROPE = 49 * MiB, WS_SQ1 = 53 * MiB, WS_SQ2 = 54 * MiB, WS_SQ3 = 55 * MiB;
constexpr size_t WS_ACTA = 56 * MiB, WS_ACTB = 88 * MiB, WS_P = 120 * MiB, WS_END = 248 * MiB;
constexpr size_t DO_LW = 0, DO_ASIG = 32 * MiB, DO_GG = 48 * MiB;

struct Args { const void* in[28]; float* out; unsigned char* ws; int ph_lo, ph_hi; };
typedef const __attribute__((address_space(4))) unsigned long long* CArgs;
__device__ __forceinline__ Args load_args() { CArgs p = (CArgs)__builtin_amdgcn_kernarg_segment_ptr(); asm volatile("" : "+s"(p)); Args a;
#pragma unroll
    for (int i = 0; i < 28; ++i) a.in[i] = (const void*)(const __attribute__((address_space(1))) void*)p[i];
    a.out = (float*)(__attribute__((address_space(1))) float*)p[28]; a.ws = (unsigned char*)(__attribute__((address_space(1))) unsigned char*)p[29]; a.ph_lo = (int)p[30]; a.ph_hi = (int)(p[30] >> 32); return a; }
#define TIDS() int tid = threadIdx.x; asm volatile("" : "+v"(tid)); const int lane = tid & 63, wave = __builtin_amdgcn_readfirstlane(tid >> 6); (void)lane; (void)wave
enum { I_X = 0, I_MEM, I_POS, I_NMIX, I_WIN, I_RGNW, I_RGNB, I_MU, I_W0, I_WUP, I_A0, I_AUP, I_GUP, I_KK, I_KA, I_RK, I_WGNW, I_WGNB, I_WOUT, I_NXA, I_NMEM, I_WQ, I_WKV, I_WO, I_NMLP, I_MUP, I_MDN, I_NFIN };

__device__ __forceinline__ void p0_transpose_item(const float* W, int K, int N, const float* gain, bf16_t* WT, int row_off, LAS float* scr, int item, int lane) {
    const int nblk = N / 32, kb = item / nblk, nb = item % nblk, k0 = 64 * kb, n0 = 32 * nb;
#pragma unroll 8
    for (int i = 0; i < 32; ++i) { const int kk = 2 * i + (lane >> 5); float v = W[(size_t)(k0 + kk) * N + n0 + (lane & 31)]; if (gain) v *= gain[k0 + kk]; scr[kk * 33 + (lane & 31)] = v; }
    asm volatile("s_waitcnt lgkmcnt(0)" ::: "memory");
    const int c = lane & 7;
#pragma unroll
    for (int j = 0; j < 4; ++j) { const int n = (lane >> 3) + 8 * j; const LAS float* s = scr + (8 * c) * 33 + n;
        u32x4 o; o.x = cvt_pk_bf16(s[0 * 33], s[1 * 33]); o.y = cvt_pk_bf16(s[2 * 33], s[3 * 33]); o.z = cvt_pk_bf16(s[4 * 33], s[5 * 33]); o.w = cvt_pk_bf16(s[6 * 33], s[7 * 33]);
        *(u32x4*)(WT + (size_t)(row_off + n0 + n) * K + k0 + 8 * c) = o; }
    asm volatile("s_waitcnt lgkmcnt(0)" ::: "memory");
}
__device__ __forceinline__ void rms_row_to_bf16(const float* xrow, bf16_t* orow, int lane) {
    const f32x4* xr = (const f32x4*)xrow + lane;
    f32x4 v[4]; float s = 0.f;
#pragma unroll
    for (int j = 0; j < 4; ++j) { v[j] = xr[64 * j]; s += (v[j][0] * v[j][0] + v[j][1] * v[j][1]) + (v[j][2] * v[j][2] + v[j][3] * v[j][3]); }
    const float rstd = 1.0f / sqrtf(wave_sum(s) * (1.f / 1024.f) + 1e-6f);
    u32x2* o8 = (u32x2*)orow + lane;
#pragma unroll
    for (int j = 0; j < 4; ++j) { u32x2 w; w.x = cvt_pk_bf16(v[j][0] * rstd, v[j][1] * rstd); w.y = cvt_pk_bf16(v[j][2] * rstd, v[j][3] * rstd); o8[64 * j] = w; }
}

__device__ __forceinline__ void phase0(LAS unsigned char* lds) {
    const Args a = load_args(); TIDS();
    unsigned char* ws = a.ws;
    LAS float* scr = (LAS float*)(lds + wave * 16384);
    const int gw = blockIdx.x * NWAVES + wave, NGW = gridDim.x * NWAVES;
    const int gt = blockIdx.x * 512 + tid, NGT = gridDim.x * 512;
    constexpr int I_IN = 16 * 121, I_SQ = 16 * 32, I_KV = 16 * 64, I_UP = 16 * 128, I_DN = 64 * 32;
    constexpr int NITEMS = I_IN + 3 * I_SQ + I_KV + I_UP + I_DN;
    for (int it = gw; it < NITEMS; it += NGW) {
        int r = it;
        if (r < I_IN) { p0_transpose_item((const float*)a.in[I_WIN], D, NIN, (const float*)a.in[I_NMIX], (bf16_t*)(ws + WS_WIN), 0, scr, r, lane); continue; } r -= I_IN;
        if (r < I_UP) { p0_transpose_item((const float*)a.in[I_MUP], D, FF, (const float*)a.in[I_NMLP], (bf16_t*)(ws + WS_WUP), 0, scr, r, lane); continue; } r -= I_UP;
        if (r < I_DN) { p0_transpose_item((const float*)a.in[I_MDN], FF, D, nullptr, (bf16_t*)(ws + WS_WDN), 0, scr, r, lane); continue; } r -= I_DN;
        if (r < I_KV) { p0_transpose_item((const float*)a.in[I_WKV], D, 2 * D, (const float*)a.in[I_NMEM], (bf16_t*)(ws + WS_WKV), 0, scr, r, lane); continue; } r -= I_KV;
        if (r < I_SQ) { p0_transpose_item((const float*)a.in[I_WOUT], D, D, nullptr, (bf16_t*)(ws + WS_WOUT), 0, scr, r, lane); continue; } r -= I_SQ;
        if (r < I_SQ) { p0_transpose_item((const float*)a.in[I_WQ], D, D, (const float*)a.in[I_NXA], (bf16_t*)(ws + WS_WQ), 0, scr, r, lane); continue; } r -= I_SQ;
        p0_transpose_item((const float*)a.in[I_WO], D, D, nullptr, (bf16_t*)(ws + WS_WO), 0, scr, r, lane);
    }
    { u32x4* z = (u32x4*)(ws + WS_WIN + (size_t)NIN * D * 2); const int nz = (NP - NIN) * D * 2 / 16; for (int i = gt; i < nz; i += NGT) z[i] = (u32x4){0u, 0u, 0u, 0u}; }
    { const float* wup = (const float*)a.in[I_WUP]; const float* aup = (const float*)a.in[I_AUP]; const float* gup = (const float*)a.in[I_GUP]; u32x4* LT = (u32x4*)(ws + WS_LORA);
      for (int i = gt; i < LN * (LK / 8); i += NGT) { const int n = i / (LK / 8), k0 = (i % (LK / 8)) * 8; float v[8];
#pragma unroll
          for (int j = 0; j < 8; ++j) { const int k = k0 + j; float x = 0.f;
              if (n < 512) { if (k < 64) x = wup[k * 512 + n]; }
              else if (n < 1024) { if (k >= 64 && k < 128) x = aup[(k - 64) * 512 + (n - 512)]; }
              else { if (k >= 128 && k < 288) x = gup[(k - 128) * 512 + (n - 1024)]; }
              v[j] = x; }
          u32x4 o; o.x = cvt_pk_bf16(v[0], v[1]); o.y = cvt_pk_bf16(v[2], v[3]); o.z = cvt_pk_bf16(v[4], v[5]); o.w = cvt_pk_bf16(v[6], v[7]); LT[i] = o; } }
    for (int m = gw; m < M + MM; m += NGW) {
        if (m < M) rms_row_to_bf16((const float*)a.in[I_X] + (size_t)m * D, (bf16_t*)(ws + WS_ACTA) + (size_t)m * D, lane);
        else rms_row_to_bf16((const float*)a.in[I_MEM] + (size_t)(m - M) * D, (bf16_t*)(ws + WS_MEMN) + (size_t)(m - M) * D, lane);
    }
    { const int* pos = (const int*)a.in[I_POS]; f32x2* T = (f32x2*)(ws + WS_ROPE);
      for (int i = gt; i < M * 32; i += NGT) { const int m = i >> 5, f = i & 31;
          const float inv = (float)exp2(-(double)f * (13.287712379549449 / 32.0));
          const float ang = (float)pos[m] * inv;
          double rev = (double)ang * 0.15915494309189535; rev -= rint(rev);
          const float rv = (float)rev;
          T[i] = (f32x2){__builtin_amdgcn_cosf(rv), __builtin_amdgcn_sinf(rv)}; } }
}

__device__ __forceinline__ void phase_lora_in() {
    const Args a = load_args(); TIDS();
    const bf16_t* P = (const bf16_t*)(a.ws + WS_P); bf16_t* L = (bf16_t*)(a.ws + WS_ACTB); const float* mu = (const float*)a.in[I_MU] + 1536;
    const int gt = blockIdx.x * 512 + tid, NGT = gridDim.x * 512;
    for (int i = gt; i < M * (LK / 8); i += NGT) { const int m = i / (LK / 8), c8 = i % (LK / 8), c = 8 * c8; u32x4 o = (u32x4){0u, 0u, 0u, 0u};
        if (c < 288) { const u32x4 cur = *(const u32x4*)(P + (size_t)m * NP + C_LORA + c); u32x4 prv = (u32x4){0u, 0u, 0u, 0u}; if ((m & (SEQ - 1)) != 0) prv = *(const u32x4*)(P + (size_t)(m - 1) * NP + C_LORA + c);
            const f32x4 mu0 = *(const f32x4*)(mu + c), mu1 = *(const f32x4*)(mu + c + 4); float v[8];
#pragma unroll
            for (int j = 0; j < 4; ++j) { const float c0 = bflo(cur[j]), c1 = bfhi(cur[j]), p0 = bflo(prv[j]), p1 = bfhi(prv[j]); const float m0 = j < 2 ? mu0[2 * j] : mu1[2 * j - 4], m1 = j < 2 ? mu0[2 * j + 1] : mu1[2 * j - 3];
                v[2 * j] = c0 + (p0 - c0) * m0; v[2 * j + 1] = c1 + (p1 - c1) * m1; }
            if (c < 64) {
#pragma unroll
                for (int j = 0; j < 8; ++j) v[j] = tanhf(v[j]); }
            else if (c >= 128) {
#pragma unroll
                for (int j = 0; j < 8; ++j) v[j] = sigmoidf_(v[j]); }
            o.x = cvt_pk_bf16(v[0], v[1]); o.y = cvt_pk_bf16(v[2], v[3]); o.z = cvt_pk_bf16(v[4], v[5]); o.w = cvt_pk_bf16(v[6], v[7]); }
        *(u32x4*)(L + (size_t)m * LK + c) = o; }
}

typedef short bf16x4 __attribute__((ext_vector_type(4)));
template <int CTRL> __device__ __forceinline__ float dpp_add(float v) { return v + __builtin_bit_cast(float, __builtin_amdgcn_update_dpp(0, __builtin_bit_cast(int, v), CTRL, 0xf, 0xf, false)); }
__device__ __forceinline__ float red16(float v) { v = dpp_add<0xB1>(v); v = dpp_add<0x4E>(v); v = dpp_add<0x141>(v); v = dpp_add<0x140>(v); return v; }
__device__ __forceinline__ float wave_sum_fast(float v) { v = red16(v);
    const int iv = __builtin_bit_cast(int, v);
    return (__builtin_bit_cast(float, __builtin_amdgcn_readlane(iv, 0)) + __builtin_bit_cast(float, __builtin_amdgcn_readlane(iv, 16))) + (__builtin_bit_cast(float, __builtin_amdgcn_readlane(iv, 32)) + __builtin_bit_cast(float, __builtin_amdgcn_readlane(iv, 48))); }
__device__ __forceinline__ bf16x4 pack4(const f32x4 v) { u32x2 w; w.x = cvt_pk_bf16(v[0], v[1]); w.y = cvt_pk_bf16(v[2], v[3]); return __builtin_bit_cast(bf16x4, w); }
__device__ __forceinline__ bf16x8 pack8(const f32x4 a, const f32x4 b) { u32x4 w; w.x = cvt_pk_bf16(a[0], a[1]); w.y = cvt_pk_bf16(a[2], a[3]); w.z = cvt_pk_bf16(b[0], b[1]); w.w = cvt_pk_bf16(b[2], b[3]); return __builtin_bit_cast(bf16x8, w); }
__device__ __forceinline__ unsigned short f2bf(float v) { return (unsigned short)(cvt_pk_bf16(v, 0.f) & 0xffffu); }

__device__ __forceinline__ void rwkv_chunk_wg(LAS unsigned char* lds, int bh) {
    const Args a = load_args(); TIDS();
    const int b = bh >> 3, h = bh & 7;
    constexpr int RS = 144;
    constexpr int SLOT = 13120, O_AT = 0, O_RT = 2304, O_BHT = 4608, O_KHT = 6656, O_VT = 8704, O_CAK = 10752, O_TT = 11264, O_CBR = 11776, O_CKR = 12288, O_PL = 12800, O_RKB = 13056;
    constexpr int SCR0 = 8 * SLOT, SCR = 5632, O_BT = 0, O_KT = 2304, O_NF = 4608, O_RK = 0  ;
    constexpr int STAT0 = SCR0 + 4 * SCR;
    static_assert(STAT0 + 4096 <= 131072 + 512, "rwkv LDS map (the barrier set-up words sit at 131072 + 512)");
    constexpr int NCH = SEQ / 16, NST = NCH / 4;
    const size_t m0 = (size_t)b * SEQ;
    const int li = lane & 15, lq = lane >> 4;
    if (wave < 4) {
        const int rt = wave, vch = 64 * h + 16 * rt + li;
        const bf16_t* GG = (const bf16_t*)((const unsigned char*)a.out + DO_GG); bf16_t* Y = (bf16_t*)(a.ws + WS_ACTA);
        const float gw = ((const float*)a.in[I_WGNW])[vch], gb = ((const float*)a.in[I_WGNB])[vch];
        f32x4 S[4];
#pragma unroll
        for (int kt = 0; kt < 4; ++kt) S[kt] = (f32x4){0.f, 0.f, 0.f, 0.f};
        const f32x4 zero4 = (f32x4){0.f, 0.f, 0.f, 0.f};
        f32x4 ys[4], rkbs[4]; bf16x4 vts[4];
#pragma unroll
        for (int q = 0; q < 4; ++q) { ys[q] = zero4; rkbs[q] = zero4; vts[q] = (bf16x4){0, 0, 0, 0}; }
        for (int g = 0; g <= NST + 1; ++g) {
            unsigned short gs[4][4];
            if (g >= 2) {
#pragma unroll
                for (int q = 0; q < 4; ++q) { const bf16_t* gp = GG + (m0 + 16 * (4 * (g - 2) + q) + 4 * lq) * 512 + vch;
#pragma unroll
                    for (int r = 0; r < 4; ++r) gs[q][r] = gp[r * 512]; }
            } else {
#pragma unroll
                for (int q = 0; q < 4; ++q)
#pragma unroll
                    for (int r = 0; r < 4; ++r) gs[q][r] = 0;
            }
            f32x4 yn[4], rkbn[4]; bf16x4 vtn[4];
#pragma unroll
            for (int q = 0; q < 4; ++q) { yn[q] = zero4; rkbn[q] = zero4; vtn[q] = (bf16x4){0, 0, 0, 0}; }
            if (g >= 1 && g <= NST) {
#pragma unroll
                for (int q = 0; q < 4; ++q) {
                    LAS unsigned char* sl = lds + (((g - 1) & 1) * 4 + q) * SLOT;
                    const bf16x8 sf0 = pack8(S[0], S[1]), sf1 = pack8(S[2], S[3]);
                    const bf16x8 a0 = *(const LAS bf16x8*)(sl + O_AT + li * RS + 16 * lq), a1 = *(const LAS bf16x8*)(sl + O_AT + li * RS + 64 + 16 * lq);
                    const bf16x8 r0 = *(const LAS bf16x8*)(sl + O_RT + li * RS + 16 * lq), r1 = *(const LAS bf16x8*)(sl + O_RT + li * RS + 64 + 16 * lq);
                    const bf16x4 cak = *(const LAS bf16x4*)(sl + O_CAK + li * 32 + 8 * lq), tt = *(const LAS bf16x4*)(sl + O_TT + li * 32 + 8 * lq);
                    const bf16x4 cbr = *(const LAS bf16x4*)(sl + O_CBR + li * 32 + 8 * lq), ckr = *(const LAS bf16x4*)(sl + O_CKR + li * 32 + 8 * lq);
                    const bf16x4 vt = *(const LAS bf16x4*)(sl + O_VT + (16 * rt + li) * 32 + 8 * lq);
                    rkbn[q] = *(const LAS f32x4*)(sl + O_RKB + 16 * lq);
                    f32x4 z = __builtin_amdgcn_mfma_f32_16x16x32_bf16(a0, sf0, zero4, 0, 0, 0); z = __builtin_amdgcn_mfma_f32_16x16x32_bf16(a1, sf1, z, 0, 0, 0);
                    z = __builtin_amdgcn_mfma_f32_16x16x16bf16_1k(cak, vt, z, 0, 0, 0);
                    const bf16x4 zf = pack4(z);
                    const f32x4 u = __builtin_amdgcn_mfma_f32_16x16x16bf16_1k(tt, zf, zero4, 0, 0, 0);
                    const bf16x4 uf = pack4(u);
                    f32x4 y = __builtin_amdgcn_mfma_f32_16x16x32_bf16(r0, sf0, zero4, 0, 0, 0); y = __builtin_amdgcn_mfma_f32_16x16x32_bf16(r1, sf1, y, 0, 0, 0);
                    y = __builtin_amdgcn_mfma_f32_16x16x16bf16_1k(ckr, vt, y, 0, 0, 0); y = __builtin_amdgcn_mfma_f32_16x16x16bf16_1k(cbr, uf, y, 0, 0, 0);
#pragma unroll
                    for (int kt = 0; kt < 4; ++kt) { const f32x4 pl = *(const LAS f32x4*)(sl + O_PL + (16 * kt + 4 * lq) * 4);
                        const bf16x4 bhf = *(const LAS bf16x4*)(sl + O_BHT + (16 * kt + li) * 32 + 8 * lq), khf = *(const LAS bf16x4*)(sl + O_KHT + (16 * kt + li) * 32 + 8 * lq);
                        f32x4 acc = S[kt] * pl; acc = __builtin_amdgcn_mfma_f32_16x16x16bf16_1k(khf, vt, acc, 0, 0, 0); acc = __builtin_amdgcn_mfma_f32_16x16x16bf16_1k(bhf, uf, acc, 0, 0, 0); S[kt] = acc; }
                    yn[q] = y; vtn[q] = vt;
                    LAS float* st = (LAS float*)(lds + STAT0 + (g & 1) * 2048 + q * 512);
#pragma unroll
                    for (int r = 0; r < 4; ++r) { const float s1 = red16(y[r]), s2 = red16(y[r] * y[r]); if (li == 0) { f32x2 w2 = {s1, s2}; *(LAS f32x2*)(st + (4 * lq + r) * 8 + 2 * rt) = w2; } }
                }
            }
            if (g >= 2) {
#pragma unroll
                for (int q = 0; q < 4; ++q) { const int c = 4 * (g - 2) + q; const LAS float* st = (const LAS float*)(lds + STAT0 + ((g - 1) & 1) * 2048 + q * 512);
#pragma unroll
                    for (int r = 0; r < 4; ++r) { const int t = 4 * lq + r; const f32x4 p0 = *(const LAS f32x4*)(st + t * 8), p1 = *(const LAS f32x4*)(st + t * 8 + 4);
                        const float mean = ((p0[0] + p0[2]) + (p1[0] + p1[2])) * (1.f / 64.f), ex2 = ((p0[1] + p0[3]) + (p1[1] + p1[3])) * (1.f / 64.f);
                        const float rstd = __builtin_amdgcn_rsqf(fmaxf(ex2 - mean * mean, 0.f) + 64e-5f);
                        const float vv = bf2f((unsigned short)vts[q][r]);
                        const float o = ((ys[q][r] - mean) * rstd * gw + gb + rkbs[q][r] * vv) * bf2f(gs[q][r]);
                        Y[(m0 + 16 * c + t) * D + 512 + vch] = f2bf(o); } }
            }
#pragma unroll
            for (int q = 0; q < 4; ++q) { ys[q] = yn[q]; rkbs[q] = rkbn[q]; vts[q] = vtn[q]; }
            __syncthreads();
        }
    } else {
        const int pw = wave - 4, ci = 64 * h + lane;
        const bf16_t* P = (const bf16_t*)(a.ws + WS_P);
        const float* LW = (const float*)((const unsigned char*)a.out + DO_LW); const bf16_t* ASIG = (const bf16_t*)((const unsigned char*)a.out + DO_ASIG);
        const float* mu = (const float*)a.in[I_MU];
        const float mu_r = mu[ci], mu_k = mu[512 + ci], mu_v = mu[1024 + ci], kkc = ((const float*)a.in[I_KK])[ci], kac = ((const float*)a.in[I_KA])[ci], rkc = ((const float*)a.in[I_RK])[ci];
        const int kpos = (lane & 32) + 8 * ((lane >> 2) & 3) + 4 * ((lane >> 4) & 1) + (lane & 3);
        LAS unsigned char* scr = lds + SCR0 + pw * SCR;
        unsigned short x_r[16], x_k[16], x_v[16], x_a[16]; float x_w[16]; unsigned short p_r, p_k, p_v;
#define RW_LOAD(c) do { const size_t mb = m0 + 16 * (c); const bf16_t* pc = P + mb * NP + C_RK + ci; \
        _Pragma("unroll") for (int t = 0; t < 16; ++t) { x_r[t] = pc[(size_t)t * NP]; x_k[t] = pc[(size_t)t * NP + 512]; x_v[t] = pc[(size_t)t * NP + 1024]; x_a[t] = ASIG[(mb + t) * 512 + ci]; x_w[t] = LW[(mb + t) * 512 + ci]; } \
        if ((c) > 0) { p_r = pc[-NP]; p_k = pc[512 - NP]; p_v = pc[1024 - NP]; } else { p_r = 0; p_k = 0; p_v = 0; } } while (0)
        RW_LOAD(pw);
        for (int g = 0; g <= NST + 1; ++g) {
            if (g < NST) {
                const int c = 4 * g + pw; LAS unsigned char* sl = lds + ((g & 1) * 4 + pw) * SLOT;
                float Bt[16], Kt[16], Vv[16], Rk[16];
                float cum = 0.f, ecp = 1.f, prr = bf2f(p_r), prk = bf2f(p_k), prv = bf2f(p_v);
#pragma unroll
                for (int t = 0; t < 16; ++t) {
                    const float cr = bf2f(x_r[t]), ck = bf2f(x_k[t]), cv = bf2f(x_v[t]);
                    const float r = cr + (prr - cr) * mu_r, k0 = ck + (prk - ck) * mu_k, v = cv + (prv - cv) * mu_v; prr = cr; prk = ck; prv = cv;
                    const float asg = bf2f(x_a[t]); const float kkr = k0 * kkc; const float kk = kkr * __builtin_amdgcn_rsqf(fmaxf(wave_sum_fast(kkr * kkr), 1e-24f));
                    const float kx = k0 * (1.0f + (asg - 1.0f) * kac), bb = kk * asg;
                    cum += x_w[t]; const float ec = __expf(cum), eci = __builtin_amdgcn_rcpf(ec);
                    const float at = -kk * ecp, bt = bb * eci, kt = kx * eci, rtl = r * ec; ecp = ec;
                    *(LAS unsigned short*)(sl + O_AT + t * RS + 2 * kpos) = f2bf(at); *(LAS unsigned short*)(sl + O_RT + t * RS + 2 * kpos) = f2bf(rtl);
                    *(LAS unsigned short*)(scr + O_BT + t * RS + 2 * kpos) = f2bf(bt); *(LAS unsigned short*)(scr + O_KT + t * RS + 2 * kpos) = f2bf(kt);
                    Bt[t] = bt; Kt[t] = kt; Vv[t] = v; Rk[t] = rtl * rkc;
                }
                const float pl = ecp;
                *(LAS float*)(sl + O_PL + 4 * lane) = pl;
                { u32x4 w0, w1;
                  w0.x = cvt_pk_bf16(Bt[0] * pl, Bt[1] * pl); w0.y = cvt_pk_bf16(Bt[2] * pl, Bt[3] * pl); w0.z = cvt_pk_bf16(Bt[4] * pl, Bt[5] * pl); w0.w = cvt_pk_bf16(Bt[6] * pl, Bt[7] * pl);
                  w1.x = cvt_pk_bf16(Bt[8] * pl, Bt[9] * pl); w1.y = cvt_pk_bf16(Bt[10] * pl, Bt[11] * pl); w1.z = cvt_pk_bf16(Bt[12] * pl, Bt[13] * pl); w1.w = cvt_pk_bf16(Bt[14] * pl, Bt[15] * pl);
                  *(LAS u32x4*)(sl + O_BHT + lane * 32) = w0; *(LAS u32x4*)(sl + O_BHT + lane * 32 + 16) = w1;
                  w0.x = cvt_pk_bf16(Kt[0] * pl, Kt[1] * pl); w0.y = cvt_pk_bf16(Kt[2] * pl, Kt[3] * pl); w0.z = cvt_pk_bf16(Kt[4] * pl, Kt[5] * pl); w0.w = cvt_pk_bf16(Kt[6] * pl, Kt[7] * pl);
                  w1.x = cvt_pk_bf16(Kt[8] * pl, Kt[9] * pl); w1.y = cvt_pk_bf16(Kt[10] * pl, Kt[11] * pl); w1.z = cvt_pk_bf16(Kt[12] * pl, Kt[13] * pl); w1.w = cvt_pk_bf16(Kt[14] * pl, Kt[15] * pl);
                  *(LAS u32x4*)(sl + O_KHT + lane * 32) = w0; *(LAS u32x4*)(sl + O_KHT + lane * 32 + 16) = w1;
                  w0.x = cvt_pk_bf16(Vv[0], Vv[1]); w0.y = cvt_pk_bf16(Vv[2], Vv[3]); w0.z = cvt_pk_bf16(Vv[4], Vv[5]); w0.w = cvt_pk_bf16(Vv[6], Vv[7]);
                  w1.x = cvt_pk_bf16(Vv[8], Vv[9]); w1.y = cvt_pk_bf16(Vv[10], Vv[11]); w1.z = cvt_pk_bf16(Vv[12], Vv[13]); w1.w = cvt_pk_bf16(Vv[14], Vv[15]);
                  *(LAS u32x4*)(sl + O_VT + lane * 32) = w0; *(LAS u32x4*)(sl + O_VT + lane * 32 + 16) = w1; }
                if (g + 1 < NST) RW_LOAD(c + 4);
                const bf16x8 af0 = *(const LAS bf16x8*)(sl + O_AT + li * RS + 16 * lq), af1 = *(const LAS bf16x8*)(sl + O_AT + li * RS + 64 + 16 * lq);
                const bf16x8 rf0 = *(const LAS bf16x8*)(sl + O_RT + li * RS + 16 * lq), rf1 = *(const LAS bf16x8*)(sl + O_RT + li * RS + 64 + 16 * lq);
                const bf16x8 bf0 = *(const LAS bf16x8*)(scr + O_BT + li * RS + 16 * lq), bf1 = *(const LAS bf16x8*)(scr + O_BT + li * RS + 64 + 16 * lq);
                const bf16x8 kf0 = *(const LAS bf16x8*)(scr + O_KT + li * RS + 16 * lq), kf1 = *(const LAS bf16x8*)(scr + O_KT + li * RS + 64 + 16 * lq);
                const f32x4 zero4 = (f32x4){0.f, 0.f, 0.f, 0.f};
                f32x4 nn = __builtin_amdgcn_mfma_f32_16x16x32_bf16(bf0, af0, zero4, 0, 0, 0); nn = __builtin_amdgcn_mfma_f32_16x16x32_bf16(bf1, af1, nn, 0, 0, 0);
                f32x4 ca = __builtin_amdgcn_mfma_f32_16x16x32_bf16(kf0, af0, zero4, 0, 0, 0); ca = __builtin_amdgcn_mfma_f32_16x16x32_bf16(kf1, af1, ca, 0, 0, 0);
                f32x4 cb = __builtin_amdgcn_mfma_f32_16x16x32_bf16(bf0, rf0, zero4, 0, 0, 0); cb = __builtin_amdgcn_mfma_f32_16x16x32_bf16(bf1, rf1, cb, 0, 0, 0);
                f32x4 ck = __builtin_amdgcn_mfma_f32_16x16x32_bf16(kf0, rf0, zero4, 0, 0, 0); ck = __builtin_amdgcn_mfma_f32_16x16x32_bf16(kf1, rf1, ck, 0, 0, 0);
#pragma unroll
                for (int t = 0; t < 16; ++t) *(LAS unsigned short*)(scr + O_RK + t * RS + 2 * kpos) = f2bf(Rk[t]);
                const bf16x8 qf0 = *(const LAS bf16x8*)(scr + O_RK + li * RS + 16 * lq), qf1 = *(const LAS bf16x8*)(scr + O_RK + li * RS + 64 + 16 * lq);
                f32x4 dk = __builtin_amdgcn_mfma_f32_16x16x32_bf16(kf0, qf0, zero4, 0, 0, 0); dk = __builtin_amdgcn_mfma_f32_16x16x32_bf16(kf1, qf1, dk, 0, 0, 0);
                if (lq == (li >> 2)) { const int e = li & 3; *(LAS float*)(sl + O_RKB + 4 * li) = e == 0 ? dk[0] : (e == 1 ? dk[1] : (e == 2 ? dk[2] : dk[3])); }
#pragma unroll
                for (int r = 0; r < 4; ++r) { const int i = 4 * lq + r; const bool lt = i < li, le = i <= li;
                    nn[r] = lt ? nn[r] : 0.f; ca[r] = lt ? ca[r] : 0.f; cb[r] = le ? cb[r] : 0.f; ck[r] = le ? ck[r] : 0.f;
                    *(LAS float*)(scr + O_NF + (i * 16 + li) * 4) = nn[r]; }
                *(LAS bf16x4*)(sl + O_CAK + li * 32 + 8 * lq) = pack4(ca); *(LAS bf16x4*)(sl + O_CBR + li * 32 + 8 * lq) = pack4(cb); *(LAS bf16x4*)(sl + O_CKR + li * 32 + 8 * lq) = pack4(ck);
                { float T[16]; int li2 = li; asm volatile("" : "+v"(li2));
#pragma unroll
                  for (int t = 0; t < 16; ++t) T[t] = (t == li2) ? 1.f : 0.f;
#pragma unroll
                  for (int j = 0; j < 15; ++j) {
#pragma unroll
                      for (int t4 = (j + 1) / 4; t4 < 4; ++t4) { const f32x4 nr = *(const LAS f32x4*)(scr + O_NF + (j * 16 + 4 * t4) * 4);
#pragma unroll
                          for (int e = 0; e < 4; ++e) { const int t = 4 * t4 + e; if (t > j) T[t] += T[j] * nr[e]; } } }
                  if (lane < 16) {
#pragma unroll
                      for (int t = 0; t < 16; ++t) *(LAS unsigned short*)(sl + O_TT + (t * 16 + lane) * 2) = f2bf(T[t]); } }
            }
            __syncthreads();
        }
#undef RW_LOAD
    }
}

__device__ __forceinline__ void retention_wg(LAS unsigned char* lds, int bh) {
    const Args a = load_args(); TIDS();
    const int b = bh >> 3, h = bh & 7;
    constexpr int QS_ = 72, TS_ = 136;
    LAS bf16_t* Qs = (LAS bf16_t*)lds;
    LAS bf16_t* Ks = Qs + 128 * QS_;
    LAS bf16_t* KzT = Ks + 128 * QS_;
    LAS bf16_t* VT = KzT + 64 * TS_;
    LAS bf16_t* Ps = VT + 64 * TS_;
    LAS bf16_t* RT = Ps + 128 * TS_;
    const bf16_t* P = (const bf16_t*)(a.ws + WS_P); const f32x2* ROPE = (const f32x2*)(a.ws + WS_ROPE); bf16_t* Y = (bf16_t*)(a.ws + WS_ACTA);
    const float* gnw = (const float*)a.in[I_RGNW]; const float* gnb = (const float*)a.in[I_RGNB];
    const float lg2 = log2f(1.0f - exp2f(-5.0f - (float)h));
    const float gch = exp2f(128.0f * lg2);
    for (int i = tid; i < 64 * QS_ / 2; i += 512) ((LAS unsigned*)RT)[i] = 0u;
    const int tk = tid >> 2, qd = tid & 3;
    const float zeta = exp2f((float)(127 - tk) * lg2);
    const int li = lane & 15, lq = lane >> 4, i0 = 16 * wave;
    const float xi = exp2f((float)(i0 + li + 1) * lg2);
    f32x4 Rst[2]; Rst[0] = (f32x4){0.f, 0.f, 0.f, 0.f}; Rst[1] = Rst[0];
    u32x4 gq1, gq2, gk1, gk2, gv1, gv2; f32x4 gr[4];
#define RT_LOAD(n) do { const size_t m = (size_t)b * SEQ + (n) * 128 + tk; const bf16_t* pr = P + m * NP + 64 * h; \
        gq1 = *(const u32x4*)(pr + 8 * qd); gq2 = *(const u32x4*)(pr + 32 + 8 * qd); gk1 = *(const u32x4*)(pr + 512 + 8 * qd); gk2 = *(const u32x4*)(pr + 544 + 8 * qd); \
        gv1 = *(const u32x4*)(pr + 1024 + 16 * qd); gv2 = *(const u32x4*)(pr + 1032 + 16 * qd); \
        const f32x4* rp = (const f32x4*)(ROPE + m * 32 + 8 * qd); gr[0] = rp[0]; gr[1] = rp[1]; gr[2] = rp[2]; gr[3] = rp[3]; } while (0)
    RT_LOAD(0);
    for (int n = 0; n < SEQ / 128; ++n) {
        { float q1[8], q2[8], k1[8], k2[8];
#pragma unroll
          for (int j = 0; j < 4; ++j) { q1[2 * j] = bflo(gq1[j]); q1[2 * j + 1] = bfhi(gq1[j]); q2[2 * j] = bflo(gq2[j]); q2[2 * j + 1] = bfhi(gq2[j]);
              k1[2 * j] = bflo(gk1[j]); k1[2 * j + 1] = bfhi(gk1[j]); k2[2 * j] = bflo(gk2[j]); k2[2 * j + 1] = bfhi(gk2[j]); }
          float oq1[8], oq2[8], ok1[8], ok2[8];
#pragma unroll
          for (int j = 0; j < 8; ++j) { const float cs = gr[j >> 1][2 * (j & 1)], sn = gr[j >> 1][2 * (j & 1) + 1];
              oq1[j] = q1[j] * cs - q2[j] * sn; oq2[j] = q2[j] * cs + q1[j] * sn;
              ok1[j] = (k1[j] * cs - k2[j] * sn) * 0.125f; ok2[j] = (k2[j] * cs + k1[j] * sn) * 0.125f; }
          u32x4 w;
          w.x = cvt_pk_bf16(oq1[0], oq1[1]); w.y = cvt_pk_bf16(oq1[2], oq1[3]); w.z = cvt_pk_bf16(oq1[4], oq1[5]); w.w = cvt_pk_bf16(oq1[6], oq1[7]); *(LAS u32x4*)(Qs + tk * QS_ + 8 * qd) = w;
          w.x = cvt_pk_bf16(oq2[0], oq2[1]); w.y = cvt_pk_bf16(oq2[2], oq2[3]); w.z = cvt_pk_bf16(oq2[4], oq2[5]); w.w = cvt_pk_bf16(oq2[6], oq2[7]); *(LAS u32x4*)(Qs + tk * QS_ + 32 + 8 * qd) = w;
          w.x = cvt_pk_bf16(ok1[0], ok1[1]); w.y = cvt_pk_bf16(ok1[2], ok1[3]); w.z = cvt_pk_bf16(ok1[4], ok1[5]); w.w = cvt_pk_bf16(ok1[6], ok1[7]); *(LAS u32x4*)(Ks + tk * QS_ + 8 * qd) = w;
          w.x = cvt_pk_bf16(ok2[0], ok2[1]); w.y = cvt_pk_bf16(ok2[2], ok2[3]); w.z = cvt_pk_bf16(ok2[4], ok2[5]); w.w = cvt_pk_bf16(ok2[6], ok2[7]); *(LAS u32x4*)(Ks + tk * QS_ + 32 + 8 * qd) = w;
#pragma unroll
          for (int j = 0; j < 8; ++j) { KzT[(8 * qd + j) * TS_ + tk] = (bf16_t)(cvt_pk_bf16(ok1[j] * zeta, 0.f) & 0xffffu); KzT[(32 + 8 * qd + j) * TS_ + tk] = (bf16_t)(cvt_pk_bf16(ok2[j] * zeta, 0.f) & 0xffffu); }
#pragma unroll
          for (int j = 0; j < 4; ++j) { VT[(16 * qd + 2 * j) * TS_ + tk] = (bf16_t)(gv1[j] & 0xffffu); VT[(16 * qd + 2 * j + 1) * TS_ + tk] = (bf16_t)(gv1[j] >> 16);
              VT[(16 * qd + 8 + 2 * j) * TS_ + tk] = (bf16_t)(gv2[j] & 0xffffu); VT[(16 * qd + 8 + 2 * j + 1) * TS_ + tk] = (bf16_t)(gv2[j] >> 16); } }
        if (n + 1 < SEQ / 128) RT_LOAD(n + 1);
        __syncthreads();
        bf16x8 qf[2];
        qf[0] = *(const LAS bf16x8*)(Qs + (i0 + li) * QS_ + 8 * lq); qf[1] = *(const LAS bf16x8*)(Qs + (i0 + li) * QS_ + 32 + 8 * lq);
        const int nks = (wave + 2) >> 1;
        for (int jt = 0; jt < 2 * nks; ++jt) {
            f32x4 s = (f32x4){0.f, 0.f, 0.f, 0.f};
            if (jt <= wave) {
                const bf16x8 kf0 = *(const LAS bf16x8*)(Ks + (16 * jt + li) * QS_ + 8 * lq), kf1 = *(const LAS bf16x8*)(Ks + (16 * jt + li) * QS_ + 32 + 8 * lq);
                s = __builtin_amdgcn_mfma_f32_16x16x32_bf16(kf0, qf[0], s, 0, 0, 0); s = __builtin_amdgcn_mfma_f32_16x16x32_bf16(kf1, qf[1], s, 0, 0, 0);
#pragma unroll
                for (int r = 0; r < 4; ++r) { const int dj = (i0 + li) - (16 * jt + 4 * lq + r); s[r] = dj >= 0 ? s[r] * exp2f((float)dj * lg2) : 0.f; }
            }
            u32x2 w; w.x = cvt_pk_bf16(s[0], s[1]); w.y = cvt_pk_bf16(s[2], s[3]);
            *(LAS u32x2*)(Ps + (i0 + li) * TS_ + 16 * jt + 4 * lq) = w;
        }
        f32x4 ai_[4], ax_[4];
#pragma unroll
        for (int et = 0; et < 4; ++et) { ai_[et] = (f32x4){0.f, 0.f, 0.f, 0.f}; ax_[et] = (f32x4){0.f, 0.f, 0.f, 0.f}; }
        for (int kk = 0; kk < nks; ++kk) { const bf16x8 pf = *(const LAS bf16x8*)(Ps + (i0 + li) * TS_ + 32 * kk + 8 * lq);
#pragma unroll
            for (int et = 0; et < 4; ++et) { const bf16x8 vf = *(const LAS bf16x8*)(VT + (16 * et + li) * TS_ + 32 * kk + 8 * lq); ai_[et] = __builtin_amdgcn_mfma_f32_16x16x32_bf16(vf, pf, ai_[et], 0, 0, 0); } }
#pragma unroll
        for (int kk = 0; kk < 2; ++kk)
#pragma unroll
            for (int et = 0; et < 4; ++et) { const bf16x8 rf = *(const LAS bf16x8*)(RT + (16 * et + li) * QS_ + 32 * kk + 8 * lq); ax_[et] = __builtin_amdgcn_mfma_f32_16x16x32_bf16(rf, qf[kk], ax_[et], 0, 0, 0); }
#pragma unroll
        for (int t2 = 0; t2 < 2; ++t2) { const int id = 2 * wave + t2, dt = id >> 2, et = id & 3; f32x4 kv = (f32x4){0.f, 0.f, 0.f, 0.f};
#pragma unroll
            for (int kk = 0; kk < 4; ++kk) { const bf16x8 kz = *(const LAS bf16x8*)(KzT + (16 * dt + li) * TS_ + 32 * kk + 8 * lq), vf = *(const LAS bf16x8*)(VT + (16 * et + li) * TS_ + 32 * kk + 8 * lq);
                kv = __builtin_amdgcn_mfma_f32_16x16x32_bf16(kz, vf, kv, 0, 0, 0); }
            Rst[t2] = Rst[t2] * gch + kv; }
        __syncthreads();
#pragma unroll
        for (int t2 = 0; t2 < 2; ++t2) { const int id = 2 * wave + t2, dt = id >> 2, et = id & 3; u32x2 w; w.x = cvt_pk_bf16(Rst[t2][0], Rst[t2][1]); w.y = cvt_pk_bf16(Rst[t2][2], Rst[t2][3]);
            *(LAS u32x2*)(RT + (16 * et + li) * QS_ + 16 * dt + 4 * lq) = w; }
        { float y[4][4]; float s = 0.f;
#pragma unroll
          for (int et = 0; et < 4; ++et)
#pragma unroll
              for (int r = 0; r < 4; ++r) { y[et][r] = ai_[et][r] + xi * ax_[et][r]; s += y[et][r]; }
          s += __shfl_xor(s, 16); s += __shfl_xor(s, 32); const float mean = s * (1.f / 64.f); float q = 0.f;
#pragma unroll
          for (int et = 0; et < 4; ++et)
#pragma unroll
              for (int r = 0; r < 4; ++r) { const float d = y[et][r] - mean; q += d * d; }
          q += __shfl_xor(q, 16); q += __shfl_xor(q, 32); const float rstd = 1.0f / sqrtf(q * (1.f / 64.f) + 1e-5f);
          const size_t m = (size_t)b * SEQ + n * 128 + i0 + li;
#pragma unroll
          for (int et = 0; et < 4; ++et) { const int e0 = 64 * h + 16 * et + 4 * lq; const u32x2 g2 = *(const u32x2*)(P + m * NP + 1536 + e0);
              const f32x4 gw4 = *(const f32x4*)(gnw + e0), gb4 = *(const f32x4*)(gnb + e0); float o[4];
              const float gg[4] = {bflo(g2.x), bfhi(g2.x), bflo(g2.y), bfhi(g2.y)};
#pragma unroll
              for (int r = 0; r < 4; ++r) { const float gn = (y[et][r] - mean) * rstd * gw4[r] + gb4[r]; o[r] = gg[r] * sigmoidf_(gg[r]) * gn; }
              u32x2 w; w.x = cvt_pk_bf16(o[0], o[1]); w.y = cvt_pk_bf16(o[2], o[3]); *(u32x2*)(Y + m * D + e0) = w; } }
    }
#undef RT_LOAD
}

__device__ __forceinline__ void phase_rwkv_fin() {
    const Args a = load_args(); TIDS();
    const bf16_t* P = (const bf16_t*)(a.ws + WS_P); const float* YRAW = (const float*)(a.ws + WS_ACTB); bf16_t* Y = (bf16_t*)(a.ws + WS_ACTA);
    const bf16_t* ASIG = (const bf16_t*)((const unsigned char*)a.out + DO_ASIG); const bf16_t* GG = (const bf16_t*)((const unsigned char*)a.out + DO_GG);
    const float* mu = (const float*)a.in[I_MU]; const float* ka = (const float*)a.in[I_KA]; const float* rk = (const float*)a.in[I_RK];
    const float* gnw = (const float*)a.in[I_WGNW]; const float* gnb = (const float*)a.in[I_WGNB];
    const int gw = blockIdx.x * NWAVES + wave, NGW = gridDim.x * NWAVES;
    for (int it = gw; it < M * 8; it += NGW) { const int m = it >> 3, h = it & 7, ci = 64 * h + lane;
        const float y = YRAW[(size_t)m * 512 + ci];
        const float mean = wave_sum(y) * (1.f / 64.f); const float d = y - mean; const float var = wave_sum(d * d) * (1.f / 64.f);
        const float yn = d * (1.0f / sqrtf(var + 64e-5f)) * gnw[ci] + gnb[ci];
        const bf16_t* pc = P + (size_t)m * NP + C_RK + ci;
        const float cr = bf2f(pc[0]), ck = bf2f(pc[512]), cv = bf2f(pc[1024]); float pr = 0.f, pk = 0.f, pv = 0.f;
        if ((m & (SEQ - 1)) != 0) { pr = bf2f(pc[-NP]); pk = bf2f(pc[512 - NP]); pv = bf2f(pc[1024 - NP]); }
        const float r = cr + (pr - cr) * mu[ci], k0 = ck + (pk - ck) * mu[512 + ci], v = cv + (pv - cv) * mu[1024 + ci];
        const float asg = bf2f(ASIG[(size_t)m * 512 + ci]); const float kx = k0 * (1.0f + (asg - 1.0f) * ka[ci]);
        const float bonus = wave_sum(r * kx * rk[ci]) * v;
        const float g = bf2f(GG[(size_t)m * 512 + ci]);
        Y[(size_t)m * D + 512 + ci] = (bf16_t)(cvt_pk_bf16((yn + bonus) * g, 0.f) & 0xffffu); }
}

#define XB_TMO      128
#define XB_XCNT(j)  (256  + 64 * (j))
#define XB_XSUB(j)  (1280 + 64 * (j))
#define XB_XGEN(j)  (2304 + 64 * (j))
#define XB_TOP      3328
#define XB_TOPGEN   3392
#define XCD_BAR_WORDS 3456
#define XB_SPIN_CAP (1u << 18)
__device__ __forceinline__ unsigned xb_ld(unsigned* p)              { return __hip_atomic_load(p, __ATOMIC_RELAXED, __HIP_MEMORY_SCOPE_AGENT); }
__device__ __forceinline__ unsigned xb_add(unsigned* p, unsigned v) { return __hip_atomic_fetch_add(p, v, __ATOMIC_RELAXED, __HIP_MEMORY_SCOPE_AGENT); }
__device__ __forceinline__ unsigned xb_xcc_id() { return (unsigned)__builtin_amdgcn_s_getreg((3 << 11) | 20) & 0xFu; }
#define XB_SPIN(cond, bar) do { unsigned _sp = 0; while (cond) { __builtin_amdgcn_s_sleep(1); \
    if ((++_sp & 255u) == 0u) { if (xb_ld(&(bar)[XB_TMO])) break; if (_sp > XB_SPIN_CAP) { atomicAdd(&(bar)[XB_TMO], 1u); break; } } } } while (0)
struct XcdBarrier { unsigned* bar; unsigned x; volatile LAS unsigned* st; };
__device__ __forceinline__ XcdBarrier xcd_barrier_post(unsigned* bar, volatile LAS unsigned* st) {
    XcdBarrier b; b.bar = bar; b.x = xb_xcc_id(); b.st = st;
    if (threadIdx.x == 0) (void)xb_add(&bar[XB_XCNT(b.x)], 1u);
    return b;
}
__device__ __forceinline__ void xcd_barrier_complete(unsigned* bar, unsigned x, unsigned& nloc, unsigned& nx) {
    const unsigned G = gridDim.x * gridDim.y * gridDim.z;
    unsigned sum, cnt, mine, sp = 0u;
    for (;;) {
        sum = 0u; cnt = 0u; mine = 0u;
#pragma unroll
        for (unsigned j = 0; j < 16; ++j) { const unsigned c = xb_ld(&bar[XB_XCNT(j)]); sum += c; cnt += (c > 0u) ? 1u : 0u; mine = (j == x) ? c : mine; }
        if (sum == G) break;
        __builtin_amdgcn_s_sleep(1);
        if ((++sp & 255u) == 0u) { if (xb_ld(&bar[XB_TMO])) break; if (sp > XB_SPIN_CAP) { atomicAdd(&bar[XB_TMO], 1u); break; } }
    }
    nloc = mine > 0u ? mine : 1u; nx = cnt > 0u ? cnt : 1u;
}
__device__ __forceinline__ void xcd_barrier(const XcdBarrier& b) {
    asm volatile("s_waitcnt vmcnt(0)" ::: "memory");
    __syncthreads();
    if (threadIdx.x == 0) {
        unsigned* bar = b.bar;
        __builtin_amdgcn_s_waitcnt(0);
        unsigned nloc = b.st[0], nx = b.st[1];
        if (nloc == 0u) { xcd_barrier_complete(bar, b.x, nloc, nx); b.st[0] = nloc; b.st[1] = nx; }
        const unsigned old = xb_add(&bar[XB_XSUB(b.x)], 1u);
        const unsigned gen = old / nloc;
        if (old + 1u == (gen + 1u) * nloc) {
            __builtin_amdgcn_fence(__ATOMIC_RELEASE, "agent");
            asm volatile("s_waitcnt vmcnt(0)" ::: "memory");
            const unsigned og = xb_add(&bar[XB_TOP], 1u);
            const unsigned tg = og / nx;
            if (og + 1u == (tg + 1u) * nx) xb_add(&bar[XB_TOPGEN], 1u);
            else XB_SPIN(xb_ld(&bar[XB_TOPGEN]) == tg, bar);
            __builtin_amdgcn_fence(__ATOMIC_ACQUIRE, "agent");
            xb_add(&bar[XB_XGEN(b.x)], 1u);
            asm volatile("s_waitcnt vmcnt(0)" ::: "memory");
        } else {
            XB_SPIN(xb_ld(&bar[XB_XGEN(b.x)]) == gen, bar);
            __builtin_amdgcn_fence(__ATOMIC_ACQUIRE, "agent");
            asm volatile("s_waitcnt vmcnt(0)" ::: "memory");
        }
    }
    __syncthreads();
}

__global__ void __launch_bounds__(NWAVES * 64, 2) mega(Args a_) {
    extern __shared__ __attribute__((aligned(16))) unsigned char lds_raw[];
    LAS unsigned char* lds = (LAS unsigned char*)lds_raw;
    cg::grid_group grid = cg::this_grid();
    const int G = gridDim.x, bx = blockIdx.x;
    volatile LAS unsigned* MISC = (volatile LAS unsigned*)(lds + 131072 + 512);
    if (threadIdx.x < 16) MISC[threadIdx.x] = 0u;
    __syncthreads();
    (void)xcd_barrier_post((unsigned*)a_.ws + 4096, MISC + 8);
#ifndef PHMASK
#define PHMASK 0xfff
#endif
#define IN(k) ((PHMASK >> (k)) & 1)
#define GSYNC() do { XcdBarrier xb_; xb_.bar = (unsigned*)load_args().ws + 4096; xb_.x = xb_xcc_id(); xb_.st = (volatile LAS unsigned*)(lds + 131072 + 512) + 8; xcd_barrier(xb_); } while (0)
#define SEAM(k) do { if (IN(k) && IN((k) + 1)) { if ((k) == 0) grid.sync(); else GSYNC(); } } while (0)
#define ARGS() const Args a = load_args(); unsigned char* ws = a.ws; (void)ws
#ifndef REPMASK
#define REPMASK 0
#endif
#ifndef NSYNC_EXTRA
#define NSYNC_EXTRA 0
#endif
#define REPS(k) (((REPMASK >> (k)) & 1) ? 2 : 1)
#define REPSYNC() do { if (rep) GSYNC(); } while (0)

    for (int i = 0; i < NSYNC_EXTRA; ++i) GSYNC();
    if (IN(0)) for (int rep = 0; rep < REPS(0); ++rep) { REPSYNC(); phase0(lds); }
    SEAM(0);
    if (IN(1)) for (int rep = 0; rep < REPS(1); ++rep) {   REPSYNC();
        ARGS();
        pg8::Gemm g{(const bf16_t*)(ws + WS_ACTA), (const bf16_t*)(ws + WS_WIN), D, D, D}; pg8::StaticOrder S; S.init(M, NP, G, bx);
        pg8::EpiStore<0, false> E{(bf16_t*)(ws + WS_P), NP, 1, 1, nullptr, 1.0f};
        pg8::gemm_phase<pg8::EpiStore<0, false>, pg8::StaticOrder, true>(lds, g, S, E);
    }
    SEAM(1);
    if (IN(2)) for (int rep = 0; rep < REPS(2); ++rep) { REPSYNC(); phase_lora_in(); }
    SEAM(2);
    if (IN(3)) for (int rep = 0; rep < REPS(3); ++rep) {   REPSYNC();
        ARGS();
        pg8::Gemm g{(const bf16_t*)(ws + WS_ACTB), (const bf16_t*)(ws + WS_LORA), LK, LK, LK}; pg8::StaticOrder S; S.init(M, LN, G, bx);
        pg8::EpiLora E{(float*)((unsigned char*)a.out + DO_LW), (bf16_t*)((unsigned char*)a.out + DO_ASIG), (bf16_t*)((unsigned char*)a.out + DO_GG), (const float*)a.in[I_W0], (const float*)a.in[I_A0]};
        pg8::gemm_phase<pg8::EpiLora, pg8::StaticOrder, true>(lds, g, S, E);
    }
    SEAM(3);
    if (IN(4)) for (int rep = 0; rep < REPS(4); ++rep) {   REPSYNC();
#ifndef REP_SCAN
#define REP_SCAN 1
#endif
#ifndef REP_RET
#define REP_RET 1
#endif
        if (bx < 64) { for (int r2 = 0; r2 < REP_SCAN; ++r2) { if (r2) __syncthreads(); rwkv_chunk_wg(lds, bx); } }
        else if (bx < 128) { for (int r2 = 0; r2 < REP_RET; ++r2) { if (r2) __syncthreads(); retention_wg(lds, bx - 64); } }
        else if (bx < 192) { ARGS(); const int idx = bx - 128;
            if (idx < 32) { pg8::Gemm g{(const bf16_t*)(ws + WS_MEMN), (const bf16_t*)(ws + WS_WKV), D, D, D}; pg8::OneUnit S{idx >> 2, idx & 3};
                pg8::EpiStore<0, false> E{(bf16_t*)(ws + WS_KM), D, 1, 1, nullptr, 1.0f}; pg8::gemm_phase<pg8::EpiStore<0, false>, pg8::OneUnit, true>(lds, g, S, E); }
            else { const int j = idx - 32; pg8::Gemm g{(const bf16_t*)(ws + WS_WKV) + (size_t)D * D, (const bf16_t*)(ws + WS_MEMN), D, D, D}; pg8::OneUnit S{j >> 3, j & 7};
                pg8::EpiStore<0, false> E{(bf16_t*)(ws + WS_VT), MM, 1, 1, nullptr, 1.0f}; pg8::gemm_phase<pg8::EpiStore<0, false>, pg8::OneUnit, true>(lds, g, S, E); } }
    }
    SEAM(4);
    if (IN(6)) for (int rep = 0; rep < REPS(6); ++rep) {   REPSYNC();
        ARGS();
        pg8::Gemm g{(const bf16_t*)(ws + WS_ACTA), (const bf16_t*)(ws + WS_WOUT), D, D, D}; pg8::StaticOrder S; S.init(M, D, G, bx);
        pg8::EpiRes E{(const float*)a.in[I_X], a.out, (bf16_t*)(ws + WS_ACTB), (float*)(ws + WS_SQ1)};
        pg8::gemm_phase<pg8::EpiRes, pg8::StaticOrder, true>(lds, g, S, E);
    }
    SEAM(6);
    if (IN(7)) for (int rep = 0; rep < REPS(7); ++rep) {   REPSYNC();
        if (bx < 256) { ARGS(); const int u = bx; const int b = u >> 5, h4 = (u >> 3) & 3, qt = u & 7; const int pm = b * 8 + qt;
            bf16_t* QS = (bf16_t*)(ws + WS_P) + (size_t)u * 131072; bf16_t* PSb = QS + 65536;
            { pg8::Gemm g{(const bf16_t*)(ws + WS_ACTB), (const bf16_t*)(ws + WS_WQ), D, D, D}; pg8::OneUnit S{pm, h4};
              pg8::EpiStore<0, true> E{QS, 256, 0, 0, (const float*)(ws + WS_SQ1), 0.0625f}; pg8::gemm_phase<pg8::EpiStore<0, true>, pg8::OneUnit, true>(lds, g, S, E); }
            asm volatile("s_waitcnt vmcnt(0)" ::: "memory"); __syncthreads(); __builtin_amdgcn_fence(__ATOMIC_ACQUIRE, "agent"); asm volatile("s_waitcnt vmcnt(0)" ::: "memory"); __syncthreads();
            { pg8::Gemm g{QS, (const bf16_t*)(ws + WS_KM) + (size_t)(b * 256) * D + h4 * 256, 256, D, 256}; pg8::OneUnit S{0, 0};
              pg8::EpiSoftmax E{PSb}; pg8::gemm_phase<pg8::EpiSoftmax, pg8::OneUnit, false>(lds, g, S, E); }
            asm volatile("s_waitcnt vmcnt(0)" ::: "memory"); __syncthreads(); __builtin_amdgcn_fence(__ATOMIC_ACQUIRE, "agent"); asm volatile("s_waitcnt vmcnt(0)" ::: "memory"); __syncthreads();
            { pg8::Gemm g{PSb, (const bf16_t*)(ws + WS_VT) + (size_t)(h4 * 256) * MM + b * 256, 256, MM, 256}; pg8::OneUnit S{0, 0};
              pg8::EpiStore<0, false> E{(bf16_t*)(ws + WS_ACTA) + (size_t)(pm * 256) * D + h4 * 256, D, 0, 0, nullptr, 1.0f}; pg8::gemm_phase<pg8::EpiStore<0, false>, pg8::OneUnit, true>(lds, g, S, E); }
            __syncthreads();
        }
    }
    SEAM(7);
    if (IN(8)) {
        ARGS();
        pg8::Gemm g{(const bf16_t*)(ws + WS_ACTA), (const bf16_t*)(ws + WS_WO), D, D, D}; pg8::StaticOrder S; S.init(M, D, G, bx);
        pg8::EpiRes E{a.out, a.out, (bf16_t*)(ws + WS_ACTB), (float*)(ws + WS_SQ2)};
        pg8::gemm_phase<pg8::EpiRes, pg8::StaticOrder, true>(lds, g, S, E);
    }
    SEAM(8);
    if (IN(9)) for (int rep = 0; rep < REPS(9); ++rep) {   REPSYNC();
        ARGS();
        pg8::Gemm g{(const bf16_t*)(ws + WS_ACTB), (const bf16_t*)(ws + WS_WUP), D, D, D}; pg8::StaticOrder S; S.init(M, FF, G, bx);
        pg8::EpiStore<2, true> E{(bf16_t*)(ws + WS_P), FF, 1, 1, (const float*)(ws + WS_SQ2), 1.0f};
        pg8::gemm_phase<pg8::EpiStore<2, true>, pg8::StaticOrder, true>(lds, g, S, E);
    }
    SEAM(9);
    if (IN(10)) {
        ARGS();
        pg8::Gemm g{(const bf16_t*)(ws + WS_P), (const bf16_t*)(ws + WS_WDN), FF, FF, FF}; pg8::StaticOrder S; S.init(M, D, G, bx);
        pg8::EpiRes E{a.out, a.out, nullptr, (float*)(ws + WS_SQ3)};
        pg8::gemm_phase<pg8::EpiRes, pg8::StaticOrder, true>(lds, g, S, E);
    }
    SEAM(10);
    if (IN(11)) {
        ARGS(); TIDS();
        const float* sq = (const float*)(ws + WS_SQ3); const float* gf = (const float*)a.in[I_NFIN];
        const int gw = bx * NWAVES + wave, NGW = G * NWAVES;
        f32x4 gv[4];
#pragma unroll
        for (int j = 0; j < 4; ++j) gv[j] = ((const f32x4*)gf)[lane + 64 * j];
        for (int m = gw; m < M; m += NGW) { const f32x4* q4 = (const f32x4*)(sq + (size_t)m * 16); const f32x4 s = q4[0] + q4[1] + q4[2] + q4[3];
            const float rstd = 1.0f / sqrtf((s[0] + s[1] + s[2] + s[3]) * (1.f / 1024.f) + 1e-6f);
            f32x4* xr = (f32x4*)(a.out + (size_t)m * D) + lane;
#pragma unroll
            for (int j = 0; j < 4; ++j) xr[64 * j] = xr[64 * j] * rstd * gv[j]; }
    }
#undef IN
#undef SEAM
#undef ARGS
}

extern "C" void kernel_launch(void* const* d_in, const int* in_sizes, int n_in, void* d_out, int out_size, void* d_ws, size_t ws_size, hipStream_t stream) {
    static int grid = 0;
    if (grid == 0) {
        if (n_in != 28 || out_size != M * D || ws_size < WS_END) { fprintf(stderr, "kernel_launch: unexpected shapes (n_in %d out %d ws %zu)\n", n_in, out_size, ws_size); grid = -1; return; }
        int dev = 0, cus = 0, per_cu = 0;
        if (hipGetDevice(&dev) != hipSuccess || hipDeviceGetAttribute(&cus, hipDeviceAttributeMultiprocessorCount, dev) != hipSuccess) { grid = -1; return; }
        if (hipFuncSetAttribute((const void*)mega, hipFuncAttributeMaxDynamicSharedMemorySize, LDS_BYTES) != hipSuccess) { fprintf(stderr, "kernel_launch: hipFuncSetAttribute failed\n"); grid = -1; return; }
        if (hipOccupancyMaxActiveBlocksPerMultiprocessor(&per_cu, (const void*)mega, NWAVES * 64, LDS_BYTES) != hipSuccess || per_cu < 1) { fprintf(stderr, "kernel_launch: occupancy query says %d\n", per_cu); (void)hipGetLastError(); }
        grid = cus;
        if (grid != 256) fprintf(stderr, "kernel_launch: %d CUs (built for 256)\n", grid);
    }
    if (grid < 0) return;
    if (hipMemsetAsync(d_ws, 0, 65536, stream) != hipSuccess) { fprintf(stderr, "kernel_launch: memset failed\n"); return; }
    Args a{};
    for (int i = 0; i < 28; ++i) a.in[i] = d_in[i];
    a.out = (float*)d_out; a.ws = (unsigned char*)d_ws; a.ph_lo = 0; a.ph_hi = 12;
    void* args[] = {&a};
    hipError_t e = hipLaunchCooperativeKernel((const void*)mega, dim3(grid), dim3(NWAVES * 64), args, LDS_BYTES, stream);
    if (e != hipSuccess) fprintf(stderr, "cooperative launch failed: %s (grid %d)\n", hipGetErrorString(e), grid);
}
```

```cpp
#include <hip/hip_runtime.h>
#include <hip/hip_cooperative_groups.h>
#include <cstdio>
#include <cstdint>
namespace cg = cooperative_groups;
#define REPMASK 0
#define NSYNC_EXTRA 0
#define REP_SCAN 1
#define REP_RET 1

#define LAS __attribute__((address_space(3)))
typedef unsigned short bf16_t;
typedef short bf16x8 __attribute__((ext_vector_type(8)));
typedef float f32x4 __attribute__((ext_vector_type(4)));
typedef float f32x2 __attribute__((ext_vector_type(2)));
typedef unsigned u32x4 __attribute__((ext_vector_type(4)));
typedef unsigned u32x2 __attribute__((ext_vector_type(2)));

typedef __bf16 bf16x2_t __attribute__((ext_vector_type(2)));
__device__ __forceinline__ unsigned cvt_pk_bf16(float lo, float hi) { f32x2 v = {lo, hi}; bf16x2_t b = __builtin_convertvector(v, bf16x2_t); return __builtin_bit_cast(unsigned, b); }
__device__ __forceinline__ float bf2f(unsigned short b) { return __uint_as_float(((unsigned)b) << 16); }
__device__ __forceinline__ float bflo(unsigned w) { return __uint_as_float(w << 16); }
__device__ __forceinline__ float bfhi(unsigned w) { return __uint_as_float(w & 0xffff0000u); }
__device__ __forceinline__ float sigmoidf_(float x) { return __builtin_amdgcn_rcpf(1.0f + __expf(-x)); }
__device__ __forceinline__ float wave_sum(float v) {
#pragma unroll
    for (int o = 1; o < 64; o <<= 1) v += __shfl_xor(v, o);
    return v;
}

namespace pg8 {
constexpr int BM = 256, BK = 64, HALF = 128, HTB = HALF * BK * 2, STAGE_BYTES = 8 * HTB, NXCD = 8, WGM = 8;
__host__ __device__ __forceinline__ int lds_byte(int r, int c) { const int st = (r >> 4) * 2 + (c >> 5), rr = r & 15, cc = c & 31, ob = rr * 64 + cc * 2; return st * 1024 + (ob ^ (((ob >> 9) & 1) << 5)); }
__host__ __device__ __forceinline__ void stage_rc(int b, int& R, int& C) { const int st = b / 1024, sb = b % 1024, swz = sb ^ (((sb >> 9) & 1) << 5); R = (st >> 1) * 16 + swz / 64; C = (st & 1) * 32 + (swz % 64) / 2; }
__host__ __device__ __forceinline__ int perm32(int rho) { const int n = rho >> 4, i = rho & 15; return 8 * (i >> 2) + 4 * n + (i & 3); }

struct Unit { int pm, pn; };
struct Gemm { const bf16_t* A; const bf16_t* Bt; int lda, ldb, K; };

struct StaticOrder {
    int nM, nN, nwg, G, c;
    __device__ void init(int M, int N, int G_, int c_) { nM = M / BM; nN = N / BM; nwg = nM * nN; G = G_; c = c_; }
    __device__ bool next(int i, Unit& u) const {
        const long L = (long)i * G + c; if (L >= nwg) return false;
        int wgid = (int)L; { const int q = nwg / NXCD, r = nwg % NXCD, xcd = wgid % NXCD, off = wgid / NXCD; wgid = (xcd < r ? xcd * (q + 1) : r * (q + 1) + (xcd - r) * q) + off; }
        const int nig = WGM * nN, gid = wgid / nig, fm = gid * WGM, gsz = (nM - fm) < WGM ? (nM - fm) : WGM;
        u.pm = fm + ((wgid % nig) % gsz); u.pn = (wgid % nig) / gsz; return true;
    }
};
struct OneUnit {
    int pm, pn;
    __device__ bool next(int i, Unit& u) const { if (i) return false; u.pm = pm; u.pn = pn; return true; }
};


template <int ACT, bool RS> struct EpiStore {
    static constexpr bool PERM = true, AFTER_DRAIN = false;
    bf16_t* O; int ldc; int om, on; const float* sq; float cs;
    __device__ __forceinline__ void operator()(const f32x4 (&acc)[2][2][4][2], const Unit& u, int wr, int wc, int fr, int fq) const {
        int rl0 = wr * 64 + fr, cl0 = wc * 32 + 8 * fq; asm volatile("" : "+v"(rl0), "+v"(cl0));
        bf16_t* base = O + (size_t)(om * u.pm * BM) * ldc + on * u.pn * BM + cl0;
#pragma unroll
        for (int ai = 0; ai < 2; ++ai)
#pragma unroll
            for (int m = 0; m < 4; ++m) {
                const int rl = rl0 + ai * HALF + m * 16;
                float sc = cs;
                if (RS) { const f32x4* q4 = (const f32x4*)(sq + (size_t)(u.pm * BM + rl) * 16); f32x4 s = q4[0] + q4[1] + q4[2] + q4[3];
                    sc *= __builtin_amdgcn_rsqf((s[0] + s[1] + s[2] + s[3]) * (1.0f / 1024.0f) + 1e-6f); }
                bf16_t* rowp = base + (size_t)rl * ldc;
#pragma unroll
                for (int bj = 0; bj < 2; ++bj) { f32x4 v0 = acc[ai][bj][m][0] * sc, v1 = acc[ai][bj][m][1] * sc;
                    if (ACT == 2) {
#pragma unroll
                        for (int j = 0; j < 4; ++j) { float x = fmaxf(v0[j], 0.f); v0[j] = x * x; float y = fmaxf(v1[j], 0.f); v1[j] = y * y; } }
                    u32x4 w; w.x = cvt_pk_bf16(v0[0], v0[1]); w.y = cvt_pk_bf16(v0[2], v0[3]); w.z = cvt_pk_bf16(v1[0], v1[1]); w.w = cvt_pk_bf16(v1[2], v1[3]);
                    *(u32x4*)(rowp + bj * HALF) = w; } }
    }
};

struct EpiLora {
    static constexpr bool PERM = true, AFTER_DRAIN = false;
    float* LW; bf16_t* ASIG; bf16_t* GG; const float* w0; const float* a0;
    template <int SECT> __device__ __forceinline__ void run(const f32x4 (&acc)[2][2][4][2], int rl0, int c0) const {
        const float* cvec = SECT == 0 ? w0 : a0; bf16_t* ob = SECT == 1 ? ASIG : GG;
#pragma unroll
        for (int ai = 0; ai < 2; ++ai)
#pragma unroll
            for (int m = 0; m < 4; ++m) {
                const size_t row = (size_t)(rl0 + ai * HALF + m * 16);
#pragma unroll
                for (int bj = 0; bj < 2; ++bj) { const int c = c0 + bj * HALF; f32x4 v0 = acc[ai][bj][m][0], v1 = acc[ai][bj][m][1];
                    if (SECT < 2) { v0 += *(const f32x4*)(cvec + c); v1 += *(const f32x4*)(cvec + c + 4); }
                    if (SECT == 0) {
#pragma unroll
                        for (int j = 0; j < 4; ++j) { v0[j] = -0.60653065971f * sigmoidf_(v0[j]); v1[j] = -0.60653065971f * sigmoidf_(v1[j]); }
                        *(f32x4*)(LW + row * 512 + c) = v0; *(f32x4*)(LW + row * 512 + c + 4) = v1;
                    } else {
                        if (SECT == 1) {
#pragma unroll
                            for (int j = 0; j < 4; ++j) { v0[j] = sigmoidf_(v0[j]); v1[j] = sigmoidf_(v1[j]); } }
                        u32x4 w; w.x = cvt_pk_bf16(v0[0], v0[1]); w.y = cvt_pk_bf16(v0[2], v0[3]); w.z = cvt_pk_bf16(v1[0], v1[1]); w.w = cvt_pk_bf16(v1[2], v1[3]);
                        *(u32x4*)(ob + row * 512 + c) = w; } }
                asm volatile("" ::: "memory"); }
    }
    __device__ __forceinline__ void operator()(const f32x4 (&acc)[2][2][4][2], const Unit& u, int wr, int wc, int fr, int fq) const {
        int rl0 = u.pm * BM + wr * 64 + fr, c0 = (u.pn & 1) * BM + wc * 32 + 8 * fq; const int sect = u.pn >> 1; asm volatile("" : "+v"(rl0), "+v"(c0));
        if (sect == 0) run<0>(acc, rl0, c0); else if (sect == 1) run<1>(acc, rl0, c0); else run<2>(acc, rl0, c0);
    }
};

struct EpiRes {
    static constexpr bool PERM = true, AFTER_DRAIN = false;
    const float* base; float* out; bf16_t* xb; float* sq;
    __device__ __forceinline__ void operator()(const f32x4 (&acc)[2][2][4][2], const Unit& u, int wr, int wc, int fr, int fq) const {
        int rl0 = u.pm * BM + wr * 64 + fr, c0 = u.pn * BM + wc * 32 + 8 * fq; asm volatile("" : "+v"(rl0), "+v"(c0));
#pragma unroll
        for (int ai = 0; ai < 2; ++ai)
#pragma unroll
            for (int m = 0; m < 4; ++m) {
                const size_t row = (size_t)(rl0 + ai * HALF + m * 16); float ss = 0.f;
#pragma unroll
                for (int bj = 0; bj < 2; ++bj) { const size_t off = row * 1024 + c0 + bj * HALF;
                    const f32x4 b0 = *(const f32x4*)(base + off), b1 = *(const f32x4*)(base + off + 4);
                    const f32x4 o0 = b0 + acc[ai][bj][m][0], o1 = b1 + acc[ai][bj][m][1];
                    *(f32x4*)(out + off) = o0; *(f32x4*)(out + off + 4) = o1;
                    if (xb) { u32x4 w; w.x = cvt_pk_bf16(o0[0], o0[1]); w.y = cvt_pk_bf16(o0[2], o0[3]); w.z = cvt_pk_bf16(o1[0], o1[1]); w.w = cvt_pk_bf16(o1[2], o1[3]); *(u32x4*)(xb + off) = w; }
                    ss += (o0[0] * o0[0] + o0[1] * o0[1]) + (o0[2] * o0[2] + o0[3] * o0[3]) + (o1[0] * o1[0] + o1[1] * o1[1]) + (o1[2] * o1[2] + o1[3] * o1[3]); }
                ss += __shfl_xor(ss, 16); ss += __shfl_xor(ss, 32);
                if (fq == 0) sq[row * 16 + u.pn * 4 + wc] = ss;
                if (m & 1) asm volatile("" ::: "memory"); }
    }
};

struct EpiSoftmax {
    static constexpr bool PERM = true, AFTER_DRAIN = true;
    bf16_t* Pout;
    __device__ __forceinline__ void fused(f32x4 (&acc)[2][2][4][2], const Unit& u, int wr, int wc, int fr, int fq, LAS unsigned char* lds, int wid, int lane) const {
        LAS float* PM = (LAS float*)lds;
        LAS float* PS = (LAS float*)(lds + 4096);
        int rl0 = wr * 64 + fr; asm volatile("" : "+v"(rl0));
#pragma unroll
        for (int ai = 0; ai < 2; ++ai)
#pragma unroll
            for (int m = 0; m < 4; ++m) { float v = -3.0e38f;
#pragma unroll
                for (int bj = 0; bj < 2; ++bj)
#pragma unroll
                    for (int n = 0; n < 2; ++n) { const f32x4 x = acc[ai][bj][m][n]; v = fmaxf(v, fmaxf(fmaxf(x[0], x[1]), fmaxf(x[2], x[3]))); }
                v = fmaxf(v, __shfl_xor(v, 16)); v = fmaxf(v, __shfl_xor(v, 32));
                if (fq == 0) PM[(rl0 + ai * HALF + m * 16) * 4 + wc] = v; }
        asm volatile("s_waitcnt lgkmcnt(0)" ::: "memory"); __builtin_amdgcn_s_barrier(); asm volatile("" ::: "memory");
#pragma unroll
        for (int ai = 0; ai < 2; ++ai)
#pragma unroll
            for (int m = 0; m < 4; ++m) { const f32x4 p = *(const LAS f32x4*)(PM + (rl0 + ai * HALF + m * 16) * 4);
                const float rm = fmaxf(fmaxf(p[0], p[1]), fmaxf(p[2], p[3])) * 1.44269504089f; float s = 0.f;
#pragma unroll
                for (int bj = 0; bj < 2; ++bj)
#pragma unroll
                    for (int n = 0; n < 2; ++n) {
#pragma unroll
                        for (int j = 0; j < 4; ++j) { const float e = __builtin_amdgcn_exp2f(acc[ai][bj][m][n][j] * 1.44269504089f - rm); acc[ai][bj][m][n][j] = e; s += e; } }
                s += __shfl_xor(s, 16); s += __shfl_xor(s, 32);
                if (fq == 0) PS[(rl0 + ai * HALF + m * 16) * 4 + wc] = s; }
        asm volatile("s_waitcnt lgkmcnt(0)" ::: "memory"); __builtin_amdgcn_s_barrier(); asm volatile("" ::: "memory");
#pragma unroll
        for (int ai = 0; ai < 2; ++ai)
#pragma unroll
            for (int m = 0; m < 4; ++m) { const int rl = rl0 + ai * HALF + m * 16; const f32x4 p = *(const LAS f32x4*)(PS + rl * 4);
                const float inv = __builtin_amdgcn_rcpf((p[0] + p[1]) + (p[2] + p[3]));
#pragma unroll
                for (int bj = 0; bj < 2; ++bj) { const f32x4 v0 = acc[ai][bj][m][0] * inv, v1 = acc[ai][bj][m][1] * inv;
                    u32x4 w; w.x = cvt_pk_bf16(v0[0], v0[1]); w.y = cvt_pk_bf16(v0[2], v0[3]); w.z = cvt_pk_bf16(v1[0], v1[1]); w.w = cvt_pk_bf16(v1[2], v1[3]);
                    *(u32x4*)(Pout + (size_t)rl * 256 + wc * 32 + 8 * fq + bj * HALF) = w; } }
    }
};

template <class Epi, class Sched, bool ALIGN_EPI = false, bool SP2 = true>
__device__ __forceinline__ void gemm_phase(LAS unsigned char* lds, const Gemm g, const Sched& S, const Epi& E) {
    int tid = threadIdx.x; asm volatile("" : "+v"(tid));
    const int wid = __builtin_amdgcn_readfirstlane(tid >> 6), lane = tid & 63, wr = wid >> 2, wc = wid & 3, fr = lane & 15, fq = lane >> 4;
    const int K = g.K, nt = K / BK;
    unsigned voffA[2], voffB[2];
#pragma unroll
    for (int i = 0; i < 2; ++i) { int R, C; stage_rc(tid * 16 + i * 8192, R, C); const int Rb = Epi::PERM ? ((R & ~31) + perm32(R & 31)) : R;
        voffA[i] = (unsigned)(R * g.lda + C) * 2u; voffB[i] = (unsigned)(Rb * g.ldb + C) * 2u; }
    const size_t kstep = (size_t)(BK * 2);
    const size_t hstepA = (size_t)HALF * g.lda * 2, hstepB = (size_t)HALF * g.ldb * 2;
    const size_t tstepA = 2 * hstepA, tstepB = 2 * hstepB;
    const unsigned ldsw = (unsigned)wid * 1024u;
    const int aoff = lds_byte(wr * 64 + fr, fq * 8), boff = lds_byte(wc * 32 + fr, fq * 8);
#define PG8_SA(b, h) (((b) * 2 + (h)) * HTB)
#define PG8_SB(b, h) ((4 + (b) * 2 + (h)) * HTB)
#define PG8_STAGE(bufoff, gbase, voff) do { _Pragma("unroll") for (int _i = 0; _i < 2; ++_i) \
        __builtin_amdgcn_global_load_lds((const unsigned*)((const char*)(gbase) + (voff)[_i]), (LAS unsigned*)(lds + (bufoff) + ldsw + _i * 8192), 16, 0, 0); } while (0)
#define PG8_LDA(dst, b, h) do { _Pragma("unroll") for (int m = 0; m < 4; ++m) _Pragma("unroll") for (int k = 0; k < 2; ++k) dst[m][k] = *(const LAS bf16x8*)(lds + PG8_SA(b, h) + aoff + m * 2048 + k * 1024); } while (0)
#define PG8_LDB(dst, b, h) do { _Pragma("unroll") for (int n = 0; n < 2; ++n) _Pragma("unroll") for (int k = 0; k < 2; ++k) dst[n][k] = *(const LAS bf16x8*)(lds + PG8_SB(b, h) + boff + n * 2048 + k * 1024); } while (0)
#define PG8_MMA(ai, bj, At, Bt) do { __builtin_amdgcn_s_setprio(1); _Pragma("unroll") for (int m = 0; m < 4; ++m) _Pragma("unroll") for (int n = 0; n < 2; ++n) _Pragma("unroll") for (int k = 0; k < 2; ++k) \
        acc[ai][bj][m][n] = __builtin_amdgcn_mfma_f32_16x16x32_bf16(Bt[n][k], At[m][k], acc[ai][bj][m][n], 0, 0, 0); __builtin_amdgcn_s_setprio(0); } while (0)
#define PG8_WAIT_V(n) asm volatile("s_waitcnt vmcnt(" #n ")" ::: "memory")
#define PG8_WAIT_L(n) asm volatile("s_waitcnt lgkmcnt(" #n ")" ::: "memory")
#define PG8_BAR __builtin_amdgcn_s_barrier()
#define PG8_SCHED __builtin_amdgcn_sched_barrier(0)
    Unit cur, nxt; int ui = 0;
    if (!S.next(0, cur)) return;
    f32x4 acc[2][2][4][2];
#pragma unroll
    for (int a = 0; a < 2; ++a)
#pragma unroll
        for (int b = 0; b < 2; ++b)
#pragma unroll
            for (int m = 0; m < 4; ++m)
#pragma unroll
                for (int n = 0; n < 2; ++n) acc[a][b][m][n] = (f32x4){0.f, 0.f, 0.f, 0.f};
    bf16x8 At[4][2], B0[2][2], B1[2][2];
    const char* cA = (const char*)g.A + (size_t)cur.pm * tstepA; const char* cB = (const char*)g.Bt + (size_t)cur.pn * tstepB;
    static_assert(SP2, "only the two-super-phase loop is kept here");
    PG8_STAGE(PG8_SB(0, 0), cB, voffB); PG8_STAGE(PG8_SB(0, 1), cB + hstepB, voffB); PG8_STAGE(PG8_SA(0, 0), cA, voffA); PG8_STAGE(PG8_SA(0, 1), cA + hstepA, voffA);
    if (wr == 1) PG8_BAR;
    PG8_WAIT_V(2); PG8_BAR;
    PG8_STAGE(PG8_SB(1, 0), cB + kstep, voffB); PG8_STAGE(PG8_SA(1, 0), cA + kstep, voffA); PG8_STAGE(PG8_SB(1, 1), cB + hstepB + kstep, voffB);
    PG8_WAIT_V(6); PG8_BAR;
    for (;;) {
        const bool has_next = S.next(ui + 1, nxt);
        const char* nA = has_next ? (const char*)g.A + (size_t)nxt.pm * tstepA : cA; const char* nB = has_next ? (const char*)g.Bt + (size_t)nxt.pn * tstepB : cB;
        for (int t = 0; t < nt; t += 2) {
            const bool last = (t == nt - 2);
            const char* a1 = cA + (size_t)(t + 1) * kstep;
            const char* a2 = last ? nA : cA + (size_t)(t + 2) * kstep; const char* b2 = last ? nB : cB + (size_t)(t + 2) * kstep;
            const char* a3 = a2 + kstep; const char* b3 = b2 + kstep;
            PG8_LDB(B0, 0, 0); PG8_LDB(B1, 0, 1); PG8_SCHED; PG8_LDA(At, 0, 0); PG8_STAGE(PG8_SA(1, 1), a1 + hstepA, voffA);
            PG8_WAIT_V(8); PG8_WAIT_L(0); PG8_BAR; PG8_MMA(0, 0, At, B0); PG8_MMA(0, 1, At, B1); PG8_BAR; PG8_SCHED;
            PG8_LDA(At, 0, 1); PG8_STAGE(PG8_SB(0, 0), b2, voffB); PG8_STAGE(PG8_SB(0, 1), b2 + hstepB, voffB); PG8_STAGE(PG8_SA(0, 0), a2, voffA);
            PG8_WAIT_V(8); PG8_WAIT_L(0); PG8_BAR; PG8_MMA(1, 0, At, B0); PG8_MMA(1, 1, At, B1); PG8_BAR; PG8_SCHED;
            PG8_LDB(B0, 1, 0); PG8_LDB(B1, 1, 1); PG8_SCHED; PG8_LDA(At, 1, 0); PG8_STAGE(PG8_SA(0, 1), a2 + hstepA, voffA);
            PG8_WAIT_V(8); PG8_WAIT_L(0); PG8_BAR; PG8_MMA(0, 0, At, B0); PG8_MMA(0, 1, At, B1); PG8_BAR; PG8_SCHED;
            PG8_LDA(At, 1, 1); PG8_STAGE(PG8_SB(1, 0), b3, voffB); PG8_STAGE(PG8_SB(1, 1), b3 + hstepB, voffB); PG8_STAGE(PG8_SA(1, 0), a3, voffA);
            PG8_WAIT_V(8); PG8_WAIT_L(0); PG8_BAR; PG8_MMA(1, 0, At, B0); PG8_MMA(1, 1, At, B1); PG8_BAR; PG8_SCHED;
        }
        if constexpr (ALIGN_EPI) { if (wr == 0) PG8_BAR; }
        if constexpr (!Epi::AFTER_DRAIN) { E(acc, cur, wr, wc, fr, fq); }
        if (!has_next) break;
#pragma unroll
        for (int a = 0; a < 2; ++a)
#pragma unroll
            for (int b = 0; b < 2; ++b)
#pragma unroll
                for (int m = 0; m < 4; ++m)
#pragma unroll
                    for (int n = 0; n < 2; ++n) acc[a][b][m][n] = (f32x4){0.f, 0.f, 0.f, 0.f};
        cur = nxt; cA = nA; cB = nB; ++ui;
        if constexpr (ALIGN_EPI) { if (wr == 1) PG8_BAR; }
    }
    PG8_WAIT_V(0);
    if constexpr (!ALIGN_EPI) { if (wr == 0) PG8_BAR; }
    PG8_BAR;
    if constexpr (Epi::AFTER_DRAIN) { E.fused(acc, cur, wr, wc, fr, fq, lds, wid, lane); }
#undef PG8_SA
#undef PG8_SB
#undef PG8_STAGE
#undef PG8_LDA
#undef PG8_LDB
#undef PG8_MMA
#undef PG8_WAIT_V
#undef PG8_WAIT_L
#undef PG8_BAR
#undef PG8_SCHED
}
}

constexpr int BATCH = 8, SEQ = 2048, D = 1024, M = BATCH * SEQ, NMEM = 256, MM = BATCH * NMEM;
constexpr int NIN = 3872, NP = 4096, FF = 4096, LK = 384, LN = 1536;
constexpr int C_RK = 2048, C_LORA = 3584;
constexpr int NWAVES = 8, LDS_BYTES = 147456;
constexpr size_t MiB = 1u << 20;
constexpr size_t WS_WIN = 1 * MiB, WS_WOUT = 9 * MiB, WS_WQ = 11 * MiB, WS_WKV = 13 * MiB, WS_WO = 17 * MiB, WS_WUP = 19 * MiB, WS_WDN = 27 * MiB, WS_LORA = 35 * MiB;
constexpr size_t WS_MEMN = 37 * MiB, WS_KM = 41 * MiB, WS_VT = 45 * MiB, WS_ROPE = 49 * MiB, WS_SQ1 = 53 * MiB, WS_SQ2 = 54 * MiB, WS_SQ3 = 55 * MiB;
constexpr size_t WS_ACTA = 56 * MiB, WS_ACTB = 88 * MiB, WS_P = 120 * MiB, WS_END = 248 * MiB;
constexpr size_t DO_LW = 0, DO_ASIG = 32 * MiB, DO_GG = 48 * MiB;

struct Args { const void* in[28]; float* out; unsigned char* ws; int ph_lo, ph_hi; };
typedef const __attribute__((address_space(4))) unsigned long long* CArgs;
__device__ __forceinline__ Args load_args() { CArgs p = (CArgs)__builtin_amdgcn_kernarg_segment_ptr(); asm volatile("" : "+s"(p)); Args a;
#pragma unroll
    for (int i = 0; i < 28; ++i) a.in[i] = (const void*)(const __attribute__((address_space(1))) void*)p[i];
    a.out = (float*)(__attribute__((address_space(1))) float*)p[28]; a.ws = (unsigned char*)(__attribute__((address_space(1))) unsigned char*)p[29]; a.ph_lo = (int)p[30]; a.ph_hi = (int)(p[30] >> 32); return a; }
#define TIDS() int tid = threadIdx.x; asm volatile("" : "+v"(tid)); const int lane = tid & 63, wave = __builtin_amdgcn_readfirstlane(tid >> 6); (void)lane; (void)wave
enum { I_X = 0, I_MEM, I_POS, I_NMIX, I_WIN, I_RGNW, I_RGNB, I_MU, I_W0, I_WUP, I_A0, I_AUP, I_GUP, I_KK, I_KA, I_RK, I_WGNW, I_WGNB, I_WOUT, I_NXA, I_NMEM, I_WQ, I_WKV, I_WO, I_NMLP, I_MUP, I_MDN, I_NFIN };

__device__ __forceinline__ void p0_transpose_item(const float* W, int K, int N, const float* gain, bf16_t* WT, int row_off, LAS float* scr, int item, int lane) {
    const int nblk = N / 32, kb = item / nblk, nb = item % nblk, k0 = 64 * kb, n0 = 32 * nb;
#pragma unroll 8
    for (int i = 0; i < 32; ++i) { const int kk = 2 * i + (lane >> 5); float v = W[(size_t)(k0 + kk) * N + n0 + (lane & 31)]; if (gain) v *= gain[k0 + kk]; scr[kk * 33 + (lane & 31)] = v; }
    asm volatile("s_waitcnt lgkmcnt(0)" ::: "memory");
    const int c = lane & 7;
#pragma unroll
    for (int j = 0; j < 4; ++j) { const int n = (lane >> 3) + 8 * j; const LAS float* s = scr + (8 * c) * 33 + n;
        u32x4 o; o.x = cvt_pk_bf16(s[0 * 33], s[1 * 33]); o.y = cvt_pk_bf16(s[2 * 33], s[3 * 33]); o.z = cvt_pk_bf16(s[4 * 33], s[5 * 33]); o.w = cvt_pk_bf16(s[6 * 33], s[7 * 33]);
        *(u32x4*)(WT + (size_t)(row_off + n0 + n) * K + k0 + 8 * c) = o; }
    asm volatile("s_waitcnt lgkmcnt(0)" ::: "memory");
}
__device__ __forceinline__ void rms_row_to_bf16(const float* xrow, bf16_t* orow, int lane) {
    const f32x4* xr = (const f32x4*)xrow + lane;
    f32x4 v[4]; float s = 0.f;
#pragma unroll
    for (int j = 0; j < 4; ++j) { v[j] = xr[64 * j]; s += (v[j][0] * v[j][0] + v[j][1] * v[j][1]) + (v[j][2] * v[j][2] + v[j][3] * v[j][3]); }
    const float rstd = 1.0f / sqrtf(wave_sum(s) * (1.f / 1024.f) + 1e-6f);
    u32x2* o8 = (u32x2*)orow + lane;
#pragma unroll
    for (int j = 0; j < 4; ++j) { u32x2 w; w.x = cvt_pk_bf16(v[j][0] * rstd, v[j][1] * rstd); w.y = cvt_pk_bf16(v[j][2] * rstd, v[j][3] * rstd); o8[64 * j] = w; }
}

__device__ __forceinline__ void phase0(LAS unsigned char* lds) {
    const Args a = load_args(); TIDS();
    unsigned char* ws = a.ws;
    LAS float* scr = (LAS float*)(lds + wave * 16384);
    const int gw = blockIdx.x * NWAVES + wave, NGW = gridDim.x * NWAVES;
    const int gt = blockIdx.x * 512 + tid, NGT = gridDim.x * 512;
    constexpr int I_IN = 16 * 121, I_KV = 16 * 64;
    constexpr int NITEMS = I_IN + I_KV;
    for (int it = gw; it < NITEMS; it += NGW) {
        int r = it;
        if (r < I_IN) { p0_transpose_item((const float*)a.in[I_WIN], D, NIN, (const float*)a.in[I_NMIX], (bf16_t*)(ws + WS_WIN), 0, scr, r, lane); continue; } r -= I_IN;
        p0_transpose_item((const float*)a.in[I_WKV], D, 2 * D, (const float*)a.in[I_NMEM], (bf16_t*)(ws + WS_WKV), 0, scr, r, lane);
    }
    { u32x4* z = (u32x4*)(ws + WS_WIN + (size_t)NIN * D * 2); const int nz = (NP - NIN) * D * 2 / 16; for (int i = gt; i < nz; i += NGT) z[i] = (u32x4){0u, 0u, 0u, 0u}; }
    { const float* wup = (const float*)a.in[I_WUP]; const float* aup = (const float*)a.in[I_AUP]; const float* gup = (const float*)a.in[I_GUP]; u32x4* LT = (u32x4*)(ws + WS_LORA);
      for (int i = gt; i < LN * (LK / 8); i += NGT) { const int n = i / (LK / 8), k0 = (i % (LK / 8)) * 8; float v[8];
#pragma unroll
          for (int j = 0; j < 8; ++j) { const int k = k0 + j; float x = 0.f;
              if (n < 512) { if (k < 64) x = wup[k * 512 + n]; }
              else if (n < 1024) { if (k >= 64 && k < 128) x = aup[(k - 64) * 512 + (n - 512)]; }
              else { if (k >= 128 && k < 288) x = gup[(k - 128) * 512 + (n - 1024)]; }
              v[j] = x; }
          u32x4 o; o.x = cvt_pk_bf16(v[0], v[1]); o.y = cvt_pk_bf16(v[2], v[3]); o.z = cvt_pk_bf16(v[4], v[5]); o.w = cvt_pk_bf16(v[6], v[7]); LT[i] = o; } }
    for (int m = gw; m < M + MM; m += NGW) {
        if (m < M) rms_row_to_bf16((const float*)a.in[I_X] + (size_t)m * D, (bf16_t*)(ws + WS_ACTA) + (size_t)m * D, lane);
        else rms_row_to_bf16((const float*)a.in[I_MEM] + (size_t)(m - M) * D, (bf16_t*)(ws + WS_MEMN) + (size_t)(m - M) * D, lane);
    }
    { const int* pos = (const int*)a.in[I_POS]; f32x2* T = (f32x2*)(ws + WS_ROPE);
      for (int i = gt; i < M * 32; i += NGT) { const int m = i >> 5, f = i & 31;
          const float inv = (float)exp2(-(double)f * (13.287712379549449 / 32.0));
          const float ang = (float)pos[m] * inv;
          double rev = (double)ang * 0.15915494309189535; rev -= rint(rev);
          const float rv = (float)rev;
          T[i] = (f32x2){__builtin_amdgcn_cosf(rv), __builtin_amdgcn_sinf(rv)}; } }
}

__device__ __forceinline__ void p0_late_weights(LAS unsigned char* lds, int wg, int nwg) {
    const Args a = load_args(); TIDS();
    unsigned char* ws = a.ws;
    LAS float* scr = (LAS float*)(lds + wave * 16384);
    const int gw = wg * NWAVES + wave, NGW = nwg * NWAVES;
    constexpr int I_SQ = 16 * 32, I_UP = 16 * 128, I_DN = 64 * 32;
    constexpr int NITEMS = 3 * I_SQ + I_UP + I_DN;
    for (int it = gw; it < NITEMS; it += NGW) {
        int r = it;
        if (r < I_SQ) { p0_transpose_item((const float*)a.in[I_WOUT], D, D, nullptr, (bf16_t*)(ws + WS_WOUT), 0, scr, r, lane); continue; } r -= I_SQ;
        if (r < I_SQ) { p0_transpose_item((const float*)a.in[I_WQ], D, D, (const float*)a.in[I_NXA], (bf16_t*)(ws + WS_WQ), 0, scr, r, lane); continue; } r -= I_SQ;
        if (r < I_SQ) { p0_transpose_item((const float*)a.in[I_WO], D, D, nullptr, (bf16_t*)(ws + WS_WO), 0, scr, r, lane); continue; } r -= I_SQ;
        if (r < I_UP) { p0_transpose_item((const float*)a.in[I_MUP], D, FF, (const float*)a.in[I_NMLP], (bf16_t*)(ws + WS_WUP), 0, scr, r, lane); continue; } r -= I_UP;
        p0_transpose_item((const float*)a.in[I_MDN], FF, D, nullptr, (bf16_t*)(ws + WS_WDN), 0, scr, r, lane);
    }
}

__device__ __forceinline__ void phase_lora_in() {
    const Args a = load_args(); TIDS();
    const bf16_t* P = (const bf16_t*)(a.ws + WS_P); bf16_t* L = (bf16_t*)(a.ws + WS_ACTB); const float* mu = (const float*)a.in[I_MU] + 1536;
    const int gt = blockIdx.x * 512 + tid, NGT = gridDim.x * 512;
    for (int i = gt; i < M * (LK / 8); i += NGT) { const int m = i / (LK / 8), c8 = i % (LK / 8), c = 8 * c8; u32x4 o = (u32x4){0u, 0u, 0u, 0u};
        if (c < 288) { const u32x4 cur = *(const u32x4*)(P + (size_t)m * NP + C_LORA + c); u32x4 prv = (u32x4){0u, 0u, 0u, 0u}; if ((m & (SEQ - 1)) != 0) prv = *(const u32x4*)(P + (size_t)(m - 1) * NP + C_LORA + c);
            const f32x4 mu0 = *(const f32x4*)(mu + c), mu1 = *(const f32x4*)(mu + c + 4); float v[8];
#pragma unroll
            for (int j = 0; j < 4; ++j) { const float c0 = bflo(cur[j]), c1 = bfhi(cur[j]), p0 = bflo(prv[j]), p1 = bfhi(prv[j]); const float m0 = j < 2 ? mu0[2 * j] : mu1[2 * j - 4], m1 = j < 2 ? mu0[2 * j + 1] : mu1[2 * j - 3];
                v[2 * j] = c0 + (p0 - c0) * m0; v[2 * j + 1] = c1 + (p1 - c1) * m1; }
            if (c < 64) {
#pragma unroll
                for (int j = 0; j < 8; ++j) v[j] = tanhf(v[j]); }
            else if (c >= 128) {
#pragma unroll
                for (int j = 0; j < 8; ++j) v[j] = sigmoidf_(v[j]); }
            o.x = cvt_pk_bf16(v[0], v[1]); o.y = cvt_pk_bf16(v[2], v[3]); o.z = cvt_pk_bf16(v[4], v[5]); o.w = cvt_pk_bf16(v[6], v[7]); }
        *(u32x4*)(L + (size_t)m * LK + c) = o; }
}

typedef short bf16x4 __attribute__((ext_vector_type(4)));
template <int CTRL> __device__ __forceinline__ float dpp_add(float v) { return v + __builtin_bit_cast(float, __builtin_amdgcn_update_dpp(0, __builtin_bit_cast(int, v), CTRL, 0xf, 0xf, false)); }
__device__ __forceinline__ float red16(float v) { v = dpp_add<0xB1>(v); v = dpp_add<0x4E>(v); v = dpp_add<0x141>(v); v = dpp_add<0x140>(v); return v; }
__device__ __forceinline__ float wave_sum_fast(float v) { v = red16(v);
    const int iv = __builtin_bit_cast(int, v);
    return (__builtin_bit_cast(float, __builtin_amdgcn_readlane(iv, 0)) + __builtin_bit_cast(float, __builtin_amdgcn_readlane(iv, 16))) + (__builtin_bit_cast(float, __builtin_amdgcn_readlane(iv, 32)) + __builtin_bit_cast(float, __builtin_amdgcn_readlane(iv, 48))); }
__device__ __forceinline__ bf16x4 pack4(const f32x4 v) { u32x2 w; w.x = cvt_pk_bf16(v[0], v[1]); w.y = cvt_pk_bf16(v[2], v[3]); return __builtin_bit_cast(bf16x4, w); }
__device__ __forceinline__ bf16x8 pack8(const f32x4 a, const f32x4 b) { u32x4 w; w.x = cvt_pk_bf16(a[0], a[1]); w.y = cvt_pk_bf16(a[2], a[3]); w.z = cvt_pk_bf16(b[0], b[1]); w.w = cvt_pk_bf16(b[2], b[3]); return __builtin_bit_cast(bf16x8, w); }
__device__ __forceinline__ unsigned short f2bf(float v) { return (unsigned short)(cvt_pk_bf16(v, 0.f) & 0xffffu); }

__device__ __forceinline__ void rwkv_chunk_wg(LAS unsigned char* lds, int bh) {
    const Args a = load_args(); TIDS();
    const int b = bh >> 3, h = bh & 7;
    constexpr int RS = 144;
    constexpr int SLOT = 13120, O_AT = 0, O_RT = 2304, O_BHT = 4608, O_KHT = 6656, O_VT = 8704, O_CAK = 10752, O_TT = 11264, O_CBR = 11776, O_CKR = 12288, O_PL = 12800, O_RKB = 13056;
    constexpr int SCR0 = 8 * SLOT, SCR = 5632, O_BT = 0, O_KT = 2304, O_NF = 4608, O_RK = 0  ;
    constexpr int STAT0 = SCR0 + 4 * SCR;
    static_assert(STAT0 + 4096 <= 131072 + 512, "rwkv LDS map (the barrier set-up words sit at 131072 + 512)");
    constexpr int NCH = SEQ / 16, NST = NCH / 4;
    const size_t m0 = (size_t)b * SEQ;
    const int li = lane & 15, lq = lane >> 4;
    if (wave < 4) {
        const int rt = wave, vch = 64 * h + 16 * rt + li;
        const bf16_t* GG = (const bf16_t*)((const unsigned char*)a.out + DO_GG); bf16_t* Y = (bf16_t*)(a.ws + WS_ACTA);
        const float gw = ((const float*)a.in[I_WGNW])[vch], gb = ((const float*)a.in[I_WGNB])[vch];
        f32x4 S[4];
#pragma unroll
        for (int kt = 0; kt < 4; ++kt) S[kt] = (f32x4){0.f, 0.f, 0.f, 0.f};
        const f32x4 zero4 = (f32x4){0.f, 0.f, 0.f, 0.f};
        f32x4 ys[4], rkbs[4]; bf16x4 vts[4];
#pragma unroll
        for (int q = 0; q < 4; ++q) { ys[q] = zero4; rkbs[q] = zero4; vts[q] = (bf16x4){0, 0, 0, 0}; }
        for (int g = 0; g <= NST + 1; ++g) {
            unsigned short gs[4][4];
            if (g >= 2) {
#pragma unroll
                for (int q = 0; q < 4; ++q) { const bf16_t* gp = GG + (m0 + 16 * (4 * (g - 2) + q) + 4 * lq) * 512 + vch;
#pragma unroll
                    for (int r = 0; r < 4; ++r) gs[q][r] = gp[r * 512]; }
            } else {
#pragma unroll
                for (int q = 0; q < 4; ++q)
#pragma unroll
                    for (int r = 0; r < 4; ++r) gs[q][r] = 0;
            }
            f32x4 yn[4], rkbn[4]; bf16x4 vtn[4];
#pragma unroll
            for (int q = 0; q < 4; ++q) { yn[q] = zero4; rkbn[q] = zero4; vtn[q] = (bf16x4){0, 0, 0, 0}; }
            if (g >= 1 && g <= NST) {
#pragma unroll
                for (int q = 0; q < 4; ++q) {
                    LAS unsigned char* sl = lds + (((g - 1) & 1) * 4 + q) * SLOT;
                    const bf16x8 sf0 = pack8(S[0], S[1]), sf1 = pack8(S[2], S[3]);
                    const bf16x8 a0 = *(const LAS bf16x8*)(sl + O_AT + li * RS + 16 * lq), a1 = *(const LAS bf16x8*)(sl + O_AT + li * RS + 64 + 16 * lq);
                    const bf16x8 r0 = *(const LAS bf16x8*)(sl + O_RT + li * RS + 16 * lq), r1 = *(const LAS bf16x8*)(sl + O_RT + li * RS + 64 + 16 * lq);
                    const bf16x4 cak = *(const LAS bf16x4*)(sl + O_CAK + li * 32 + 8 * lq), tt = *(const LAS bf16x4*)(sl + O_TT + li * 32 + 8 * lq);
                    const bf16x4 cbr = *(const LAS bf16x4*)(sl + O_CBR + li * 32 + 8 * lq), ckr = *(const LAS bf16x4*)(sl + O_CKR + li * 32 + 8 * lq);
                    const bf16x4 vt = *(const LAS bf16x4*)(sl + O_VT + (16 * rt + li) * 32 + 8 * lq);
                    rkbn[q] = *(const LAS f32x4*)(sl + O_RKB + 16 * lq);
                    f32x4 z = __builtin_amdgcn_mfma_f32_16x16x32_bf16(a0, sf0, zero4, 0, 0, 0); z = __builtin_amdgcn_mfma_f32_16x16x32_bf16(a1, sf1, z, 0, 0, 0);
                    z = __builtin_amdgcn_mfma_f32_16x16x16bf16_1k(cak, vt, z, 0, 0, 0);
                    const bf16x4 zf = pack4(z);
                    const f32x4 u = __builtin_amdgcn_mfma_f32_16x16x16bf16_1k(tt, zf, zero4, 0, 0, 0);
                    const bf16x4 uf = pack4(u);
                    f32x4 y = __builtin_amdgcn_mfma_f32_16x16x32_bf16(r0, sf0, zero4, 0, 0, 0); y = __builtin_amdgcn_mfma_f32_16x16x32_bf16(r1, sf1, y, 0, 0, 0);
                    y = __builtin_amdgcn_mfma_f32_16x16x16bf16_1k(ckr, vt, y, 0, 0, 0); y = __builtin_amdgcn_mfma_f32_16x16x16bf16_1k(cbr, uf, y, 0, 0, 0);
#pragma unroll
                    for (int kt = 0; kt < 4; ++kt) { const f32x4 pl = *(const LAS f32x4*)(sl + O_PL + (16 * kt + 4 * lq) * 4);
                        const bf16x4 bhf = *(const LAS bf16x4*)(sl + O_BHT + (16 * kt + li) * 32 + 8 * lq), khf = *(const LAS bf16x4*)(sl + O_KHT + (16 * kt + li) * 32 + 8 * lq);
                        f32x4 acc = S[kt] * pl; acc = __builtin_amdgcn_mfma_f32_16x16x16bf16_1k(khf, vt, acc, 0, 0, 0); acc = __builtin_amdgcn_mfma_f32_16x16x16bf16_1k(bhf, uf, acc, 0, 0, 0); S[kt] = acc; }
                    yn[q] = y; vtn[q] = vt;
                    LAS float* st = (LAS float*)(lds + STAT0 + (g & 1) * 2048 + q * 512);
#pragma unroll
                    for (int r = 0; r < 4; ++r) { const float s1 = red16(y[r]), s2 = red16(y[r] * y[r]); if (li == 0) { f32x2 w2 = {s1, s2}; *(LAS f32x2*)(st + (4 * lq + r) * 8 + 2 * rt) = w2; } }
                }
            }
            if (g >= 2) {
#pragma unroll
                for (int q = 0; q < 4; ++q) { const int c = 4 * (g - 2) + q; const LAS float* st = (const LAS float*)(lds + STAT0 + ((g - 1) & 1) * 2048 + q * 512);
#pragma unroll
                    for (int r = 0; r < 4; ++r) { const int t = 4 * lq + r; const f32x4 p0 = *(const LAS f32x4*)(st + t * 8), p1 = *(const LAS f32x4*)(st + t * 8 + 4);
                        const float mean = ((p0[0] + p0[2]) + (p1[0] + p1[2])) * (1.f / 64.f), ex2 = ((p0[1] + p0[3]) + (p1[1] + p1[3])) * (1.f / 64.f);
                        const float rstd = __builtin_amdgcn_rsqf(fmaxf(ex2 - mean * mean, 0.f) + 64e-5f);
                        const float vv = bf2f((unsigned short)vts[q][r]);
                        const float o = ((ys[q][r] - mean) * rstd * gw + gb + rkbs[q][r] * vv) * bf2f(gs[q][r]);
                        Y[(m0 + 16 * c + t) * D + 512 + vch] = f2bf(o); } }
            }
#pragma unroll
            for (int q = 0; q < 4; ++q) { ys[q] = yn[q]; rkbs[q] = rkbn[q]; vts[q] = vtn[q]; }
            __syncthreads();
        }
    } else {
        const int pw = wave - 4, ci = 64 * h + lane;
        const bf16_t* P = (const bf16_t*)(a.ws + WS_P);
        const float* LW = (const float*)((const unsigned char*)a.out + DO_LW); const bf16_t* ASIG = (const bf16_t*)((const unsigned char*)a.out + DO_ASIG);
        const float* mu = (const float*)a.in[I_MU];
        const float mu_r = mu[ci], mu_k = mu[512 + ci], mu_v = mu[1024 + ci], kkc = ((const float*)a.in[I_KK])[ci], kac = ((const float*)a.in[I_KA])[ci], rkc = ((const float*)a.in[I_RK])[ci];
        const int kpos = (lane & 32) + 8 * ((lane >> 2) & 3) + 4 * ((lane >> 4) & 1) + (lane & 3);
        LAS unsigned char* scr = lds + SCR0 + pw * SCR;
        unsigned short x_r[16], x_k[16], x_v[16], x_a[16]; float x_w[16]; unsigned short p_r, p_k, p_v;
#define RW_LOAD(c) do { const size_t mb = m0 + 16 * (c); const bf16_t* pc = P + mb * NP + C_RK + ci; \
        _Pragma("unroll") for (int t = 0; t < 16; ++t) { x_r[t] = pc[(size_t)t * NP]; x_k[t] = pc[(size_t)t * NP + 512]; x_v[t] = pc[(size_t)t * NP + 1024]; x_a[t] = ASIG[(mb + t) * 512 + ci]; x_w[t] = LW[(mb + t) * 512 + ci]; } \
        if ((c) > 0) { p_r = pc[-NP]; p_k = pc[512 - NP]; p_v = pc[1024 - NP]; } else { p_r = 0; p_k = 0; p_v = 0; } } while (0)
        RW_LOAD(pw);
        for (int g = 0; g <= NST + 1; ++g) {
            if (g < NST) {
                const int c = 4 * g + pw; LAS unsigned char* sl = lds + ((g & 1) * 4 + pw) * SLOT;
                float Bt[16], Kt[16], Vv[16], Rk[16];
                float cum = 0.f, ecp = 1.f, prr = bf2f(p_r), prk = bf2f(p_k), prv = bf2f(p_v);
#pragma unroll
                for (int t = 0; t < 16; ++t) {
                    const float cr = bf2f(x_r[t]), ck = bf2f(x_k[t]), cv = bf2f(x_v[t]);
                    const float r = cr + (prr - cr) * mu_r, k0 = ck + (prk - ck) * mu_k, v = cv + (prv - cv) * mu_v; prr = cr; prk = ck; prv = cv;
                    const float asg = bf2f(x_a[t]); const float kkr = k0 * kkc; const float kk = kkr * __builtin_amdgcn_rsqf(fmaxf(wave_sum_fast(kkr * kkr), 1e-24f));
                    const float kx = k0 * (1.0f + (asg - 1.0f) * kac), bb = kk * asg;
                    cum += x_w[t]; const float ec = __expf(cum), eci = __builtin_amdgcn_rcpf(ec);
                    const float at = -kk * ecp, bt = bb * eci, kt = kx * eci, rtl = r * ec; ecp = ec;
                    *(LAS unsigned short*)(sl + O_AT + t * RS + 2 * kpos) = f2bf(at); *(LAS unsigned short*)(sl + O_RT + t * RS + 2 * kpos) = f2bf(rtl);
                    *(LAS unsigned short*)(scr + O_BT + t * RS + 2 * kpos) = f2bf(bt); *(LAS unsigned short*)(scr + O_KT + t * RS + 2 * kpos) = f2bf(kt);
                    Bt[t] = bt; Kt[t] = kt; Vv[t] = v; Rk[t] = rtl * rkc;
                }
                const float pl = ecp;
                *(LAS float*)(sl + O_PL + 4 * lane) = pl;
                { u32x4 w0, w1;
                  w0.x = cvt_pk_bf16(Bt[0] * pl, Bt[1] * pl); w0.y = cvt_pk_bf16(Bt[2] * pl, Bt[3] * pl); w0.z = cvt_pk_bf16(Bt[4] * pl, Bt[5] * pl); w0.w = cvt_pk_bf16(Bt[6] * pl, Bt[7] * pl);
                  w1.x = cvt_pk_bf16(Bt[8] * pl, Bt[9] * pl); w1.y = cvt_pk_bf16(Bt[10] * pl, Bt[11] * pl); w1.z = cvt_pk_bf16(Bt[12] * pl, Bt[13] * pl); w1.w = cvt_pk_bf16(Bt[14] * pl, Bt[15] * pl);
                  *(LAS u32x4*)(sl + O_BHT + lane * 32) = w0; *(LAS u32x4*)(sl + O_BHT + lane * 32 + 16) = w1;
                  w0.x = cvt_pk_bf16(Kt[0] * pl, Kt[1] * pl); w0.y = cvt_pk_bf16(Kt[2] * pl, Kt[3] * pl); w0.z = cvt_pk_bf16(Kt[4] * pl, Kt[5] * pl); w0.w = cvt_pk_bf16(Kt[6] * pl, Kt[7] * pl);
                  w1.x = cvt_pk_bf16(Kt[8] * pl, Kt[9] * pl); w1.y = cvt_pk_bf16(Kt[10] * pl, Kt[11] * pl); w1.z = cvt_pk_bf16(Kt[12] * pl, Kt[13] * pl); w1.w = cvt_pk_bf16(Kt[14] * pl, Kt[15] * pl);
                  *(LAS u32x4*)(sl + O_KHT + lane * 32) = w0; *(LAS u32x4*)(sl + O_KHT + lane * 32 + 16) = w1;
                  w0.x = cvt_pk_bf16(Vv[0], Vv[1]); w0.y = cvt_pk_bf16(Vv[2], Vv[3]); w0.z = cvt_pk_bf16(Vv[4], Vv[5]); w0.w = cvt_pk_bf16(Vv[6], Vv[7]);
                  w1.x = cvt_pk_bf16(Vv[8], Vv[9]); w1.y = cvt_pk_bf16(Vv[10], Vv[11]); w1.z = cvt_pk_bf16(Vv[12], Vv[13]); w1.w = cvt_pk_bf16(Vv[14], Vv[15]);
                  *(LAS u32x4*)(sl + O_VT + lane * 32) = w0; *(LAS u32x4*)(sl + O_VT + lane * 32 + 16) = w1; }
                if (g + 1 < NST) RW_LOAD(c + 4);
                const bf16x8 af0 = *(const LAS bf16x8*)(sl + O_AT + li * RS + 16 * lq), af1 = *(const LAS bf16x8*)(sl + O_AT + li * RS + 64 + 16 * lq);
                const bf16x8 rf0 = *(const LAS bf16x8*)(sl + O_RT + li * RS + 16 * lq), rf1 = *(const LAS bf16x8*)(sl + O_RT + li * RS + 64 + 16 * lq);
                const bf16x8 bf0 = *(const LAS bf16x8*)(scr + O_BT + li * RS + 16 * lq), bf1 = *(const LAS bf16x8*)(scr + O_BT + li * RS + 64 + 16 * lq);
                const bf16x8 kf0 = *(const LAS bf16x8*)(scr + O_KT + li * RS + 16 * lq), kf1 = *(const LAS bf16x8*)(scr + O_KT + li * RS + 64 + 16 * lq);
                const f32x4 zero4 = (f32x4){0.f, 0.f, 0.f, 0.f};
                f32x4 nn = __builtin_amdgcn_mfma_f32_16x16x32_bf16(bf0, af0, zero4, 0, 0, 0); nn = __builtin_amdgcn_mfma_f32_16x16x32_bf16(bf1, af1, nn, 0, 0, 0);
                f32x4 ca = __builtin_amdgcn_mfma_f32_16x16x32_bf16(kf0, af0, zero4, 0, 0, 0); ca = __builtin_amdgcn_mfma_f32_16x16x32_bf16(kf1, af1, ca, 0, 0, 0);
                f32x4 cb = __builtin_amdgcn_mfma_f32_16x16x32_bf16(bf0, rf0, zero4, 0, 0, 0); cb = __builtin_amdgcn_mfma_f32_16x16x32_bf16(bf1, rf1, cb, 0, 0, 0);
                f32x4 ck = __builtin_amdgcn_mfma_f32_16x16x32_bf16(kf0, rf0, zero4, 0, 0, 0); ck = __builtin_amdgcn_mfma_f32_16x16x32_bf16(kf1, rf1, ck, 0, 0, 0);
#pragma unroll
                for (int t = 0; t < 16; ++t) *(LAS unsigned short*)(scr + O_RK + t * RS + 2 * kpos) = f2bf(Rk[t]);
                const bf16x8 qf0 = *(const LAS bf16x8*)(scr + O_RK + li * RS + 16 * lq), qf1 = *(const LAS bf16x8*)(scr + O_RK + li * RS + 64 + 16 * lq);
                f32x4 dk = __builtin_amdgcn_mfma_f32_16x16x32_bf16(kf0, qf0, zero4, 0, 0, 0); dk = __builtin_amdgcn_mfma_f32_16x16x32_bf16(kf1, qf1, dk, 0, 0, 0);
                if (lq == (li >> 2)) { const int e = li & 3; *(LAS float*)(sl + O_RKB + 4 * li) = e == 0 ? dk[0] : (e == 1 ? dk[1] : (e == 2 ? dk[2] : dk[3])); }
#pragma unroll
                for (int r = 0; r < 4; ++r) { const int i = 4 * lq + r; const bool lt = i < li, le = i <= li;
                    nn[r] = lt ? nn[r] : 0.f; ca[r] = lt ? ca[r] : 0.f; cb[r] = le ? cb[r] : 0.f; ck[r] = le ? ck[r] : 0.f;
                    *(LAS float*)(scr + O_NF + (i * 16 + li) * 4) = nn[r]; }
                *(LAS bf16x4*)(sl + O_CAK + li * 32 + 8 * lq) = pack4(ca); *(LAS bf16x4*)(sl + O_CBR + li * 32 + 8 * lq) = pack4(cb); *(LAS bf16x4*)(sl + O_CKR + li * 32 + 8 * lq) = pack4(ck);
                { float T[16]; int li2 = li; asm volatile("" : "+v"(li2));
#pragma unroll
                  for (int t = 0; t < 16; ++t) T[t] = (t == li2) ? 1.f : 0.f;
#pragma unroll
                  for (int j = 0; j < 15; ++j) {
#pragma unroll
                      for (int t4 = (j + 1) / 4; t4 < 4; ++t4) { const f32x4 nr = *(const LAS f32x4*)(scr + O_NF + (j * 16 + 4 * t4) * 4);
#pragma unroll
                          for (int e = 0; e < 4; ++e) { const int t = 4 * t4 + e; if (t > j) T[t] += T[j] * nr[e]; } } }
                  if (lane < 16) {
#pragma unroll
                      for (int t = 0; t < 16; ++t) *(LAS unsigned short*)(sl + O_TT + (t * 16 + lane) * 2) = f2bf(T[t]); } }
            }
            __syncthreads();
        }
#undef RW_LOAD
    }
}

__device__ __forceinline__ void retention_wg(LAS unsigned char* lds, int bh) {
    const Args a = load_args(); TIDS();
    const int b = bh >> 3, h = bh & 7;
    constexpr int QS_ = 72, TS_ = 136;
    LAS bf16_t* Qs = (LAS bf16_t*)lds;
    LAS bf16_t* Ks = Qs + 128 * QS_;
    LAS bf16_t* KzT = Ks + 128 * QS_;
    LAS bf16_t* VT = KzT + 64 * TS_;
    LAS bf16_t* Ps = VT + 64 * TS_;
    LAS bf16_t* RT = Ps + 128 * TS_;
    const bf16_t* P = (const bf16_t*)(a.ws + WS_P); const f32x2* ROPE = (const f32x2*)(a.ws + WS_ROPE); bf16_t* Y = (bf16_t*)(a.ws + WS_ACTA);
    const float* gnw = (const float*)a.in[I_RGNW]; const float* gnb = (const float*)a.in[I_RGNB];
    const float lg2 = log2f(1.0f - exp2f(-5.0f - (float)h));
    const float gch = exp2f(128.0f * lg2);
    for (int i = tid; i < 64 * QS_ / 2; i += 512) ((LAS unsigned*)RT)[i] = 0u;
    const int tk = tid >> 2, qd = tid & 3;
    const float zeta = exp2f((float)(127 - tk) * lg2);
    const int li = lane & 15, lq = lane >> 4, i0 = 16 * wave;
    const float xi = exp2f((float)(i0 + li + 1) * lg2);
    f32x4 Rst[2]; Rst[0] = (f32x4){0.f, 0.f, 0.f, 0.f}; Rst[1] = Rst[0];
    u32x4 gq1, gq2, gk1, gk2, gv1, gv2; f32x4 gr[4];
#define RT_LOAD(n) do { const size_t m = (size_t)b * SEQ + (n) * 128 + tk; const bf16_t* pr = P + m * NP + 64 * h; \
        gq1 = *(const u32x4*)(pr + 8 * qd); gq2 = *(const u32x4*)(pr + 32 + 8 * qd); gk1 = *(const u32x4*)(pr + 512 + 8 * qd); gk2 = *(const u32x4*)(pr + 544 + 8 * qd); \
        gv1 = *(const u32x4*)(pr + 1024 + 16 * qd); gv2 = *(const u32x4*)(pr + 1032 + 16 * qd); \
        const f32x4* rp = (const f32x4*)(ROPE + m * 32 + 8 * qd); gr[0] = rp[0]; gr[1] = rp[1]; gr[2] = rp[2]; gr[3] = rp[3]; } while (0)
    RT_LOAD(0);
    for (int n = 0; n < SEQ / 128; ++n) {
        { float q1[8], q2[8], k1[8], k2[8];
#pragma unroll
          for (int j = 0; j < 4; ++j) { q1[2 * j] = bflo(gq1[j]); q1[2 * j + 1] = bfhi(gq1[j]); q2[2 * j] = bflo(gq2[j]); q2[2 * j + 1] = bfhi(gq2[j]);
              k1[2 * j] = bflo(gk1[j]); k1[2 * j + 1] = bfhi(gk1[j]); k2[2 * j] = bflo(gk2[j]); k2[2 * j + 1] = bfhi(gk2[j]); }
          float oq1[8], oq2[8], ok1[8], ok2[8];
#pragma unroll
          for (int j = 0; j < 8; ++j) { const float cs = gr[j >> 1][2 * (j & 1)], sn = gr[j >> 1][2 * (j & 1) + 1];
              oq1[j] = q1[j] * cs - q2[j] * sn; oq2[j] = q2[j] * cs + q1[j] * sn;
              ok1[j] = (k1[j] * cs - k2[j] * sn) * 0.125f; ok2[j] = (k2[j] * cs + k1[j] * sn) * 0.125f; }
          u32x4 w;
          w.x = cvt_pk_bf16(oq1[0], oq1[1]); w.y = cvt_pk_bf16(oq1[2], oq1[3]); w.z = cvt_pk_bf16(oq1[4], oq1[5]); w.w = cvt_pk_bf16(oq1[6], oq1[7]); *(LAS u32x4*)(Qs + tk * QS_ + 8 * qd) = w;
          w.x = cvt_pk_bf16(oq2[0], oq2[1]); w.y = cvt_pk_bf16(oq2[2], oq2[3]); w.z = cvt_pk_bf16(oq2[4], oq2[5]); w.w = cvt_pk_bf16(oq2[6], oq2[7]); *(LAS u32x4*)(Qs + tk * QS_ + 32 + 8 * qd) = w;
          w.x = cvt_pk_bf16(ok1[0], ok1[1]); w.y = cvt_pk_bf16(ok1[2], ok1[3]); w.z = cvt_pk_bf16(ok1[4], ok1[5]); w.w = cvt_pk_bf16(ok1[6], ok1[7]); *(LAS u32x4*)(Ks + tk * QS_ + 8 * qd) = w;
          w.x = cvt_pk_bf16(ok2[0], ok2[1]); w.y = cvt_pk_bf16(ok2[2], ok2[3]); w.z = cvt_pk_bf16(ok2[4], ok2[5]); w.w = cvt_pk_bf16(ok2[6], ok2[7]); *(LAS u32x4*)(Ks + tk * QS_ + 32 + 8 * qd) = w;
#pragma unroll
          for (int j = 0; j < 8; ++j) { KzT[(8 * qd + j) * TS_ + tk] = (bf16_t)(cvt_pk_bf16(ok1[j] * zeta, 0.f) & 0xffffu); KzT[(32 + 8 * qd + j) * TS_ + tk] = (bf16_t)(cvt_pk_bf16(ok2[j] * zeta, 0.f) & 0xffffu); }
#pragma unroll
          for (int j = 0; j < 4; ++j) { VT[(16 * qd + 2 * j) * TS_ + tk] = (bf16_t)(gv1[j] & 0xffffu); VT[(16 * qd + 2 * j + 1) * TS_ + tk] = (bf16_t)(gv1[j] >> 16);
              VT[(16 * qd + 8 + 2 * j) * TS_ + tk] = (bf16_t)(gv2[j] & 0xffffu); VT[(16 * qd + 8 + 2 * j + 1) * TS_ + tk] = (bf16_t)(gv2[j] >> 16); } }
        if (n + 1 < SEQ / 128) RT_LOAD(n + 1);
        __syncthreads();
        bf16x8 qf[2];
        qf[0] = *(const LAS bf16x8*)(Qs + (i0 + li) * QS_ + 8 * lq); qf[1] = *(const LAS bf16x8*)(Qs + (i0 + li) * QS_ + 32 + 8 * lq);
        const int nks = (wave + 2) >> 1;
        for (int jt = 0; jt < 2 * nks; ++jt) {
            f32x4 s = (f32x4){0.f, 0.f, 0.f, 0.f};
            if (jt <= wave) {
                const bf16x8 kf0 = *(const LAS bf16x8*)(Ks + (16 * jt + li) * QS_ + 8 * lq), kf1 = *(const LAS bf16x8*)(Ks + (16 * jt + li) * QS_ + 32 + 8 * lq);
                s = __builtin_amdgcn_mfma_f32_16x16x32_bf16(kf0, qf[0], s, 0, 0, 0); s = __builtin_amdgcn_mfma_f32_16x16x32_bf16(kf1, qf[1], s, 0, 0, 0);
#pragma unroll
                for (int r = 0; r < 4; ++r) { const int dj = (i0 + li) - (16 * jt + 4 * lq + r); s[r] = dj >= 0 ? s[r] * exp2f((float)dj * lg2) : 0.f; }
            }
            u32x2 w; w.x = cvt_pk_bf16(s[0], s[1]); w.y = cvt_pk_bf16(s[2], s[3]);
            *(LAS u32x2*)(Ps + (i0 + li) * TS_ + 16 * jt + 4 * lq) = w;
        }
        f32x4 ai_[4], ax_[4];
#pragma unroll
        for (int et = 0; et < 4; ++et) { ai_[et] = (f32x4){0.f, 0.f, 0.f, 0.f}; ax_[et] = (f32x4){0.f, 0.f, 0.f, 0.f}; }
        for (int kk = 0; kk < nks; ++kk) { const bf16x8 pf = *(const LAS bf16x8*)(Ps + (i0 + li) * TS_ + 32 * kk + 8 * lq);
#pragma unroll
            for (int et = 0; et < 4; ++et) { const bf16x8 vf = *(const LAS bf16x8*)(VT + (16 * et + li) * TS_ + 32 * kk + 8 * lq); ai_[et] = __builtin_amdgcn_mfma_f32_16x16x32_bf16(vf, pf, ai_[et], 0, 0, 0); } }
#pragma unroll
        for (int kk = 0; kk < 2; ++kk)
#pragma unroll
            for (int et = 0; et < 4; ++et) { const bf16x8 rf = *(const LAS bf16x8*)(RT + (16 * et + li) * QS_ + 32 * kk + 8 * lq); ax_[et] = __builtin_amdgcn_mfma_f32_16x16x32_bf16(rf, qf[kk], ax_[et], 0, 0, 0); }
#pragma unroll
        for (int t2 = 0; t2 < 2; ++t2) { const int id = 2 * wave + t2, dt = id >> 2, et = id & 3; f32x4 kv = (f32x4){0.f, 0.f, 0.f, 0.f};
#pragma unroll
            for (int kk = 0; kk < 4; ++kk) { const bf16x8 kz = *(const LAS bf16x8*)(KzT + (16 * dt + li) * TS_ + 32 * kk + 8 * lq), vf = *(const LAS bf16x8*)(VT + (16 * et + li) * TS_ + 32 * kk + 8 * lq);
                kv = __builtin_amdgcn_mfma_f32_16x16x32_bf16(kz, vf, kv, 0, 0, 0); }
            Rst[t2] = Rst[t2] * gch + kv; }
        __syncthreads();
#pragma unroll
        for (int t2 = 0; t2 < 2; ++t2) { const int id = 2 * wave + t2, dt = id >> 2, et = id & 3; u32x2 w; w.x = cvt_pk_bf16(Rst[t2][0], Rst[t2][1]); w.y = cvt_pk_bf16(Rst[t2][2], Rst[t2][3]);
            *(LAS u32x2*)(RT + (16 * et + li) * QS_ + 16 * dt + 4 * lq) = w; }
        { float y[4][4]; float s = 0.f;
#pragma unroll
          for (int et = 0; et < 4; ++et)
#pragma unroll
              for (int r = 0; r < 4; ++r) { y[et][r] = ai_[et][r] + xi * ax_[et][r]; s += y[et][r]; }
          s += __shfl_xor(s, 16); s += __shfl_xor(s, 32); const float mean = s * (1.f / 64.f); float q = 0.f;
#pragma unroll
          for (int et = 0; et < 4; ++et)
#pragma unroll
              for (int r = 0; r < 4; ++r) { const float d = y[et][r] - mean; q += d * d; }
          q += __shfl_xor(q, 16); q += __shfl_xor(q, 32); const float rstd = 1.0f / sqrtf(q * (1.f / 64.f) + 1e-5f);
          const size_t m = (size_t)b * SEQ + n * 128 + i0 + li;
#pragma unroll
          for (int et = 0; et < 4; ++et) { const int e0 = 64 * h + 16 * et + 4 * lq; const u32x2 g2 = *(const u32x2*)(P + m * NP + 1536 + e0);
              const f32x4 gw4 = *(const f32x4*)(gnw + e0), gb4 = *(const f32x4*)(gnb + e0); float o[4];
              const float gg[4] = {bflo(g2.x), bfhi(g2.x), bflo(g2.y), bfhi(g2.y)};
#pragma unroll
              for (int r = 0; r < 4; ++r) { const float gn = (y[et][r] - mean) * rstd * gw4[r] + gb4[r]; o[r] = gg[r] * sigmoidf_(gg[r]) * gn; }
              u32x2 w; w.x = cvt_pk_bf16(o[0], o[1]); w.y = cvt_pk_bf16(o[2], o[3]); *(u32x2*)(Y + m * D + e0) = w; } }
    }
#undef RT_LOAD
}

__device__ __forceinline__ void phase_rwkv_fin() {
    const Args a = load_args(); TIDS();
    const bf16_t* P = (const bf16_t*)(a.ws + WS_P); const float* YRAW = (const float*)(a.ws + WS_ACTB); bf16_t* Y = (bf16_t*)(a.ws + WS_ACTA);
    const bf16_t* ASIG = (const bf16_t*)((const unsigned char*)a.out + DO_ASIG); const bf16_t* GG = (const bf16_t*)((const unsigned char*)a.out + DO_GG);
    const float* mu = (const float*)a.in[I_MU]; const float* ka = (const float*)a.in[I_KA]; const float* rk = (const float*)a.in[I_RK];
    const float* gnw = (const float*)a.in[I_WGNW]; const float* gnb = (const float*)a.in[I_WGNB];
    const int gw = blockIdx.x * NWAVES + wave, NGW = gridDim.x * NWAVES;
    for (int it = gw; it < M * 8; it += NGW) { const int m = it >> 3, h = it & 7, ci = 64 * h + lane;
        const float y = YRAW[(size_t)m * 512 + ci];
        const float mean = wave_sum(y) * (1.f / 64.f); const float d = y - mean; const float var = wave_sum(d * d) * (1.f / 64.f);
        const float yn = d * (1.0f / sqrtf(var + 64e-5f)) * gnw[ci] + gnb[ci];
        const bf16_t* pc = P + (size_t)m * NP + C_RK + ci;
        const float cr = bf2f(pc[0]), ck = bf2f(pc[512]), cv = bf2f(pc[1024]); float pr = 0.f, pk = 0.f, pv = 0.f;
        if ((m & (SEQ - 1)) != 0) { pr = bf2f(pc[-NP]); pk = bf2f(pc[512 - NP]); pv = bf2f(pc[1024 - NP]); }
        const float r = cr + (pr - cr) * mu[ci], k0 = ck + (pk - ck) * mu[512 + ci], v = cv + (pv - cv) * mu[1024 + ci];
        const float asg = bf2f(ASIG[(size_t)m * 512 + ci]); const float kx = k0 * (1.0f + (asg - 1.0f) * ka[ci]);
        const float bonus = wave_sum(r * kx * rk[ci]) * v;
        const float g = bf2f(GG[(size_t)m * 512 + ci]);
        Y[(size_t)m * D + 512 + ci] = (bf16_t)(cvt_pk_bf16((yn + bonus) * g, 0.f) & 0xffffu); }
}

#define XB_TMO      128
#define XB_XCNT(j)  (256  + 64 * (j))
#define XB_XSUB(j)  (1280 + 64 * (j))
#define XB_XGEN(j)  (2304 + 64 * (j))
#define XB_TOP      3328
#define XB_TOPGEN   3392
#define XCD_BAR_WORDS 3456
#define XB_SPIN_CAP (1u << 18)
__device__ __forceinline__ unsigned xb_ld(unsigned* p)              { return __hip_atomic_load(p, __ATOMIC_RELAXED, __HIP_MEMORY_SCOPE_AGENT); }
__device__ __forceinline__ unsigned xb_add(unsigned* p, unsigned v) { return __hip_atomic_fetch_add(p, v, __ATOMIC_RELAXED, __HIP_MEMORY_SCOPE_AGENT); }
__device__ __forceinline__ unsigned xb_xcc_id() { return (unsigned)__builtin_amdgcn_s_getreg((3 << 11) | 20) & 0xFu; }
#define XB_SPIN(cond, bar) do { unsigned _sp = 0; while (cond) { __builtin_amdgcn_s_sleep(1); \
    if ((++_sp & 255u) == 0u) { if (xb_ld(&(bar)[XB_TMO])) break; if (_sp > XB_SPIN_CAP) { atomicAdd(&(bar)[XB_TMO], 1u); break; } } } } while (0)
struct XcdBarrier { unsigned* bar; unsigned x; volatile LAS unsigned* st; };
__device__ __forceinline__ XcdBarrier xcd_barrier_post(unsigned* bar, volatile LAS unsigned* st) {
    XcdBarrier b; b.bar = bar; b.x = xb_xcc_id(); b.st = st;
    if (threadIdx.x == 0) (void)xb_add(&bar[XB_XCNT(b.x)], 1u);
    return b;
}
__device__ __forceinline__ void xcd_barrier_complete(unsigned* bar, unsigned x, unsigned& nloc, unsigned& nx) {
    const unsigned G = gridDim.x * gridDim.y * gridDim.z;
    unsigned sum, cnt, mine, sp = 0u;
    for (;;) {
        sum = 0u; cnt = 0u; mine = 0u;
#pragma unroll
        for (unsigned j = 0; j < 16; ++j) { const unsigned c = xb_ld(&bar[XB_XCNT(j)]); sum += c; cnt += (c > 0u) ? 1u : 0u; mine = (j == x) ? c : mine; }
        if (sum == G) break;
        __builtin_amdgcn_s_sleep(1);
        if ((++sp & 255u) == 0u) { if (xb_ld(&bar[XB_TMO])) break; if (sp > XB_SPIN_CAP) { atomicAdd(&bar[XB_TMO], 1u); break; } }
    }
    nloc = mine > 0u ? mine : 1u; nx = cnt > 0u ? cnt : 1u;
}
__device__ __forceinline__ void xcd_barrier(const XcdBarrier& b) {
    asm volatile("s_waitcnt vmcnt(0)" ::: "memory");
    __syncthreads();
    if (threadIdx.x == 0) {
        unsigned* bar = b.bar;
        __builtin_amdgcn_s_waitcnt(0);
        unsigned nloc = b.st[0], nx = b.st[1];
        if (nloc == 0u) { xcd_barrier_complete(bar, b.x, nloc, nx); b.st[0] = nloc; b.st[1] = nx; }
        const unsigned old = xb_add(&bar[XB_XSUB(b.x)], 1u);
        const unsigned gen = old / nloc;
        if (old + 1u == (gen + 1u) * nloc) {
            __builtin_amdgcn_fence(__ATOMIC_RELEASE, "agent");
            asm volatile("s_waitcnt vmcnt(0)" ::: "memory");
            const unsigned og = xb_add(&bar[XB_TOP], 1u);
            const unsigned tg = og / nx;
            if (og + 1u == (tg + 1u) * nx) xb_add(&bar[XB_TOPGEN], 1u);
            else XB_SPIN(xb_ld(&bar[XB_TOPGEN]) == tg, bar);
            __builtin_amdgcn_fence(__ATOMIC_ACQUIRE, "agent");
            xb_add(&bar[XB_XGEN(b.x)], 1u);
            asm volatile("s_waitcnt vmcnt(0)" ::: "memory");
        } else {
            XB_SPIN(xb_ld(&bar[XB_XGEN(b.x)]) == gen, bar);
            __builtin_amdgcn_fence(__ATOMIC_ACQUIRE, "agent");
            asm volatile("s_waitcnt vmcnt(0)" ::: "memory");
        }
    }
    __syncthreads();
}

__global__ void __launch_bounds__(NWAVES * 64, 2) mega(Args a_) {
    extern __shared__ __attribute__((aligned(16))) unsigned char lds_raw[];
    LAS unsigned char* lds = (LAS unsigned char*)lds_raw;
    cg::grid_group grid = cg::this_grid();
    const int G = gridDim.x, bx = blockIdx.x;
    volatile LAS unsigned* MISC = (volatile LAS unsigned*)(lds + 131072 + 512);
    if (threadIdx.x < 16) MISC[threadIdx.x] = 0u;
    __syncthreads();
    (void)xcd_barrier_post((unsigned*)a_.ws + 4096, MISC + 8);
#ifndef PHMASK
#define PHMASK 0xfff
#endif
#define IN(k) ((PHMASK >> (k)) & 1)
#define GSYNC() do { XcdBarrier xb_; xb_.bar = (unsigned*)load_args().ws + 4096; xb_.x = xb_xcc_id(); xb_.st = (volatile LAS unsigned*)(lds + 131072 + 512) + 8; xcd_barrier(xb_); } while (0)
#define SEAM(k) do { if (IN(k) && IN((k) + 1)) { if ((k) == 0) grid.sync(); else GSYNC(); } } while (0)
#define ARGS() const Args a = load_args(); unsigned char* ws = a.ws; (void)ws
#ifndef REPMASK
#define REPMASK 0
#endif
#ifndef NSYNC_EXTRA
#define NSYNC_EXTRA 0
#endif
#define REPS(k) (((REPMASK >> (k)) & 1) ? 2 : 1)
#define REPSYNC() do { if (rep) GSYNC(); } while (0)

    for (int i = 0; i < NSYNC_EXTRA; ++i) GSYNC();
    if (IN(0)) for (int rep = 0; rep < REPS(0); ++rep) { REPSYNC(); phase0(lds); }
    SEAM(0);
    if (IN(1)) for (int rep = 0; rep < REPS(1); ++rep) {   REPSYNC();
        ARGS();
        pg8::Gemm g{(const bf16_t*)(ws + WS_ACTA), (const bf16_t*)(ws + WS_WIN), D, D, D}; pg8::StaticOrder S; S.init(M, NP, G, bx);
        pg8::EpiStore<0, false> E{(bf16_t*)(ws + WS_P), NP, 1, 1, nullptr, 1.0f};
        pg8::gemm_phase<pg8::EpiStore<0, false>, pg8::StaticOrder, true>(lds, g, S, E);
    }
    SEAM(1);
    if (IN(2)) for (int rep = 0; rep < REPS(2); ++rep) { REPSYNC(); phase_lora_in(); }
    SEAM(2);
    if (IN(3)) for (int rep = 0; rep < REPS(3); ++rep) {   REPSYNC();
        ARGS();
        pg8::Gemm g{(const bf16_t*)(ws + WS_ACTB), (const bf16_t*)(ws + WS_LORA), LK, LK, LK}; pg8::StaticOrder S; S.init(M, LN, G, bx);
        pg8::EpiLora E{(float*)((unsigned char*)a.out + DO_LW), (bf16_t*)((unsigned char*)a.out + DO_ASIG), (bf16_t*)((unsigned char*)a.out + DO_GG), (const float*)a.in[I_W0], (const float*)a.in[I_A0]};
        pg8::gemm_phase<pg8::EpiLora, pg8::StaticOrder, true>(lds, g, S, E);
    }
    SEAM(3);
    if (IN(4)) for (int rep = 0; rep < REPS(4); ++rep) {   REPSYNC();
#ifndef REP_SCAN
#define REP_SCAN 1
#endif
#ifndef REP_RET
#define REP_RET 1
#endif
        if (bx < 64) { for (int r2 = 0; r2 < REP_SCAN; ++r2) { if (r2) __syncthreads(); rwkv_chunk_wg(lds, bx); } }
        else if (bx < 128) { for (int r2 = 0; r2 < REP_RET; ++r2) { if (r2) __syncthreads(); retention_wg(lds, bx - 64); } }
        else if (bx < 192) { ARGS(); const int idx = bx - 128;
            if (idx < 32) { pg8::Gemm g{(const bf16_t*)(ws + WS_MEMN), (const bf16_t*)(ws + WS_WKV), D, D, D}; pg8::OneUnit S{idx >> 2, idx & 3};
                pg8::EpiStore<0, false> E{(bf16_t*)(ws + WS_KM), D, 1, 1, nullptr, 1.0f}; pg8::gemm_phase<pg8::EpiStore<0, false>, pg8::OneUnit, true>(lds, g, S, E); }
            else { const int j = idx - 32; pg8::Gemm g{(const bf16_t*)(ws + WS_WKV) + (size_t)D * D, (const bf16_t*)(ws + WS_MEMN), D, D, D}; pg8::OneUnit S{j >> 3, j & 7};
                pg8::EpiStore<0, false> E{(bf16_t*)(ws + WS_VT), MM, 1, 1, nullptr, 1.0f}; pg8::gemm_phase<pg8::EpiStore<0, false>, pg8::OneUnit, true>(lds, g, S, E); } }
        else p0_late_weights(lds, bx - 192, G - 192);
    }
    SEAM(4);
    if (IN(6)) for (int rep = 0; rep < REPS(6); ++rep) {   REPSYNC();
        ARGS();
        pg8::Gemm g{(const bf16_t*)(ws + WS_ACTA), (const bf16_t*)(ws + WS_WOUT), D, D, D}; pg8::StaticOrder S; S.init(M, D, G, bx);
        pg8::EpiRes E{(const float*)a.in[I_X], a.out, (bf16_t*)(ws + WS_ACTB), (float*)(ws + WS_SQ1)};
        pg8::gemm_phase<pg8::EpiRes, pg8::StaticOrder, true>(lds, g, S, E);
    }
    SEAM(6);
    if (IN(7)) for (int rep = 0; rep < REPS(7); ++rep) {   REPSYNC();
        if (bx < 256) { ARGS(); const int u = bx; const int b = u >> 5, h4 = (u >> 3) & 3, qt = u & 7; const int pm = b * 8 + qt;
            bf16_t* QS = (bf16_t*)(ws + WS_P) + (size_t)u * 131072; bf16_t* PSb = QS + 65536;
            { pg8::Gemm g{(const bf16_t*)(ws + WS_ACTB), (const bf16_t*)(ws + WS_WQ), D, D, D}; pg8::OneUnit S{pm, h4};
              pg8::EpiStore<0, true> E{QS, 256, 0, 0, (const float*)(ws + WS_SQ1), 0.0625f}; pg8::gemm_phase<pg8::EpiStore<0, true>, pg8::OneUnit, true>(lds, g, S, E); }
            asm volatile("s_waitcnt vmcnt(0)" ::: "memory"); __syncthreads(); __builtin_amdgcn_fence(__ATOMIC_ACQUIRE, "agent"); asm volatile("s_waitcnt vmcnt(0)" ::: "memory"); __syncthreads();
            { pg8::Gemm g{QS, (const bf16_t*)(ws + WS_KM) + (size_t)(b * 256) * D + h4 * 256, 256, D, 256}; pg8::OneUnit S{0, 0};
              pg8::EpiSoftmax E{PSb}; pg8::gemm_phase<pg8::EpiSoftmax, pg8::OneUnit, false>(lds, g, S, E); }
            asm volatile("s_waitcnt vmcnt(0)" ::: "memory"); __syncthreads(); __builtin_amdgcn_fence(__ATOMIC_ACQUIRE, "agent"); asm volatile("s_waitcnt vmcnt(0)" ::: "memory"); __syncthreads();
            { pg8::Gemm g{PSb, (const bf16_t*)(ws + WS_VT) + (size_t)(h4 * 256) * MM + b * 256, 256, MM, 256}; pg8::OneUnit S{0, 0};
              pg8::EpiStore<0, false> E{(bf16_t*)(ws + WS_ACTA) + (size_t)(pm * 256) * D + h4 * 256, D, 0, 0, nullptr, 1.0f}; pg8::gemm_phase<pg8::EpiStore<0, false>, pg8::OneUnit, true>(lds, g, S, E); }
            __syncthreads();
        }
    }
    SEAM(7);
    if (IN(8)) {
        ARGS();
        pg8::Gemm g{(const bf16_t*)(ws + WS_ACTA), (const bf16_t*)(ws + WS_WO), D, D, D}; pg8::StaticOrder S; S.init(M, D, G, bx);
        pg8::EpiRes E{a.out, a.out, (bf16_t*)(ws + WS_ACTB), (float*)(ws + WS_SQ2)};
        pg8::gemm_phase<pg8::EpiRes, pg8::StaticOrder, true>(lds, g, S, E);
    }
    SEAM(8);
    if (IN(9)) for (int rep = 0; rep < REPS(9); ++rep) {   REPSYNC();
        ARGS();
        pg8::Gemm g{(const bf16_t*)(ws + WS_ACTB), (const bf16_t*)(ws + WS_WUP), D, D, D}; pg8::StaticOrder S; S.init(M, FF, G, bx);
        pg8::EpiStore<2, true> E{(bf16_t*)(ws + WS_P), FF, 1, 1, (const float*)(ws + WS_SQ2), 1.0f};
        pg8::gemm_phase<pg8::EpiStore<2, true>, pg8::StaticOrder, true>(lds, g, S, E);
    }
    SEAM(9);
    if (IN(10)) {
        ARGS();
        pg8::Gemm g{(const bf16_t*)(ws + WS_P), (const bf16_t*)(ws + WS_WDN), FF, FF, FF}; pg8::StaticOrder S; S.init(M, D, G, bx);
        pg8::EpiRes E{a.out, a.out, nullptr, (float*)(ws + WS_SQ3)};
        pg8::gemm_phase<pg8::EpiRes, pg8::StaticOrder, true>(lds, g, S, E);
    }
    SEAM(10);
    if (IN(11)) {
        ARGS(); TIDS();
        const float* sq = (const float*)(ws + WS_SQ3); const float* gf = (const float*)a.in[I_NFIN];
        const int gw = bx * NWAVES + wave, NGW = G * NWAVES;
        f32x4 gv[4];
#pragma unroll
        for (int j = 0; j < 4; ++j) gv[j] = ((const f32x4*)gf)[lane + 64 * j];
        for (int m = gw; m < M; m += NGW) { const f32x4* q4 = (const f32x4*)(sq + (size_t)m * 16); const f32x4 s = q4[0] + q4[1] + q4[2] + q4[3];
            const float rstd = 1.0f / sqrtf((s[0] + s[1] + s[2] + s[3]) * (1.f / 1024.f) + 1e-6f);
            f32x4* xr = (f32x4*)(a.out + (size_t)m * D) + lane;
#pragma unroll
            for (int j = 0; j < 4; ++j) xr[64 * j] = xr[64 * j] * rstd * gv[j]; }
    }
#undef IN
#undef SEAM
#undef ARGS
}

extern "C" void kernel_launch(void* const* d_in, const int* in_sizes, int n_in, void* d_out, int out_size, void* d_ws, size_t ws_size, hipStream_t stream) {
    static int grid = 0;
    if (grid == 0) {
        if (n_in != 28 || out_size != M * D || ws_size < WS_END) { fprintf(stderr, "kernel_launch: unexpected shapes (n_in %d out %d ws %zu)\n", n_in, out_size, ws_size); grid = -1; return; }
        int dev = 0, cus = 0, per_cu = 0;
        if (hipGetDevice(&dev) != hipSuccess || hipDeviceGetAttribute(&cus, hipDeviceAttributeMultiprocessorCount, dev) != hipSuccess) { grid = -1; return; }
        if (hipFuncSetAttribute((const void*)mega, hipFuncAttributeMaxDynamicSharedMemorySize, LDS_BYTES) != hipSuccess) { fprintf(stderr, "kernel_launch: hipFuncSetAttribute failed\n"); grid = -1; return; }
        if (hipOccupancyMaxActiveBlocksPerMultiprocessor(&per_cu, (const void*)mega, NWAVES * 64, LDS_BYTES) != hipSuccess || per_cu < 1) { fprintf(stderr, "kernel_launch: occupancy query says %d\n", per_cu); (void)hipGetLastError(); }
        grid = cus;
        if (grid != 256) fprintf(stderr, "kernel_launch: %d CUs (built for 256)\n", grid);
    }
    if (grid < 0) return;
    if (hipMemsetAsync(d_ws, 0, 65536, stream) != hipSuccess) { fprintf(stderr, "kernel_launch: memset failed\n"); return; }
    Args a{};
    for (int i = 0; i < 28; ++i) a.in[i] = d_in[i];
    a.out = (float*)d_out; a.ws = (unsigned char*)d_ws; a.ph_lo = 0; a.ph_hi = 12;
    void* args[] = {&a};
    hipError_t e = hipLaunchCooperativeKernel((const void*)mega, dim3(grid), dim3(NWAVES * 64), args, LDS_BYTES, stream);
    if (e != hipSuccess) fprintf(stderr, "cooperative launch failed: %s (grid %d)\n", hipGetErrorString(e), grid);
}
```

```cpp
#include <hip/hip_runtime.h>
#include <hip/hip_cooperative_groups.h>
#include <cstdio>
#include <cstdint>
namespace cg = cooperative_groups;
#define REPMASK 0
#define NSYNC_EXTRA 0
#define REP_SCAN 1
#define REP_RET 1

#define LAS __attribute__((address_space(3)))
typedef unsigned short bf16_t;
typedef short bf16x8 __attribute__((ext_vector_type(8)));
typedef float f32x4 __attribute__((ext_vector_type(4)));
typedef float f32x2 __attribute__((ext_vector_type(2)));
typedef unsigned u32x4 __attribute__((ext_vector_type(4)));
typedef unsigned u32x2 __attribute__((ext_vector_type(2)));

typedef __bf16 bf16x2_t __attribute__((ext_vector_type(2)));
__device__ __forceinline__ unsigned cvt_pk_bf16(float lo, float hi) { f32x2 v = {lo, hi}; bf16x2_t b = __builtin_convertvector(v, bf16x2_t); return __builtin_bit_cast(unsigned, b); }
__device__ __forceinline__ float bf2f(unsigned short b) { return __uint_as_float(((unsigned)b) << 16); }
__device__ __forceinline__ float bflo(unsigned w) { return __uint_as_float(w << 16); }
__device__ __forceinline__ float bfhi(unsigned w) { return __uint_as_float(w & 0xffff0000u); }
__device__ __forceinline__ float sigmoidf_(float x) { return __builtin_amdgcn_rcpf(1.0f + __expf(-x)); }
__device__ __forceinline__ float wave_sum(float v) {
#pragma unroll
    for (int o = 1; o < 64; o <<= 1) v += __shfl_xor(v, o);
    return v;
}

namespace pg8 {
constexpr int BM = 256, BK = 64, HALF = 128, HTB = HALF * BK * 2, STAGE_BYTES = 8 * HTB, NXCD = 8, WGM = 8;
__host__ __device__ __forceinline__ int lds_byte(int r, int c) { const int st = (r >> 4) * 2 + (c >> 5), rr = r & 15, cc = c & 31, ob = rr * 64 + cc * 2; return st * 1024 + (ob ^ (((ob >> 9) & 1) << 5)); }
__host__ __device__ __forceinline__ void stage_rc(int b, int& R, int& C) { const int st = b / 1024, sb = b % 1024, swz = sb ^ (((sb >> 9) & 1) << 5); R = (st >> 1) * 16 + swz / 64; C = (st & 1) * 32 + (swz % 64) / 2; }
__host__ __device__ __forceinline__ int perm32(int rho) { const int n = rho >> 4, i = rho & 15; return 8 * (i >> 2) + 4 * n + (i & 3); }

struct Unit { int pm, pn; };
struct Gemm { const bf16_t* A; const bf16_t* Bt; int lda, ldb, K; };

struct StaticOrder {
    int nM, nN, nwg, G, c;
    __device__ void init(int M, int N, int G_, int c_) { nM = M / BM; nN = N / BM; nwg = nM * nN; G = G_; c = c_; }
    __device__ bool next(int i, Unit& u) const {
        const long L = (long)i * G + c; if (L >= nwg) return false;
        int wgid = (int)L; { const int q = nwg / NXCD, r = nwg % NXCD, xcd = wgid % NXCD, off = wgid / NXCD; wgid = (xcd < r ? xcd * (q + 1) : r * (q + 1) + (xcd - r) * q) + off; }
        const int nig = WGM * nN, gid = wgid / nig, fm = gid * WGM, gsz = (nM - fm) < WGM ? (nM - fm) : WGM;
        u.pm = fm + ((wgid % nig) % gsz); u.pn = (wgid % nig) / gsz; return true;
    }
};
struct OneUnit {
    int pm, pn;
    __device__ bool next(int i, Unit& u) const { if (i) return false; u.pm = pm; u.pn = pn; return true; }
};


template <int ACT, bool RS> struct EpiStore {
    static constexpr bool PERM = true, AFTER_DRAIN = false;
    bf16_t* O; int ldc; int om, on; const float* sq; float cs;
    __device__ __forceinline__ void operator()(const f32x4 (&acc)[2][2][4][2], const Unit& u, int wr, int wc, int fr, int fq) const {
        int rl0 = wr * 64 + fr, cl0 = wc * 32 + 8 * fq; asm volatile("" : "+v"(rl0), "+v"(cl0));
        bf16_t* base = O + (size_t)(om * u.pm * BM) * ldc + on * u.pn * BM + cl0;
#pragma unroll
        for (int ai = 0; ai < 2; ++ai)
#pragma unroll
            for (int m = 0; m < 4; ++m) {
                const int rl = rl0 + ai * HALF + m * 16;
                float sc = cs;
                if (RS) { const f32x4* q4 = (const f32x4*)(sq + (size_t)(u.pm * BM + rl) * 16); f32x4 s = q4[0] + q4[1] + q4[2] + q4[3];
                    sc *= __builtin_amdgcn_rsqf((s[0] + s[1] + s[2] + s[3]) * (1.0f / 1024.0f) + 1e-6f); }
                bf16_t* rowp = base + (size_t)rl * ldc;
#pragma unroll
                for (int bj = 0; bj < 2; ++bj) { f32x4 v0 = acc[ai][bj][m][0] * sc, v1 = acc[ai][bj][m][1] * sc;
                    if (ACT == 2) {
#pragma unroll
                        for (int j = 0; j < 4; ++j) { float x = fmaxf(v0[j], 0.f); v0[j] = x * x; float y = fmaxf(v1[j], 0.f); v1[j] = y * y; } }
                    u32x4 w; w.x = cvt_pk_bf16(v0[0], v0[1]); w.y = cvt_pk_bf16(v0[2], v0[3]); w.z = cvt_pk_bf16(v1[0], v1[1]); w.w = cvt_pk_bf16(v1[2], v1[3]);
                    *(u32x4*)(rowp + bj * HALF) = w; } }
    }
};

struct EpiLora {
    static constexpr bool PERM = true, AFTER_DRAIN = false;
    float* LW; bf16_t* ASIG; bf16_t* GG; const float* w0; const float* a0;
    template <int SECT> __device__ __forceinline__ void run(const f32x4 (&acc)[2][2][4][2], int rl0, int c0) const {
        const float* cvec = SECT == 0 ? w0 : a0; bf16_t* ob = SECT == 1 ? ASIG : GG;
#pragma unroll
        for (int ai = 0; ai < 2; ++ai)
#pragma unroll
            for (int m = 0; m < 4; ++m) {
                const size_t row = (size_t)(rl0 + ai * HALF + m * 16);
#pragma unroll
                for (int bj = 0; bj < 2; ++bj) { const int c = c0 + bj * HALF; f32x4 v0 = acc[ai][bj][m][0], v1 = acc[ai][bj][m][1];
                    if (SECT < 2) { v0 += *(const f32x4*)(cvec + c); v1 += *(const f32x4*)(cvec + c + 4); }
                    if (SECT == 0) {
#pragma unroll
                        for (int j = 0; j < 4; ++j) { v0[j] = -0.60653065971f * sigmoidf_(v0[j]); v1[j] = -0.60653065971f * sigmoidf_(v1[j]); }
                        *(f32x4*)(LW + row * 512 + c) = v0; *(f32x4*)(LW + row * 512 + c + 4) = v1;
                    } else {
                        if (SECT == 1) {
#pragma unroll
                            for (int j = 0; j < 4; ++j) { v0[j] = sigmoidf_(v0[j]); v1[j] = sigmoidf_(v1[j]); } }
                        u32x4 w; w.x = cvt_pk_bf16(v0[0], v0[1]); w.y = cvt_pk_bf16(v0[2], v0[3]); w.z = cvt_pk_bf16(v1[0], v1[1]); w.w = cvt_pk_bf16(v1[2], v1[3]);
                        *(u32x4*)(ob + row * 512 + c) = w; } }
                asm volatile("" ::: "memory"); }
    }
    __device__ __forceinline__ void operator()(const f32x4 (&acc)[2][2][4][2], const Unit& u, int wr, int wc, int fr, int fq) const {
        int rl0 = u.pm * BM + wr * 64 + fr, c0 = (u.pn & 1) * BM + wc * 32 + 8 * fq; const int sect = u.pn >> 1; asm volatile("" : "+v"(rl0), "+v"(c0));
        if (sect == 0) run<0>(acc, rl0, c0); else if (sect == 1) run<1>(acc, rl0, c0); else run<2>(acc, rl0, c0);
    }
};

struct EpiRes {
    static constexpr bool PERM = true, AFTER_DRAIN = false;
    const float* base; float* out; bf16_t* xb; float* sq;
    __device__ __forceinline__ void operator()(const f32x4 (&acc)[2][2][4][2], const Unit& u, int wr, int wc, int fr, int fq) const {
        int rl0 = u.pm * BM + wr * 64 + fr, c0 = u.pn * BM + wc * 32 + 8 * fq; asm volatile("" : "+v"(rl0), "+v"(c0));
#pragma unroll
        for (int ai = 0; ai < 2; ++ai)
#pragma unroll
            for (int m = 0; m < 4; ++m) {
                const size_t row = (size_t)(rl0 + ai * HALF + m * 16); float ss = 0.f;
#pragma unroll
                for (int bj = 0; bj < 2; ++bj) { const size_t off = row * 1024 + c0 + bj * HALF;
                    const f32x4 b0 = *(const f32x4*)(base + off), b1 = *(const f32x4*)(base + off + 4);
                    const f32x4 o0 = b0 + acc[ai][bj][m][0], o1 = b1 + acc[ai][bj][m][1];
                    *(f32x4*)(out + off) = o0; *(f32x4*)(out + off + 4) = o1;
                    if (xb) { u32x4 w; w.x = cvt_pk_bf16(o0[0], o0[1]); w.y = cvt_pk_bf16(o0[2], o0[3]); w.z = cvt_pk_bf16(o1[0], o1[1]); w.w = cvt_pk_bf16(o1[2], o1[3]); *(u32x4*)(xb + off) = w; }
                    ss += (o0[0] * o0[0] + o0[1] * o0[1]) + (o0[2] * o0[2] + o0[3] * o0[3]) + (o1[0] * o1[0] + o1[1] * o1[1]) + (o1[2] * o1[2] + o1[3] * o1[3]); }
                ss += __shfl_xor(ss, 16); ss += __shfl_xor(ss, 32);
                if (fq == 0) sq[row * 16 + u.pn * 4 + wc] = ss;
                if (m & 1) asm volatile("" ::: "memory"); }
    }
};

struct EpiSoftmax {
    static constexpr bool PERM = true, AFTER_DRAIN = true;
    bf16_t* Pout;
    __device__ __forceinline__ void fused(f32x4 (&acc)[2][2][4][2], const Unit& u, int wr, int wc, int fr, int fq, LAS unsigned char* lds, int wid, int lane) const {
        LAS float* PM = (LAS float*)lds;
        LAS float* PS = (LAS float*)(lds + 4096);
        int rl0 = wr * 64 + fr; asm volatile("" : "+v"(rl0));
#pragma unroll
        for (int ai = 0; ai < 2; ++ai)
#pragma unroll
            for (int m = 0; m < 4; ++m) { float v = -3.0e38f;
#pragma unroll
                for (int bj = 0; bj < 2; ++bj)
#pragma unroll
                    for (int n = 0; n < 2; ++n) { const f32x4 x = acc[ai][bj][m][n]; v = fmaxf(v, fmaxf(fmaxf(x[0], x[1]), fmaxf(x[2], x[3]))); }
                v = fmaxf(v, __shfl_xor(v, 16)); v = fmaxf(v, __shfl_xor(v, 32));
                if (fq == 0) PM[(rl0 + ai * HALF + m * 16) * 4 + wc] = v; }
        asm volatile("s_waitcnt lgkmcnt(0)" ::: "memory"); __builtin_amdgcn_s_barrier(); asm volatile("" ::: "memory");
#pragma unroll
        for (int ai = 0; ai < 2; ++ai)
#pragma unroll
            for (int m = 0; m < 4; ++m) { const f32x4 p = *(const LAS f32x4*)(PM + (rl0 + ai * HALF + m * 16) * 4);
                const float rm = fmaxf(fmaxf(p[0], p[1]), fmaxf(p[2], p[3])) * 1.44269504089f; float s = 0.f;
#pragma unroll
                for (int bj = 0; bj < 2; ++bj)
#pragma unroll
                    for (int n = 0; n < 2; ++n) {
#pragma unroll
                        for (int j = 0; j < 4; ++j) { const float e = __builtin_amdgcn_exp2f(acc[ai][bj][m][n][j] * 1.44269504089f - rm); acc[ai][bj][m][n][j] = e; s += e; } }
                s += __shfl_xor(s, 16); s += __shfl_xor(s, 32);
                if (fq == 0) PS[(rl0 + ai * HALF + m * 16) * 4 + wc] = s; }
        asm volatile("s_waitcnt lgkmcnt(0)" ::: "memory"); __builtin_amdgcn_s_barrier(); asm volatile("" ::: "memory");
#pragma unroll
        for (int ai = 0; ai < 2; ++ai)
#pragma unroll
            for (int m = 0; m < 4; ++m) { const int rl = rl0 + ai * HALF + m * 16; const f32x4 p = *(const LAS f32x4*)(PS + rl * 4);
                const float inv = __builtin_amdgcn_rcpf((p[0] + p[1]) + (p[2] + p[3]));
#pragma unroll
                for (int bj = 0; bj < 2; ++bj) { const f32x4 v0 = acc[ai][bj][m][0] * inv, v1 = acc[ai][bj][m][1] * inv;
                    u32x4 w; w.x = cvt_pk_bf16(v0[0], v0[1]); w.y = cvt_pk_bf16(v0[2], v0[3]); w.z = cvt_pk_bf16(v1[0], v1[1]); w.w = cvt_pk_bf16(v1[2], v1[3]);
                    *(u32x4*)(Pout + (size_t)rl * 256 + wc * 32 + 8 * fq + bj * HALF) = w; } }
    }
};

template <class Epi, class Sched, bool ALIGN_EPI = false, bool SP2 = true>
__device__ __forceinline__ void gemm_phase(LAS unsigned char* lds, const Gemm g, const Sched& S, const Epi& E) {
    int tid = threadIdx.x; asm volatile("" : "+v"(tid));
    const int wid = __builtin_amdgcn_readfirstlane(tid >> 6), lane = tid & 63, wr = wid >> 2, wc = wid & 3, fr = lane & 15, fq = lane >> 4;
    const int K = g.K, nt = K / BK;
    unsigned voffA[2], voffB[2];
#pragma unroll
    for (int i = 0; i < 2; ++i) { int R, C; stage_rc(tid * 16 + i * 8192, R, C); const int Rb = Epi::PERM ? ((R & ~31) + perm32(R & 31)) : R;
        voffA[i] = (unsigned)(R * g.lda + C) * 2u; voffB[i] = (unsigned)(Rb * g.ldb + C) * 2u; }
    const size_t kstep = (size_t)(BK * 2);
    const size_t hstepA = (size_t)HALF * g.lda * 2, hstepB = (size_t)HALF * g.ldb * 2;
    const size_t tstepA = 2 * hstepA, tstepB = 2 * hstepB;
    const unsigned ldsw = (unsigned)wid * 1024u;
    const int aoff = lds_byte(wr * 64 + fr, fq * 8), boff = lds_byte(wc * 32 + fr, fq * 8);
#define PG8_SA(b, h) (((b) * 2 + (h)) * HTB)
#define PG8_SB(b, h) ((4 + (b) * 2 + (h)) * HTB)
#define PG8_STAGE(bufoff, gbase, voff) do { _Pragma("unroll") for (int _i = 0; _i < 2; ++_i) \
        __builtin_amdgcn_global_load_lds((const unsigned*)((const char*)(gbase) + (voff)[_i]), (LAS unsigned*)(lds + (bufoff) + ldsw + _i * 8192), 16, 0, 0); } while (0)
#define PG8_LDA(dst, b, h) do { _Pragma("unroll") for (int m = 0; m < 4; ++m) _Pragma("unroll") for (int k = 0; k < 2; ++k) dst[m][k] = *(const LAS bf16x8*)(lds + PG8_SA(b, h) + aoff + m * 2048 + k * 1024); } while (0)
#define PG8_LDB(dst, b, h) do { _Pragma("unroll") for (int n = 0; n < 2; ++n) _Pragma("unroll") for (int k = 0; k < 2; ++k) dst[n][k] = *(const LAS bf16x8*)(lds + PG8_SB(b, h) + boff + n * 2048 + k * 1024); } while (0)
#define PG8_MMA(ai, bj, At, Bt) do { __builtin_amdgcn_s_setprio(1); _Pragma("unroll") for (int m = 0; m < 4; ++m) _Pragma("unroll") for (int n = 0; n < 2; ++n) _Pragma("unroll") for (int k = 0; k < 2; ++k) \
        acc[ai][bj][m][n] = __builtin_amdgcn_mfma_f32_16x16x32_bf16(Bt[n][k], At[m][k], acc[ai][bj][m][n], 0, 0, 0); __builtin_amdgcn_s_setprio(0); } while (0)
#define PG8_WAIT_V(n) asm volatile("s_waitcnt vmcnt(" #n ")" ::: "memory")
#define PG8_WAIT_L(n) asm volatile("s_waitcnt lgkmcnt(" #n ")" ::: "memory")
#define PG8_BAR __builtin_amdgcn_s_barrier()
#define PG8_SCHED __builtin_amdgcn_sched_barrier(0)
    Unit cur, nxt; int ui = 0;
    if (!S.next(0, cur)) return;
    f32x4 acc[2][2][4][2];
#pragma unroll
    for (int a = 0; a < 2; ++a)
#pragma unroll
        for (int b = 0; b < 2; ++b)
#pragma unroll
            for (int m = 0; m < 4; ++m)
#pragma unroll
                for (int n = 0; n < 2; ++n) acc[a][b][m][n] = (f32x4){0.f, 0.f, 0.f, 0.f};
    bf16x8 At[4][2], B0[2][2], B1[2][2];
    const char* cA = (const char*)g.A + (size_t)cur.pm * tstepA; const char* cB = (const char*)g.Bt + (size_t)cur.pn * tstepB;
    static_assert(SP2, "only the two-super-phase loop is kept here");
    PG8_STAGE(PG8_SB(0, 0), cB, voffB); PG8_STAGE(PG8_SB(0, 1), cB + hstepB, voffB); PG8_STAGE(PG8_SA(0, 0), cA, voffA); PG8_STAGE(PG8_SA(0, 1), cA + hstepA, voffA);
    if (wr == 1) PG8_BAR;
    PG8_WAIT_V(2); PG8_BAR;
    PG8_STAGE(PG8_SB(1, 0), cB + kstep, voffB); PG8_STAGE(PG8_SA(1, 0), cA + kstep, voffA); PG8_STAGE(PG8_SB(1, 1), cB + hstepB + kstep, voffB);
    PG8_WAIT_V(6); PG8_BAR;
    for (;;) {
        const bool has_next = S.next(ui + 1, nxt);
        const char* nA = has_next ? (const char*)g.A + (size_t)nxt.pm * tstepA : cA; const char* nB = has_next ? (const char*)g.Bt + (size_t)nxt.pn * tstepB : cB;
        for (int t = 0; t < nt; t += 2) {
            const bool last = (t == nt - 2);
            const char* a1 = cA + (size_t)(t + 1) * kstep;
            const char* a2 = last ? nA : cA + (size_t)(t + 2) * kstep; const char* b2 = last ? nB : cB + (size_t)(t + 2) * kstep;
            const char* a3 = a2 + kstep; const char* b3 = b2 + kstep;
            PG8_LDB(B0, 0, 0); PG8_LDB(B1, 0, 1); PG8_SCHED; PG8_LDA(At, 0, 0); PG8_STAGE(PG8_SA(1, 1), a1 + hstepA, voffA);
            PG8_WAIT_V(8); PG8_WAIT_L(0); PG8_BAR; PG8_MMA(0, 0, At, B0); PG8_MMA(0, 1, At, B1); PG8_BAR; PG8_SCHED;
            PG8_LDA(At, 0, 1); PG8_STAGE(PG8_SB(0, 0), b2, voffB); PG8_STAGE(PG8_SB(0, 1), b2 + hstepB, voffB); PG8_STAGE(PG8_SA(0, 0), a2, voffA);
            PG8_WAIT_V(8); PG8_WAIT_L(0); PG8_BAR; PG8_MMA(1, 0, At, B0); PG8_MMA(1, 1, At, B1); PG8_BAR; PG8_SCHED;
            PG8_LDB(B0, 1, 0); PG8_LDB(B1, 1, 1); PG8_SCHED; PG8_LDA(At, 1, 0); PG8_STAGE(PG8_SA(0, 1), a2 + hstepA, voffA);
            PG8_WAIT_V(8); PG8_WAIT_L(0); PG8_BAR; PG8_MMA(0, 0, At, B0); PG8_MMA(0, 1, At, B1); PG8_BAR; PG8_SCHED;
            PG8_LDA(At, 1, 1); PG8_STAGE(PG8_SB(1, 0), b3, voffB); PG8_STAGE(PG8_SB(1, 1), b3 + hstepB, voffB); PG8_STAGE(PG8_SA(1, 0), a3, voffA);
            PG8_WAIT_V(8); PG8_WAIT_L(0); PG8_BAR; PG8_MMA(1, 0, At, B0); PG8_MMA(1, 1, At, B1); PG8_BAR; PG8_SCHED;
        }
        if constexpr (ALIGN_EPI) { if (wr == 0) PG8_BAR; }
        if constexpr (!Epi::AFTER_DRAIN) { E(acc, cur, wr, wc, fr, fq); }
        if (!has_next) break;
#pragma unroll
        for (int a = 0; a < 2; ++a)
#pragma unroll
            for (int b = 0; b < 2; ++b)
#pragma unroll
                for (int m = 0; m < 4; ++m)
#pragma unroll
                    for (int n = 0; n < 2; ++n) acc[a][b][m][n] = (f32x4){0.f, 0.f, 0.f, 0.f};
        cur = nxt; cA = nA; cB = nB; ++ui;
        if constexpr (ALIGN_EPI) { if (wr == 1) PG8_BAR; }
    }
    PG8_WAIT_V(0);
    if constexpr (!ALIGN_EPI) { if (wr == 0) PG8_BAR; }
    PG8_BAR;
    if constexpr (Epi::AFTER_DRAIN) { E.fused(acc, cur, wr, wc, fr, fq, lds, wid, lane); }
#undef PG8_SA
#undef PG8_SB
#undef PG8_STAGE
#undef PG8_LDA
#undef PG8_LDB
#undef PG8_MMA
#undef PG8_WAIT_V
#undef PG8_WAIT_L
#undef PG8_BAR
#undef PG8_SCHED
}
}

constexpr int BATCH = 8, SEQ = 2048, D = 1024, M = BATCH * SEQ, NMEM = 256, MM = BATCH * NMEM;
constexpr int NIN = 3872, NP = 4096, FF = 4096, LK = 384, LN = 1536;
constexpr int C_RK = 2048, C_LORA = 3584;
constexpr int NWAVES = 8, LDS_BYTES = 163840, MISC_OFF = 163840 - 256;
constexpr size_t MiB = 1u << 20;
constexpr size_t WS_WIN = 1 * MiB, WS_WOUT = 9 * MiB, WS_WQ = 11 * MiB, WS_WKV = 13 * MiB, WS_WO = 17 * MiB, WS_WUP = 19 * MiB, WS_WDN = 27 * MiB, WS_LORA = 35 * MiB;
constexpr size_t WS_MEMN = 37 * MiB, WS_KM = 41 * MiB, WS_VT = 45 * MiB, WS_ROPE = 49 * MiB, WS_SQ1 = 53 * MiB, WS_SQ2 = 54 * MiB, WS_SQ3 = 55 * MiB;
constexpr size_t WS_ACTA = 56 * MiB, WS_ACTB = 88 * MiB, WS_P = 120 * MiB, WS_KN = 248 * MiB  , WS_END = 249 * MiB;
constexpr size_t DO_LW = 0, DO_ASIG = 32 * MiB, DO_GG = 48 * MiB;

struct Args { const void* in[28]; float* out; unsigned char* ws; int ph_lo, ph_hi; };
typedef const __attribute__((address_space(4))) unsigned long long* CArgs;
__device__ __forceinline__ Args load_args() { CArgs p = (CArgs)__builtin_amdgcn_kernarg_segment_ptr(); asm volatile("" : "+s"(p)); Args a;
#pragma unroll
    for (int i = 0; i < 28; ++i) a.in[i] = (const void*)(const __attribute__((address_space(1))) void*)p[i];
    a.out = (float*)(__attribute__((address_space(1))) float*)p[28]; a.ws = (unsigned char*)(__attribute__((address_space(1))) unsigned char*)p[29]; a.ph_lo = (int)p[30]; a.ph_hi = (int)(p[30] >> 32); return a; }
#define TIDS() int tid = threadIdx.x; asm volatile("" : "+v"(tid)); const int lane = tid & 63, wave = __builtin_amdgcn_readfirstlane(tid >> 6); (void)lane; (void)wave
enum { I_X = 0, I_MEM, I_POS, I_NMIX, I_WIN, I_RGNW, I_RGNB, I_MU, I_W0, I_WUP, I_A0, I_AUP, I_GUP, I_KK, I_KA, I_RK, I_WGNW, I_WGNB, I_WOUT, I_NXA, I_NMEM, I_WQ, I_WKV, I_WO, I_NMLP, I_MUP, I_MDN, I_NFIN };

template <int CTRL> __device__ __forceinline__ float dpp_add(float v) { return v + __builtin_bit_cast(float, __builtin_amdgcn_update_dpp(0, __builtin_bit_cast(int, v), CTRL, 0xf, 0xf, false)); }
__device__ __forceinline__ float red16(float v) { v = dpp_add<0xB1>(v); v = dpp_add<0x4E>(v); v = dpp_add<0x141>(v); v = dpp_add<0x140>(v); return v; }
__device__ __forceinline__ void p0_transpose_item(const float* W, int K, int N, const float* gain, bf16_t* WT, int row_off, LAS float* scr, int item, int lane) {
    const int nblk = N / 32, kb = item / nblk, nb = item % nblk, k0 = 64 * kb, n0 = 32 * nb;
#pragma unroll 8
    for (int i = 0; i < 32; ++i) { const int kk = 2 * i + (lane >> 5); float v = W[(size_t)(k0 + kk) * N + n0 + (lane & 31)]; if (gain) v *= gain[k0 + kk]; scr[kk * 33 + (lane & 31)] = v; }
    asm volatile("s_waitcnt lgkmcnt(0)" ::: "memory");
    const int c = lane & 7;
#pragma unroll
    for (int j = 0; j < 4; ++j) { const int n = (lane >> 3) + 8 * j; const LAS float* s = scr + (8 * c) * 33 + n;
        u32x4 o; o.x = cvt_pk_bf16(s[0 * 33], s[1 * 33]); o.y = cvt_pk_bf16(s[2 * 33], s[3 * 33]); o.z = cvt_pk_bf16(s[4 * 33], s[5 * 33]); o.w = cvt_pk_bf16(s[6 * 33], s[7 * 33]);
        *(u32x4*)(WT + (size_t)(row_off + n0 + n) * K + k0 + 8 * c) = o; }
    asm volatile("s_waitcnt lgkmcnt(0)" ::: "memory");
}
__device__ __forceinline__ void rms_row_to_bf16(const float* xrow, bf16_t* orow, int lane) {
    const f32x4* xr = (const f32x4*)xrow + lane;
    f32x4 v[4]; float s = 0.f;
#pragma unroll
    for (int j = 0; j < 4; ++j) { v[j] = xr[64 * j]; s += (v[j][0] * v[j][0] + v[j][1] * v[j][1]) + (v[j][2] * v[j][2] + v[j][3] * v[j][3]); }
    const float rstd = 1.0f / sqrtf(wave_sum(s) * (1.f / 1024.f) + 1e-6f);
    u32x2* o8 = (u32x2*)orow + lane;
#pragma unroll
    for (int j = 0; j < 4; ++j) { u32x2 w; w.x = cvt_pk_bf16(v[j][0] * rstd, v[j][1] * rstd); w.y = cvt_pk_bf16(v[j][2] * rstd, v[j][3] * rstd); o8[64 * j] = w; }
}

__device__ __forceinline__ void phase0(LAS unsigned char* lds) {
    const Args a = load_args(); TIDS();
    unsigned char* ws = a.ws;
    LAS float* scr = (LAS float*)(lds + wave * 16384);
    const int gw = blockIdx.x * NWAVES + wave, NGW = gridDim.x * NWAVES;
    const int gt = blockIdx.x * 512 + tid, NGT = gridDim.x * 512;
    constexpr int I_IN = 16 * 121, I_KV = 16 * 64;
    constexpr int NITEMS = I_IN + I_KV;
    for (int it = gw; it < NITEMS; it += NGW) {
        int r = it;
        if (r < I_IN) { p0_transpose_item((const float*)a.in[I_WIN], D, NIN, (const float*)a.in[I_NMIX], (bf16_t*)(ws + WS_WIN), 0, scr, r, lane); continue; } r -= I_IN;
        p0_transpose_item((const float*)a.in[I_WKV], D, 2 * D, (const float*)a.in[I_NMEM], (bf16_t*)(ws + WS_WKV), 0, scr, r, lane);
    }
    { u32x4* z = (u32x4*)(ws + WS_WIN + (size_t)NIN * D * 2); const int nz = (NP - NIN) * D * 2 / 16; for (int i = gt; i < nz; i += NGT) z[i] = (u32x4){0u, 0u, 0u, 0u}; }
    { const float* wup = (const float*)a.in[I_WUP]; const float* aup = (const float*)a.in[I_AUP]; const float* gup = (const float*)a.in[I_GUP]; u32x4* LT = (u32x4*)(ws + WS_LORA);
      for (int i = gt; i < LN * (LK / 8); i += NGT) { const int n = i / (LK / 8), k0 = (i % (LK / 8)) * 8; float v[8];
#pragma unroll
          for (int j = 0; j < 8; ++j) { const int k = k0 + j; float x = 0.f;
              if (n < 512) { if (k < 64) x = wup[k * 512 + n]; }
              else if (n < 1024) { if (k >= 64 && k < 128) x = aup[(k - 64) * 512 + (n - 512)]; }
              else { if (k >= 128 && k < 288) x = gup[(k - 128) * 512 + (n - 1024)]; }
              v[j] = x; }
          u32x4 o; o.x = cvt_pk_bf16(v[0], v[1]); o.y = cvt_pk_bf16(v[2], v[3]); o.z = cvt_pk_bf16(v[4], v[5]); o.w = cvt_pk_bf16(v[6], v[7]); LT[i] = o; } }
    for (int m = gw; m < M + MM; m += NGW) {
        if (m < M) rms_row_to_bf16((const float*)a.in[I_X] + (size_t)m * D, (bf16_t*)(ws + WS_ACTA) + (size_t)m * D, lane);
        else rms_row_to_bf16((const float*)a.in[I_MEM] + (size_t)(m - M) * D, (bf16_t*)(ws + WS_MEMN) + (size_t)(m - M) * D, lane);
    }
    { const int* pos = (const int*)a.in[I_POS]; f32x2* T = (f32x2*)(ws + WS_ROPE);
      for (int i = gt; i < M * 32; i += NGT) { const int m = i >> 5, f = i & 31;
          const float inv = (float)exp2(-(double)f * (13.287712379549449 / 32.0));
          const float ang = (float)pos[m] * inv;
          double rev = (double)ang * 0.15915494309189535; rev -= rint(rev);
          const float rv = (float)rev;
          T[i] = (f32x2){__builtin_amdgcn_cosf(rv), __builtin_amdgcn_sinf(rv)}; } }
}

__device__ __forceinline__ void p0_late_weights(LAS unsigned char* lds, int wg, int nwg) {
    const Args a = load_args(); TIDS();
    unsigned char* ws = a.ws;
    LAS float* scr = (LAS float*)(lds + wave * 16384);
    const int gw = wg * NWAVES + wave, NGW = nwg * NWAVES;
    constexpr int I_SQ = 16 * 32, I_UP = 16 * 128, I_DN = 64 * 32;
    constexpr int NITEMS = 3 * I_SQ + I_UP + I_DN;
    for (int it = gw; it < NITEMS; it += NGW) {
        int r = it;
        if (r < I_SQ) { p0_transpose_item((const float*)a.in[I_WOUT], D, D, nullptr, (bf16_t*)(ws + WS_WOUT), 0, scr, r, lane); continue; } r -= I_SQ;
        if (r < I_SQ) { p0_transpose_item((const float*)a.in[I_WQ], D, D, (const float*)a.in[I_NXA], (bf16_t*)(ws + WS_WQ), 0, scr, r, lane); continue; } r -= I_SQ;
        if (r < I_SQ) { p0_transpose_item((const float*)a.in[I_WO], D, D, nullptr, (bf16_t*)(ws + WS_WO), 0, scr, r, lane); continue; } r -= I_SQ;
        if (r < I_UP) { p0_transpose_item((const float*)a.in[I_MUP], D, FF, (const float*)a.in[I_NMLP], (bf16_t*)(ws + WS_WUP), 0, scr, r, lane); continue; } r -= I_UP;
        p0_transpose_item((const float*)a.in[I_MDN], FF, D, nullptr, (bf16_t*)(ws + WS_WDN), 0, scr, r, lane);
    }
}

__device__ __forceinline__ void phase_lora_in() {
    const Args a = load_args(); TIDS();
    { const bf16_t* Pk = (const bf16_t*)(a.ws + WS_P) + C_RK + 512 + 8 * lane; float* KN = (float*)(a.ws + WS_KN);
      const float* muk = (const float*)a.in[I_MU] + 512 + 8 * lane; const float* kkp = (const float*)a.in[I_KK] + 8 * lane;
      const f32x4 mu0 = *(const f32x4*)muk, mu1 = *(const f32x4*)(muk + 4), kc0 = *(const f32x4*)kkp, kc1 = *(const f32x4*)(kkp + 4);
      for (int m = blockIdx.x * NWAVES + wave; m < M; m += gridDim.x * NWAVES) {
          const u32x4 cur = *(const u32x4*)(Pk + (size_t)m * NP); u32x4 prv = (u32x4){0u, 0u, 0u, 0u}; if ((m & (SEQ - 1)) != 0) prv = *(const u32x4*)(Pk + (size_t)(m - 1) * NP);
          float ss = 0.f;
#pragma unroll
          for (int j = 0; j < 4; ++j) { const float c0 = bflo(cur[j]), c1 = bfhi(cur[j]), p0 = bflo(prv[j]), p1 = bfhi(prv[j]);
              const float m0_ = j < 2 ? mu0[2 * j] : mu1[2 * j - 4], m1_ = j < 2 ? mu0[2 * j + 1] : mu1[2 * j - 3], k0_ = j < 2 ? kc0[2 * j] : kc1[2 * j - 4], k1_ = j < 2 ? kc0[2 * j + 1] : kc1[2 * j - 3];
              const float a0 = (c0 + (p0 - c0) * m0_) * k0_, a1 = (c1 + (p1 - c1) * m1_) * k1_; ss += a0 * a0 + a1 * a1; }
          ss = dpp_add<0xB1>(ss); ss = dpp_add<0x4E>(ss); ss = dpp_add<0x141>(ss);
          if ((lane & 7) == 0) KN[(size_t)m * 8 + (lane >> 3)] = __builtin_amdgcn_rsqf(fmaxf(ss, 1e-24f)); } }
    const bf16_t* P = (const bf16_t*)(a.ws + WS_P); bf16_t* L = (bf16_t*)(a.ws + WS_ACTB); const float* mu = (const float*)a.in[I_MU] + 1536;
    const int gt = blockIdx.x * 512 + tid, NGT = gridDim.x * 512;
    for (int i = gt; i < M * (LK / 8); i += NGT) { const int m = i / (LK / 8), c8 = i % (LK / 8), c = 8 * c8; u32x4 o = (u32x4){0u, 0u, 0u, 0u};
        if (c < 288) { const u32x4 cur = *(const u32x4*)(P + (size_t)m * NP + C_LORA + c); u32x4 prv = (u32x4){0u, 0u, 0u, 0u}; if ((m & (SEQ - 1)) != 0) prv = *(const u32x4*)(P + (size_t)(m - 1) * NP + C_LORA + c);
            const f32x4 mu0 = *(const f32x4*)(mu + c), mu1 = *(const f32x4*)(mu + c + 4); float v[8];
#pragma unroll
            for (int j = 0; j < 4; ++j) { const float c0 = bflo(cur[j]), c1 = bfhi(cur[j]), p0 = bflo(prv[j]), p1 = bfhi(prv[j]); const float m0 = j < 2 ? mu0[2 * j] : mu1[2 * j - 4], m1 = j < 2 ? mu0[2 * j + 1] : mu1[2 * j - 3];
                v[2 * j] = c0 + (p0 - c0) * m0; v[2 * j + 1] = c1 + (p1 - c1) * m1; }
            if (c < 64) {
#pragma unroll
                for (int j = 0; j < 8; ++j) v[j] = tanhf(v[j]); }
            else if (c >= 128) {
#pragma unroll
                for (int j = 0; j < 8; ++j) v[j] = sigmoidf_(v[j]); }
            o.x = cvt_pk_bf16(v[0], v[1]); o.y = cvt_pk_bf16(v[2], v[3]); o.z = cvt_pk_bf16(v[4], v[5]); o.w = cvt_pk_bf16(v[6], v[7]); }
        *(u32x4*)(L + (size_t)m * LK + c) = o; }
}

typedef short bf16x4 __attribute__((ext_vector_type(4)));
__device__ __forceinline__ float wave_sum_fast(float v) { v = red16(v);
    const int iv = __builtin_bit_cast(int, v);
    return (__builtin_bit_cast(float, __builtin_amdgcn_readlane(iv, 0)) + __builtin_bit_cast(float, __builtin_amdgcn_readlane(iv, 16))) + (__builtin_bit_cast(float, __builtin_amdgcn_readlane(iv, 32)) + __builtin_bit_cast(float, __builtin_amdgcn_readlane(iv, 48))); }
__device__ __forceinline__ bf16x4 pack4(const f32x4 v) { u32x2 w; w.x = cvt_pk_bf16(v[0], v[1]); w.y = cvt_pk_bf16(v[2], v[3]); return __builtin_bit_cast(bf16x4, w); }
__device__ __forceinline__ bf16x8 pack8(const f32x4 a, const f32x4 b) { u32x4 w; w.x = cvt_pk_bf16(a[0], a[1]); w.y = cvt_pk_bf16(a[2], a[3]); w.z = cvt_pk_bf16(b[0], b[1]); w.w = cvt_pk_bf16(b[2], b[3]); return __builtin_bit_cast(bf16x8, w); }
__device__ __forceinline__ unsigned short f2bf(float v) { return (unsigned short)(cvt_pk_bf16(v, 0.f) & 0xffffu); }

__device__ __forceinline__ f32x4 mfma16(const bf16x4 a, const bf16x4 b, const f32x4 c) {
    bf16x4 a_ = a, b_ = b; f32x4 c_ = c; asm volatile("s_nop 7" : "+v"(a_), "+v"(b_), "+v"(c_));
    return __builtin_amdgcn_mfma_f32_16x16x16bf16_1k(a_, b_, c_, 0, 0, 0);
}
__device__ __forceinline__ f32x4 mfma32p(const bf16x8 a, const bf16x8 b, const f32x4 c) {
    bf16x8 a_ = a, b_ = b; f32x4 c_ = c; asm volatile("s_nop 7" : "+v"(a_), "+v"(b_), "+v"(c_));
    return __builtin_amdgcn_mfma_f32_16x16x32_bf16(a_, b_, c_, 0, 0, 0);
}
__device__ __forceinline__ void rwkv_chunk_wg(LAS unsigned char* lds, int bh) {
    const Args a = load_args(); TIDS();
    const int b = bh >> 3, h = bh & 7;
    constexpr int RS = 144;
    constexpr int SLOT = 15168, O_GT = 13120  , O_AT = 0, O_RT = 2304, O_BHT = 4608, O_KHT = 6656, O_VT = 8704, O_CAK = 10752, O_TT = 11264, O_CBR = 11776, O_CKR = 12288, O_PL = 12800, O_RKB = 13056;
    constexpr int SCR0 = 8 * SLOT, SCR = 5632, O_BT = 0, O_KT = 2304, O_NF = 4608, O_RK = 0  ;
    constexpr int STAT0 = SCR0 + 4 * SCR;
    static_assert(STAT0 + 4096 <= MISC_OFF, "rwkv LDS map");
    constexpr int NCH = SEQ / 16, NST = NCH / 4;
    const size_t m0 = (size_t)b * SEQ;
    const int li = lane & 15, lq = lane >> 4;
    if (wave < 4) {
        const int rt = wave, vch = 64 * h + 16 * rt + li;
        const bf16_t* GG = (const bf16_t*)((const unsigned char*)a.out + DO_GG); bf16_t* Y = (bf16_t*)(a.ws + WS_ACTA);
        const float gw = ((const float*)a.in[I_WGNW])[vch], gb = ((const float*)a.in[I_WGNB])[vch];
        f32x4 S[4];
#pragma unroll
        for (int kt = 0; kt < 4; ++kt) S[kt] = (f32x4){0.f, 0.f, 0.f, 0.f};
        const f32x4 zero4 = (f32x4){0.f, 0.f, 0.f, 0.f};
        f32x4 ys[4], rkbs[4]; bf16x4 vts[4], gts[4];
#pragma unroll
        for (int q = 0; q < 4; ++q) { ys[q] = zero4; rkbs[q] = zero4; vts[q] = (bf16x4){0, 0, 0, 0}; gts[q] = (bf16x4){0, 0, 0, 0}; }
        for (int g = 0; g <= NST + 1; ++g) {
            if (g >= 2) {
#pragma unroll
                for (int q = 0; q < 4; ++q) { const int c = 4 * (g - 2) + q; const LAS float* st = (const LAS float*)(lds + STAT0 + ((g - 1) & 1) * 2048 + q * 512);
#pragma unroll
                    for (int r = 0; r < 4; ++r) { const int t = 4 * lq + r; const f32x4 p0 = *(const LAS f32x4*)(st + t * 8), p1 = *(const LAS f32x4*)(st + t * 8 + 4);
                        const float mean = ((p0[0] + p0[2]) + (p1[0] + p1[2])) * (1.f / 64.f), ex2 = ((p0[1] + p0[3]) + (p1[1] + p1[3])) * (1.f / 64.f);
                        const float rstd = __builtin_amdgcn_rsqf(fmaxf(ex2 - mean * mean, 0.f) + 64e-5f);
                        const float vv = bf2f((unsigned short)vts[q][r]);
                        const float o = ((ys[q][r] - mean) * rstd * gw + gb + rkbs[q][r] * vv) * bf2f((unsigned short)gts[q][r]);
                        Y[(m0 + 16 * c + t) * D + 512 + vch] = f2bf(o); } }
            }
            f32x4 yn[4], rkbn[4]; bf16x4 vtn[4], gtn[4];
#pragma unroll
            for (int q = 0; q < 4; ++q) { yn[q] = zero4; rkbn[q] = zero4; vtn[q] = (bf16x4){0, 0, 0, 0}; gtn[q] = (bf16x4){0, 0, 0, 0}; }
            if (g >= 1 && g <= NST) {
#pragma unroll
                for (int q = 0; q < 4; ++q) {
                    LAS unsigned char* sl = lds + (((g - 1) & 1) * 4 + q) * SLOT;
                    const bf16x8 sf0 = pack8(S[0], S[1]), sf1 = pack8(S[2], S[3]);
                    const bf16x8 a0 = *(const LAS bf16x8*)(sl + O_AT + li * RS + 16 * lq), a1 = *(const LAS bf16x8*)(sl + O_AT + li * RS + 64 + 16 * lq);
                    const bf16x8 r0 = *(const LAS bf16x8*)(sl + O_RT + li * RS + 16 * lq), r1 = *(const LAS bf16x8*)(sl + O_RT + li * RS + 64 + 16 * lq);
                    const bf16x4 cak = *(const LAS bf16x4*)(sl + O_CAK + li * 32 + 8 * lq), tt = *(const LAS bf16x4*)(sl + O_TT + li * 32 + 8 * lq);
                    const bf16x4 cbr = *(const LAS bf16x4*)(sl + O_CBR + li * 32 + 8 * lq), ckr = *(const LAS bf16x4*)(sl + O_CKR + li * 32 + 8 * lq);
                    const bf16x4 vt = *(const LAS bf16x4*)(sl + O_VT + (16 * rt + li) * 32 + 8 * lq);
                    rkbn[q] = *(const LAS f32x4*)(sl + O_RKB + 16 * lq);
                    f32x4 z = mfma16(cak, vt, zero4);
                    f32x4 y = mfma16(ckr, vt, zero4);
                    f32x4 accs[4];
#pragma unroll
                    for (int kt = 0; kt < 4; ++kt) { const f32x4 pl = *(const LAS f32x4*)(sl + O_PL + (16 * kt + 4 * lq) * 4);
                        const bf16x4 khf = *(const LAS bf16x4*)(sl + O_KHT + (16 * kt + li) * 32 + 8 * lq); accs[kt] = mfma16(khf, vt, S[kt] * pl); }
                    z = mfma32p(a0, sf0, z); z = mfma32p(a1, sf1, z);
                    y = mfma32p(r0, sf0, y); y = mfma32p(r1, sf1, y);
                    const bf16x4 zf = pack4(z);
                    const f32x4 u = mfma16(tt, zf, zero4);
                    const bf16x4 uf = pack4(u);
#pragma unroll
                    for (int kt = 0; kt < 4; ++kt) { const bf16x4 bhf = *(const LAS bf16x4*)(sl + O_BHT + (16 * kt + li) * 32 + 8 * lq); S[kt] = mfma16(bhf, uf, accs[kt]); }
                    y = mfma16(cbr, uf, y);
                    yn[q] = y; vtn[q] = vt; gtn[q] = *(const LAS bf16x4*)(sl + O_GT + (16 * rt + li) * 32 + 8 * lq);
                    LAS float* st = (LAS float*)(lds + STAT0 + (g & 1) * 2048 + q * 512);
#pragma unroll
                    for (int r = 0; r < 4; ++r) { const float s1 = red16(y[r]), s2 = red16(y[r] * y[r]); if (li == 0) { f32x2 w2 = {s1, s2}; *(LAS f32x2*)(st + (4 * lq + r) * 8 + 2 * rt) = w2; } }
                }
            }
#pragma unroll
            for (int q = 0; q < 4; ++q) { ys[q] = yn[q]; rkbs[q] = rkbn[q]; vts[q] = vtn[q]; gts[q] = gtn[q]; }
            __syncthreads();
        }
    } else {
        const int pw = wave - 4, ci = 64 * h + lane;
        const bf16_t* P = (const bf16_t*)(a.ws + WS_P);
        const float* LW = (const float*)((const unsigned char*)a.out + DO_LW); const bf16_t* ASIG = (const bf16_t*)((const unsigned char*)a.out + DO_ASIG);
        const float* mu = (const float*)a.in[I_MU];
        const float mu_r = mu[ci], mu_k = mu[512 + ci], mu_v = mu[1024 + ci], kkc = ((const float*)a.in[I_KK])[ci], kac = ((const float*)a.in[I_KA])[ci], rkc = ((const float*)a.in[I_RK])[ci];
        const int kpos = (lane & 32) + 8 * ((lane >> 2) & 3) + 4 * ((lane >> 4) & 1) + (lane & 3);
        LAS unsigned char* scr = lds + SCR0 + pw * SCR;
        unsigned short x_r[16], x_k[16], x_v[16], x_a[16], x_g[16]; float x_w[16]; unsigned short p_r, p_k, p_v;
        const __amdgpu_buffer_rsrc_t rsP = __builtin_amdgcn_make_buffer_rsrc((void*)(P + m0 * NP), 0, SEQ * NP * 2, 0x00020000);
        const __amdgpu_buffer_rsrc_t rsA = __builtin_amdgcn_make_buffer_rsrc((void*)(ASIG + m0 * 512), 0, SEQ * 512 * 2, 0x00020000);
        const __amdgpu_buffer_rsrc_t rsG = __builtin_amdgcn_make_buffer_rsrc((void*)((const bf16_t*)((const unsigned char*)a.out + DO_GG) + m0 * 512), 0, SEQ * 512 * 2, 0x00020000);
        const __amdgpu_buffer_rsrc_t rsW = __builtin_amdgcn_make_buffer_rsrc((void*)(LW + m0 * 512), 0, SEQ * 512 * 4, 0x00020000);
        const float* KN = (const float*)(a.ws + WS_KN) + m0 * 8 + h;
        const int voP = (C_RK + ci) * 2, voA = ci * 2, voW = ci * 4;
#define RW_LOAD(c) do { _Pragma("unroll") for (int t = 0; t < 16; ++t) { const int tk = 16 * (c) + t; \
            x_r[t] = __builtin_amdgcn_raw_buffer_load_b16(rsP, voP, tk * (NP * 2), 0); x_k[t] = __builtin_amdgcn_raw_buffer_load_b16(rsP, voP + 1024, tk * (NP * 2), 0); \
            x_v[t] = __builtin_amdgcn_raw_buffer_load_b16(rsP, voP + 2048, tk * (NP * 2), 0); x_a[t] = __builtin_amdgcn_raw_buffer_load_b16(rsA, voA, tk * 1024, 0); x_g[t] = __builtin_amdgcn_raw_buffer_load_b16(rsG, voA, tk * 1024, 0); \
            x_w[t] = __builtin_bit_cast(float, __builtin_amdgcn_raw_buffer_load_b32(rsW, voW, tk * 2048, 0)); } \
        if ((c) > 0) { const int tk = 16 * (c) - 1; p_r = __builtin_amdgcn_raw_buffer_load_b16(rsP, voP, tk * (NP * 2), 0); p_k = __builtin_amdgcn_raw_buffer_load_b16(rsP, voP + 1024, tk * (NP * 2), 0); \
            p_v = __builtin_amdgcn_raw_buffer_load_b16(rsP, voP + 2048, tk * (NP * 2), 0); } else { p_r = 0; p_k = 0; p_v = 0; } } while (0)
#define RW_LOADN(c) do { _Pragma("unroll") for (int t = 0; t < 16; ++t) { const int tk = 16 * (c) + t; \
            x_r[t] = __builtin_amdgcn_raw_buffer_load_b16(rsP, voP, tk * (NP * 2), 0); x_k[t] = __builtin_amdgcn_raw_buffer_load_b16(rsP, voP + 1024, tk * (NP * 2), 0); \
            x_v[t] = __builtin_amdgcn_raw_buffer_load_b16(rsP, voP + 2048, tk * (NP * 2), 0); x_a[t] = __builtin_amdgcn_raw_buffer_load_b16(rsA, voA, tk * 1024, 0); x_g[t] = __builtin_amdgcn_raw_buffer_load_b16(rsG, voA, tk * 1024, 0); \
            x_w[t] = __builtin_bit_cast(float, __builtin_amdgcn_raw_buffer_load_b32(rsW, voW, tk * 2048, 0)); } \
        { const int tk = 16 * (c) - 1; p_r = __builtin_amdgcn_raw_buffer_load_b16(rsP, voP, tk * (NP * 2), 0); p_k = __builtin_amdgcn_raw_buffer_load_b16(rsP, voP + 1024, tk * (NP * 2), 0); \
            p_v = __builtin_amdgcn_raw_buffer_load_b16(rsP, voP + 2048, tk * (NP * 2), 0); } } while (0)
        RW_LOAD(pw);
        for (int g = 0; g < NST; ++g) {
            {
                const int c = 4 * g + pw; LAS unsigned char* sl = lds + ((g & 1) * 4 + pw) * SLOT;
                float Bt[16], Kt[16], Vv[16], Rk[16];
                float cum = 0.f, ecp = 1.f, prr = bf2f(p_r), prk = bf2f(p_k), prv = bf2f(p_v);
#pragma unroll
                for (int t = 0; t < 16; ++t) {
                    const float cr = bf2f(x_r[t]), ck = bf2f(x_k[t]), cv = bf2f(x_v[t]);
                    const float r = cr + (prr - cr) * mu_r, k0 = ck + (prk - ck) * mu_k, v = cv + (prv - cv) * mu_v; prr = cr; prk = ck; prv = cv;
                    const float asg = bf2f(x_a[t]); const float kk = k0 * kkc * KN[(16 * c + t) * 8];
                    const float kx = k0 * (1.0f + (asg - 1.0f) * kac), bb = kk * asg;
                    cum += x_w[t]; const float ec = __expf(cum), eci = __builtin_amdgcn_rcpf(ec);
                    const float at = -kk * ecp, bt = bb * eci, kt = kx * eci, rtl = r * ec; ecp = ec;
                    *(LAS unsigned short*)(sl + O_AT + t * RS + 2 * kpos) = f2bf(at); *(LAS unsigned short*)(sl + O_RT + t * RS + 2 * kpos) = f2bf(rtl);
                    *(LAS unsigned short*)(scr + O_BT + t * RS + 2 * kpos) = f2bf(bt); *(LAS unsigned short*)(scr + O_KT + t * RS + 2 * kpos) = f2bf(kt);
                    Bt[t] = bt; Kt[t] = kt; Vv[t] = v; Rk[t] = rtl * rkc;
                }
                const float pl = ecp;
                *(LAS float*)(sl + O_PL + 4 * lane) = pl;
                { u32x4 w0, w1;
                  w0.x = cvt_pk_bf16(Bt[0] * pl, Bt[1] * pl); w0.y = cvt_pk_bf16(Bt[2] * pl, Bt[3] * pl); w0.z = cvt_pk_bf16(Bt[4] * pl, Bt[5] * pl); w0.w = cvt_pk_bf16(Bt[6] * pl, Bt[7] * pl);
                  w1.x = cvt_pk_bf16(Bt[8] * pl, Bt[9] * pl); w1.y = cvt_pk_bf16(Bt[10] * pl, Bt[11] * pl); w1.z = cvt_pk_bf16(Bt[12] * pl, Bt[13] * pl); w1.w = cvt_pk_bf16(Bt[14] * pl, Bt[15] * pl);
                  *(LAS u32x4*)(sl + O_BHT + lane * 32) = w0; *(LAS u32x4*)(sl + O_BHT + lane * 32 + 16) = w1;
                  w0.x = cvt_pk_bf16(Kt[0] * pl, Kt[1] * pl); w0.y = cvt_pk_bf16(Kt[2] * pl, Kt[3] * pl); w0.z = cvt_pk_bf16(Kt[4] * pl, Kt[5] * pl); w0.w = cvt_pk_bf16(Kt[6] * pl, Kt[7] * pl);
                  w1.x = cvt_pk_bf16(Kt[8] * pl, Kt[9] * pl); w1.y = cvt_pk_bf16(Kt[10] * pl, Kt[11] * pl); w1.z = cvt_pk_bf16(Kt[12] * pl, Kt[13] * pl); w1.w = cvt_pk_bf16(Kt[14] * pl, Kt[15] * pl);
                  *(LAS u32x4*)(sl + O_KHT + lane * 32) = w0; *(LAS u32x4*)(sl + O_KHT + lane * 32 + 16) = w1;
                  w0.x = cvt_pk_bf16(Vv[0], Vv[1]); w0.y = cvt_pk_bf16(Vv[2], Vv[3]); w0.z = cvt_pk_bf16(Vv[4], Vv[5]); w0.w = cvt_pk_bf16(Vv[6], Vv[7]);
                  w1.x = cvt_pk_bf16(Vv[8], Vv[9]); w1.y = cvt_pk_bf16(Vv[10], Vv[11]); w1.z = cvt_pk_bf16(Vv[12], Vv[13]); w1.w = cvt_pk_bf16(Vv[14], Vv[15]);
                  *(LAS u32x4*)(sl + O_VT + lane * 32) = w0; *(LAS u32x4*)(sl + O_VT + lane * 32 + 16) = w1;
                  w0.x = x_g[0] | ((unsigned)x_g[1] << 16); w0.y = x_g[2] | ((unsigned)x_g[3] << 16); w0.z = x_g[4] | ((unsigned)x_g[5] << 16); w0.w = x_g[6] | ((unsigned)x_g[7] << 16);
                  w1.x = x_g[8] | ((unsigned)x_g[9] << 16); w1.y = x_g[10] | ((unsigned)x_g[11] << 16); w1.z = x_g[12] | ((unsigned)x_g[13] << 16); w1.w = x_g[14] | ((unsigned)x_g[15] << 16);
                  *(LAS u32x4*)(sl + O_GT + lane * 32) = w0; *(LAS u32x4*)(sl + O_GT + lane * 32 + 16) = w1; }
                { const int cn = (g + 1 < NST) ? c + 4 : c; RW_LOADN(cn); }
                const bf16x8 af0 = *(const LAS bf16x8*)(sl + O_AT + li * RS + 16 * lq), af1 = *(const LAS bf16x8*)(sl + O_AT + li * RS + 64 + 16 * lq);
                const bf16x8 rf0 = *(const LAS bf16x8*)(sl + O_RT + li * RS + 16 * lq), rf1 = *(const LAS bf16x8*)(sl + O_RT + li * RS + 64 + 16 * lq);
                const bf16x8 bf0 = *(const LAS bf16x8*)(scr + O_BT + li * RS + 16 * lq), bf1 = *(const LAS bf16x8*)(scr + O_BT + li * RS + 64 + 16 * lq);
                const bf16x8 kf0 = *(const LAS bf16x8*)(scr + O_KT + li * RS + 16 * lq), kf1 = *(const LAS bf16x8*)(scr + O_KT + li * RS + 64 + 16 * lq);
                const f32x4 zero4 = (f32x4){0.f, 0.f, 0.f, 0.f};
                f32x4 nn = mfma32p(bf0, af0, zero4); nn = mfma32p(bf1, af1, nn);
                f32x4 ca = mfma32p(kf0, af0, zero4); ca = mfma32p(kf1, af1, ca);
                f32x4 cb = mfma32p(bf0, rf0, zero4); cb = mfma32p(bf1, rf1, cb);
                f32x4 ck = mfma32p(kf0, rf0, zero4); ck = mfma32p(kf1, rf1, ck);
#pragma unroll
                for (int t = 0; t < 16; ++t) *(LAS unsigned short*)(scr + O_RK + t * RS + 2 * kpos) = f2bf(Rk[t]);
                const bf16x8 qf0 = *(const LAS bf16x8*)(scr + O_RK + li * RS + 16 * lq), qf1 = *(const LAS bf16x8*)(scr + O_RK + li * RS + 64 + 16 * lq);
                f32x4 dk = mfma32p(kf0, qf0, zero4); dk = mfma32p(kf1, qf1, dk);
                if (lq == (li >> 2)) { const int e = li & 3; *(LAS float*)(sl + O_RKB + 4 * li) = e == 0 ? dk[0] : (e == 1 ? dk[1] : (e == 2 ? dk[2] : dk[3])); }
                f32x4 nt = mfma32p(af0, bf0, zero4); nt = mfma32p(af1, bf1, nt);
                f32x4 eye;
#pragma unroll
                for (int r = 0; r < 4; ++r) { const int i = 4 * lq + r; const bool lt = i < li, le = i <= li;
                    nn[r] = lt ? nn[r] : 0.f; ca[r] = lt ? ca[r] : 0.f; cb[r] = le ? cb[r] : 0.f; ck[r] = le ? ck[r] : 0.f; nt[r] = (li < i) ? nt[r] : 0.f; eye[r] = (i == li) ? 1.f : 0.f; }
                *(LAS bf16x4*)(sl + O_CAK + li * 32 + 8 * lq) = pack4(ca); *(LAS bf16x4*)(sl + O_CBR + li * 32 + 8 * lq) = pack4(cb); *(LAS bf16x4*)(sl + O_CKR + li * 32 + 8 * lq) = pack4(ck);
                { const bf16x4 nd_b = pack4(nn), nt_b = pack4(nt);
                  const f32x4 n2d = mfma16(nt_b, nd_b, zero4), n2t = mfma16(nd_b, nt_b, zero4);
                  const bf16x4 n2d_b = pack4(n2d), n2t_b = pack4(n2t);
                  const f32x4 n4d = mfma16(n2t_b, n2d_b, zero4), n4t = mfma16(n2d_b, n2t_b, zero4);
                  const f32x4 n8d = mfma16(pack4(n4t), pack4(n4d), zero4);
                  const f32x4 q1 = mfma16(pack4(n4t + eye), pack4(n8d + eye), zero4);
                  const f32x4 q2 = mfma16(pack4(n2t + eye), pack4(q1), zero4);
                  const f32x4 td = mfma16(pack4(nt + eye), pack4(q2), zero4);
                  *(LAS bf16x4*)(sl + O_TT + li * 32 + 8 * lq) = pack4(td); }
            }
            __syncthreads();
        }
        __syncthreads(); __syncthreads();
#undef RW_LOADN
#undef RW_LOAD
    }
}

__device__ __forceinline__ void retention_wg(LAS unsigned char* lds, int bh) {
    const Args a = load_args(); TIDS();
    const int b = bh >> 3, h = bh & 7;
    constexpr int QS_ = 72, TS_ = 136;
    LAS bf16_t* Qs = (LAS bf16_t*)lds;
    LAS bf16_t* Ks = Qs + 128 * QS_;
    LAS bf16_t* KzT = Ks + 128 * QS_;
    LAS bf16_t* VT = KzT + 64 * TS_;
    LAS bf16_t* Ps = VT + 64 * TS_;
    LAS bf16_t* RT = Ps + 128 * TS_;
    const bf16_t* P = (const bf16_t*)(a.ws + WS_P); const f32x2* ROPE = (const f32x2*)(a.ws + WS_ROPE); bf16_t* Y = (bf16_t*)(a.ws + WS_ACTA);
    const float* gnw = (const float*)a.in[I_RGNW]; const float* gnb = (const float*)a.in[I_RGNB];
    const float lg2 = log2f(1.0f - exp2f(-5.0f - (float)h));
    const float gch = exp2f(128.0f * lg2);
    for (int i = tid; i < 64 * QS_ / 2; i += 512) ((LAS unsigned*)RT)[i] = 0u;
    const int tk = tid >> 2, qd = tid & 3;
    const float zeta = exp2f((float)(127 - tk) * lg2);
    const int li = lane & 15, lq = lane >> 4, i0 = 16 * wave;
    const float xi = exp2f((float)(i0 + li + 1) * lg2);
    f32x4 Rst[2]; Rst[0] = (f32x4){0.f, 0.f, 0.f, 0.f}; Rst[1] = Rst[0];
    u32x4 gq1, gq2, gk1, gk2, gv1, gv2; f32x4 gr[4];
#define RT_LOAD(n) do { const size_t m = (size_t)b * SEQ + (n) * 128 + tk; const bf16_t* pr = P + m * NP + 64 * h; \
        gq1 = *(const u32x4*)(pr + 8 * qd); gq2 = *(const u32x4*)(pr + 32 + 8 * qd); gk1 = *(const u32x4*)(pr + 512 + 8 * qd); gk2 = *(const u32x4*)(pr + 544 + 8 * qd); \
        gv1 = *(const u32x4*)(pr + 1024 + 16 * qd); gv2 = *(const u32x4*)(pr + 1032 + 16 * qd); \
        const f32x4* rp = (const f32x4*)(ROPE + m * 32 + 8 * qd); gr[0] = rp[0]; gr[1] = rp[1]; gr[2] = rp[2]; gr[3] = rp[3]; } while (0)
    RT_LOAD(0);
    for (int n = 0; n < SEQ / 128; ++n) {
        { float q1[8], q2[8], k1[8], k2[8];
#pragma unroll
          for (int j = 0; j < 4; ++j) { q1[2 * j] = bflo(gq1[j]); q1[2 * j + 1] = bfhi(gq1[j]); q2[2 * j] = bflo(gq2[j]); q2[2 * j + 1] = bfhi(gq2[j]);
              k1[2 * j] = bflo(gk1[j]); k1[2 * j + 1] = bfhi(gk1[j]); k2[2 * j] = bflo(gk2[j]); k2[2 * j + 1] = bfhi(gk2[j]); }
          float oq1[8], oq2[8], ok1[8], ok2[8];
#pragma unroll
          for (int j = 0; j < 8; ++j) { const float cs = gr[j >> 1][2 * (j & 1)], sn = gr[j >> 1][2 * (j & 1) + 1];
              oq1[j] = q1[j] * cs - q2[j] * sn; oq2[j] = q2[j] * cs + q1[j] * sn;
              ok1[j] = (k1[j] * cs - k2[j] * sn) * 0.125f; ok2[j] = (k2[j] * cs + k1[j] * sn) * 0.125f; }
          u32x4 w;
          w.x = cvt_pk_bf16(oq1[0], oq1[1]); w.y = cvt_pk_bf16(oq1[2], oq1[3]); w.z = cvt_pk_bf16(oq1[4], oq1[5]); w.w = cvt_pk_bf16(oq1[6], oq1[7]); *(LAS u32x4*)(Qs + tk * QS_ + 8 * qd) = w;
          w.x = cvt_pk_bf16(oq2[0], oq2[1]); w.y = cvt_pk_bf16(oq2[2], oq2[3]); w.z = cvt_pk_bf16(oq2[4], oq2[5]); w.w = cvt_pk_bf16(oq2[6], oq2[7]); *(LAS u32x4*)(Qs + tk * QS_ + 32 + 8 * qd) = w;
          w.x = cvt_pk_bf16(ok1[0], ok1[1]); w.y = cvt_pk_bf16(ok1[2], ok1[3]); w.z = cvt_pk_bf16(ok1[4], ok1[5]); w.w = cvt_pk_bf16(ok1[6], ok1[7]); *(LAS u32x4*)(Ks + tk * QS_ + 8 * qd) = w;
          w.x = cvt_pk_bf16(ok2[0], ok2[1]); w.y = cvt_pk_bf16(ok2[2], ok2[3]); w.z = cvt_pk_bf16(ok2[4], ok2[5]); w.w = cvt_pk_bf16(ok2[6], ok2[7]); *(LAS u32x4*)(Ks + tk * QS_ + 32 + 8 * qd) = w;
#pragma unroll
          for (int j = 0; j < 8; ++j) { KzT[(8 * qd + j) * TS_ + tk] = (bf16_t)(cvt_pk_bf16(ok1[j] * zeta, 0.f) & 0xffffu); KzT[(32 + 8 * qd + j) * TS_ + tk] = (bf16_t)(cvt_pk_bf16(ok2[j] * zeta, 0.f) & 0xffffu); }
#pragma unroll
          for (int j = 0; j < 4; ++j) { VT[(16 * qd + 2 * j) * TS_ + tk] = (bf16_t)(gv1[j] & 0xffffu); VT[(16 * qd + 2 * j + 1) * TS_ + tk] = (bf16_t)(gv1[j] >> 16);
              VT[(16 * qd + 8 + 2 * j) * TS_ + tk] = (bf16_t)(gv2[j] & 0xffffu); VT[(16 * qd + 8 + 2 * j + 1) * TS_ + tk] = (bf16_t)(gv2[j] >> 16); } }
        if (n + 1 < SEQ / 128) RT_LOAD(n + 1);
        __syncthreads();
        bf16x8 qf[2];
        qf[0] = *(const LAS bf16x8*)(Qs + (i0 + li) * QS_ + 8 * lq); qf[1] = *(const LAS bf16x8*)(Qs + (i0 + li) * QS_ + 32 + 8 * lq);
        const int nks = (wave + 2) >> 1;
        for (int jt = 0; jt < 2 * nks; ++jt) {
            f32x4 s = (f32x4){0.f, 0.f, 0.f, 0.f};
            if (jt <= wave) {
                const bf16x8 kf0 = *(const LAS bf16x8*)(Ks + (16 * jt + li) * QS_ + 8 * lq), kf1 = *(const LAS bf16x8*)(Ks + (16 * jt + li) * QS_ + 32 + 8 * lq);
                s = __builtin_amdgcn_mfma_f32_16x16x32_bf16(kf0, qf[0], s, 0, 0, 0); s = __builtin_amdgcn_mfma_f32_16x16x32_bf16(kf1, qf[1], s, 0, 0, 0);
#pragma unroll
                for (int r = 0; r < 4; ++r) { const int dj = (i0 + li) - (16 * jt + 4 * lq + r); s[r] = dj >= 0 ? s[r] * exp2f((float)dj * lg2) : 0.f; }
            }
            u32x2 w; w.x = cvt_pk_bf16(s[0], s[1]); w.y = cvt_pk_bf16(s[2], s[3]);
            *(LAS u32x2*)(Ps + (i0 + li) * TS_ + 16 * jt + 4 * lq) = w;
        }
        f32x4 ai_[4], ax_[4];
#pragma unroll
        for (int et = 0; et < 4; ++et) { ai_[et] = (f32x4){0.f, 0.f, 0.f, 0.f}; ax_[et] = (f32x4){0.f, 0.f, 0.f, 0.f}; }
        for (int kk = 0; kk < nks; ++kk) { const bf16x8 pf = *(const LAS bf16x8*)(Ps + (i0 + li) * TS_ + 32 * kk + 8 * lq);
#pragma unroll
            for (int et = 0; et < 4; ++et) { const bf16x8 vf = *(const LAS bf16x8*)(VT + (16 * et + li) * TS_ + 32 * kk + 8 * lq); ai_[et] = __builtin_amdgcn_mfma_f32_16x16x32_bf16(vf, pf, ai_[et], 0, 0, 0); } }
#pragma unroll
        for (int kk = 0; kk < 2; ++kk)
#pragma unroll
            for (int et = 0; et < 4; ++et) { const bf16x8 rf = *(const LAS bf16x8*)(RT + (16 * et + li) * QS_ + 32 * kk + 8 * lq); ax_[et] = __builtin_amdgcn_mfma_f32_16x16x32_bf16(rf, qf[kk], ax_[et], 0, 0, 0); }
#pragma unroll
        for (int t2 = 0; t2 < 2; ++t2) { const int id = 2 * wave + t2, dt = id >> 2, et = id & 3; f32x4 kv = (f32x4){0.f, 0.f, 0.f, 0.f};
#pragma unroll
            for (int kk = 0; kk < 4; ++kk) { const bf16x8 kz = *(const LAS bf16x8*)(KzT + (16 * dt + li) * TS_ + 32 * kk + 8 * lq), vf = *(const LAS bf16x8*)(VT + (16 * et + li) * TS_ + 32 * kk + 8 * lq);
                kv = __builtin_amdgcn_mfma_f32_16x16x32_bf16(kz, vf, kv, 0, 0, 0); }
            Rst[t2] = Rst[t2] * gch + kv; }
        __syncthreads();
#pragma unroll
        for (int t2 = 0; t2 < 2; ++t2) { const int id = 2 * wave + t2, dt = id >> 2, et = id & 3; u32x2 w; w.x = cvt_pk_bf16(Rst[t2][0], Rst[t2][1]); w.y = cvt_pk_bf16(Rst[t2][2], Rst[t2][3]);
            *(LAS u32x2*)(RT + (16 * et + li) * QS_ + 16 * dt + 4 * lq) = w; }
        { float y[4][4]; float s = 0.f;
#pragma unroll
          for (int et = 0; et < 4; ++et)
#pragma unroll
              for (int r = 0; r < 4; ++r) { y[et][r] = ai_[et][r] + xi * ax_[et][r]; s += y[et][r]; }
          s += __shfl_xor(s, 16); s += __shfl_xor(s, 32); const float mean = s * (1.f / 64.f); float q = 0.f;
#pragma unroll
          for (int et = 0; et < 4; ++et)
#pragma unroll
              for (int r = 0; r < 4; ++r) { const float d = y[et][r] - mean; q += d * d; }
          q += __shfl_xor(q, 16); q += __shfl_xor(q, 32); const float rstd = 1.0f / sqrtf(q * (1.f / 64.f) + 1e-5f);
          const size_t m = (size_t)b * SEQ + n * 128 + i0 + li;
#pragma unroll
          for (int et = 0; et < 4; ++et) { const int e0 = 64 * h + 16 * et + 4 * lq; const u32x2 g2 = *(const u32x2*)(P + m * NP + 1536 + e0);
              const f32x4 gw4 = *(const f32x4*)(gnw + e0), gb4 = *(const f32x4*)(gnb + e0); float o[4];
              const float gg[4] = {bflo(g2.x), bfhi(g2.x), bflo(g2.y), bfhi(g2.y)};
#pragma unroll
              for (int r = 0; r < 4; ++r) { const float gn = (y[et][r] - mean) * rstd * gw4[r] + gb4[r]; o[r] = gg[r] * sigmoidf_(gg[r]) * gn; }
              u32x2 w; w.x = cvt_pk_bf16(o[0], o[1]); w.y = cvt_pk_bf16(o[2], o[3]); *(u32x2*)(Y + m * D + e0) = w; } }
    }
#undef RT_LOAD
}

__device__ __forceinline__ void phase_rwkv_fin() {
    const Args a = load_args(); TIDS();
    const bf16_t* P = (const bf16_t*)(a.ws + WS_P); const float* YRAW = (const float*)(a.ws + WS_ACTB); bf16_t* Y = (bf16_t*)(a.ws + WS_ACTA);
    const bf16_t* ASIG = (const bf16_t*)((const unsigned char*)a.out + DO_ASIG); const bf16_t* GG = (const bf16_t*)((const unsigned char*)a.out + DO_GG);
    const float* mu = (const float*)a.in[I_MU]; const float* ka = (const float*)a.in[I_KA]; const float* rk = (const float*)a.in[I_RK];
    const float* gnw = (const float*)a.in[I_WGNW]; const float* gnb = (const float*)a.in[I_WGNB];
    const int gw = blockIdx.x * NWAVES + wave, NGW = gridDim.x * NWAVES;
    for (int it = gw; it < M * 8; it += NGW) { const int m = it >> 3, h = it & 7, ci = 64 * h + lane;
        const float y = YRAW[(size_t)m * 512 + ci];
        const float mean = wave_sum(y) * (1.f / 64.f); const float d = y - mean; const float var = wave_sum(d * d) * (1.f / 64.f);
        const float yn = d * (1.0f / sqrtf(var + 64e-5f)) * gnw[ci] + gnb[ci];
        const bf16_t* pc = P + (size_t)m * NP + C_RK + ci;
        const float cr = bf2f(pc[0]), ck = bf2f(pc[512]), cv = bf2f(pc[1024]); float pr = 0.f, pk = 0.f, pv = 0.f;
        if ((m & (SEQ - 1)) != 0) { pr = bf2f(pc[-NP]); pk = bf2f(pc[512 - NP]); pv = bf2f(pc[1024 - NP]); }
        const float r = cr + (pr - cr) * mu[ci], k0 = ck + (pk - ck) * mu[512 + ci], v = cv + (pv - cv) * mu[1024 + ci];
        const float asg = bf2f(ASIG[(size_t)m * 512 + ci]); const float kx = k0 * (1.0f + (asg - 1.0f) * ka[ci]);
        const float bonus = wave_sum(r * kx * rk[ci]) * v;
        const float g = bf2f(GG[(size_t)m * 512 + ci]);
        Y[(size_t)m * D + 512 + ci] = (bf16_t)(cvt_pk_bf16((yn + bonus) * g, 0.f) & 0xffffu); }
}

#define XB_TMO      128
#define XB_XCNT(j)  (256  + 64 * (j))
#define XB_XSUB(j)  (1280 + 64 * (j))
#define XB_XGEN(j)  (2304 + 64 * (j))
#define XB_TOP      3328
#define XB_TOPGEN   3392
#define XCD_BAR_WORDS 3456
#define XB_SPIN_CAP (1u << 18)
__device__ __forceinline__ unsigned xb_ld(unsigned* p)              { return __hip_atomic_load(p, __ATOMIC_RELAXED, __HIP_MEMORY_SCOPE_AGENT); }
__device__ __forceinline__ unsigned xb_add(unsigned* p, unsigned v) { return __hip_atomic_fetch_add(p, v, __ATOMIC_RELAXED, __HIP_MEMORY_SCOPE_AGENT); }
__device__ __forceinline__ unsigned xb_xcc_id() { return (unsigned)__builtin_amdgcn_s_getreg((3 << 11) | 20) & 0xFu; }
#define XB_SPIN(cond, bar) do { unsigned _sp = 0; while (cond) { __builtin_amdgcn_s_sleep(1); \
    if ((++_sp & 255u) == 0u) { if (xb_ld(&(bar)[XB_TMO])) break; if (_sp > XB_SPIN_CAP) { atomicAdd(&(bar)[XB_TMO], 1u); break; } } } } while (0)
struct XcdBarrier { unsigned* bar; unsigned x; volatile LAS unsigned* st; };
__device__ __forceinline__ XcdBarrier xcd_barrier_post(unsigned* bar, volatile LAS unsigned* st) {
    XcdBarrier b; b.bar = bar; b.x = xb_xcc_id(); b.st = st;
    if (threadIdx.x == 0) (void)xb_add(&bar[XB_XCNT(b.x)], 1u);
    return b;
}
__device__ __forceinline__ void xcd_barrier_complete(unsigned* bar, unsigned x, unsigned& nloc, unsigned& nx) {
    const unsigned G = gridDim.x * gridDim.y * gridDim.z;
    unsigned sum, cnt, mine, sp = 0u;
    for (;;) {
        sum = 0u; cnt = 0u; mine = 0u;
#pragma unroll
        for (unsigned j = 0; j < 16; ++j) { const unsigned c = xb_ld(&bar[XB_XCNT(j)]); sum += c; cnt += (c > 0u) ? 1u : 0u; mine = (j == x) ? c : mine; }
        if (sum == G) break;
        __builtin_amdgcn_s_sleep(1);
        if ((++sp & 255u) == 0u) { if (xb_ld(&bar[XB_TMO])) break; if (sp > XB_SPIN_CAP) { atomicAdd(&bar[XB_TMO], 1u); break; } }
    }
    nloc = mine > 0u ? mine : 1u; nx = cnt > 0u ? cnt : 1u;
}
__device__ __forceinline__ void xcd_barrier(const XcdBarrier& b) {
    asm volatile("s_waitcnt vmcnt(0)" ::: "memory");
    __syncthreads();
    if (threadIdx.x == 0) {
        unsigned* bar = b.bar;
        __builtin_amdgcn_s_waitcnt(0);
        unsigned nloc = b.st[0], nx = b.st[1];
        if (nloc == 0u) { xcd_barrier_complete(bar, b.x, nloc, nx); b.st[0] = nloc; b.st[1] = nx; }
        const unsigned old = xb_add(&bar[XB_XSUB(b.x)], 1u);
        const unsigned gen = old / nloc;
        if (old + 1u == (gen + 1u) * nloc) {
            __builtin_amdgcn_fence(__ATOMIC_RELEASE, "agent");
            asm volatile("s_waitcnt vmcnt(0)" ::: "memory");
            const unsigned og = xb_add(&bar[XB_TOP], 1u);
            const unsigned tg = og / nx;
            if (og + 1u == (tg + 1u) * nx) xb_add(&bar[XB_TOPGEN], 1u);
            else XB_SPIN(xb_ld(&bar[XB_TOPGEN]) == tg, bar);
            __builtin_amdgcn_fence(__ATOMIC_ACQUIRE, "agent");
            xb_add(&bar[XB_XGEN(b.x)], 1u);
            asm volatile("s_waitcnt vmcnt(0)" ::: "memory");
        } else {
            XB_SPIN(xb_ld(&bar[XB_XGEN(b.x)]) == gen, bar);
            __builtin_amdgcn_fence(__ATOMIC_ACQUIRE, "agent");
            asm volatile("s_waitcnt vmcnt(0)" ::: "memory");
        }
    }
    __syncthreads();
}

__global__ void __launch_bounds__(NWAVES * 64, 2) mega(Args a_) {
    extern __shared__ __attribute__((aligned(16))) unsigned char lds_raw[];
    LAS unsigned char* lds = (LAS unsigned char*)lds_raw;
    cg::grid_group grid = cg::this_grid();
    const int G = gridDim.x, bx = blockIdx.x;
    volatile LAS unsigned* MISC = (volatile LAS unsigned*)(lds + MISC_OFF);
    if (threadIdx.x < 16) MISC[threadIdx.x] = 0u;
    __syncthreads();
    (void)xcd_barrier_post((unsigned*)a_.ws + 4096, MISC + 8);
#ifndef PHMASK
#define PHMASK 0xfff
#endif
#define IN(k) ((PHMASK >> (k)) & 1)
#define GSYNC() do { XcdBarrier xb_; xb_.bar = (unsigned*)load_args().ws + 4096; xb_.x = xb_xcc_id(); xb_.st = (volatile LAS unsigned*)(lds + MISC_OFF) + 8; xcd_barrier(xb_); } while (0)
#define SEAM(k) do { if (IN(k) && IN((k) + 1)) { if ((k) == 0) grid.sync(); else GSYNC(); } } while (0)
#define ARGS() const Args a = load_args(); unsigned char* ws = a.ws; (void)ws
#ifndef REPMASK
#define REPMASK 0
#endif
#ifndef NSYNC_EXTRA
#define NSYNC_EXTRA 0
#endif
#define REPS(k) (((REPMASK >> (k)) & 1) ? 2 : 1)
#define REPSYNC() do { if (rep) GSYNC(); } while (0)

    for (int i = 0; i < NSYNC_EXTRA; ++i) GSYNC();
    if (IN(0)) for (int rep = 0; rep < REPS(0); ++rep) { REPSYNC(); phase0(lds); }
    SEAM(0);
    if (IN(1)) for (int rep = 0; rep < REPS(1); ++rep) {   REPSYNC();
        ARGS();
        pg8::Gemm g{(const bf16_t*)(ws + WS_ACTA), (const bf16_t*)(ws + WS_WIN), D, D, D}; pg8::StaticOrder S; S.init(M, NP, G, bx);
        pg8::EpiStore<0, false> E{(bf16_t*)(ws + WS_P), NP, 1, 1, nullptr, 1.0f};
        pg8::gemm_phase<pg8::EpiStore<0, false>, pg8::StaticOrder, true>(lds, g, S, E);
    }
    SEAM(1);
    if (IN(2)) for (int rep = 0; rep < REPS(2); ++rep) { REPSYNC(); phase_lora_in(); }
    SEAM(2);
    if (IN(3)) for (int rep = 0; rep < REPS(3); ++rep) {   REPSYNC();
        ARGS();
        pg8::Gemm g{(const bf16_t*)(ws + WS_ACTB), (const bf16_t*)(ws + WS_LORA), LK, LK, LK}; pg8::StaticOrder S; S.init(M, LN, G, bx);
        pg8::EpiLora E{(float*)((unsigned char*)a.out + DO_LW), (bf16_t*)((unsigned char*)a.out + DO_ASIG), (bf16_t*)((unsigned char*)a.out + DO_GG), (const float*)a.in[I_W0], (const float*)a.in[I_A0]};
        pg8::gemm_phase<pg8::EpiLora, pg8::StaticOrder, true>(lds, g, S, E);
    }
    SEAM(3);
    if (IN(4)) for (int rep = 0; rep < REPS(4); ++rep) {   REPSYNC();
#ifndef REP_SCAN
#define REP_SCAN 1
#endif
#ifndef REP_RET
#define REP_RET 1
#endif
        if (bx < 64) { for (int r2 = 0; r2 < REP_SCAN; ++r2) { if (r2) __syncthreads(); rwkv_chunk_wg(lds, bx); } }
        else if (bx < 128) { for (int r2 = 0; r2 < REP_RET; ++r2) { if (r2) __syncthreads(); retention_wg(lds, bx - 64); } }
        else if (bx < 192) { ARGS(); const int idx = bx - 128;
            if (idx < 32) { pg8::Gemm g{(const bf16_t*)(ws + WS_MEMN), (const bf16_t*)(ws + WS_WKV), D, D, D}; pg8::OneUnit S{idx >> 2, idx & 3};
                pg8::EpiStore<0, false> E{(bf16_t*)(ws + WS_KM), D, 1, 1, nullptr, 1.0f}; pg8::gemm_phase<pg8::EpiStore<0, false>, pg8::OneUnit, true>(lds, g, S, E); }
            else { const int j = idx - 32; pg8::Gemm g{(const bf16_t*)(ws + WS_WKV) + (size_t)D * D, (const bf16_t*)(ws + WS_MEMN), D, D, D}; pg8::OneUnit S{j >> 3, j & 7};
                pg8::EpiStore<0, false> E{(bf16_t*)(ws + WS_VT), MM, 1, 1, nullptr, 1.0f}; pg8::gemm_phase<pg8::EpiStore<0, false>, pg8::OneUnit, true>(lds, g, S, E); } }
        else p0_late_weights(lds, bx - 192, G - 192);
    }
    SEAM(4);
    if (IN(6)) for (int rep = 0; rep < REPS(6); ++rep) {   REPSYNC();
        ARGS();
        pg8::Gemm g{(const bf16_t*)(ws + WS_ACTA), (const bf16_t*)(ws + WS_WOUT), D, D, D}; pg8::StaticOrder S; S.init(M, D, G, bx);
        pg8::EpiRes E{(const float*)a.in[I_X], a.out, (bf16_t*)(ws + WS_ACTB), (float*)(ws + WS_SQ1)};
        pg8::gemm_phase<pg8::EpiRes, pg8::StaticOrder, true>(lds, g, S, E);
    }
    SEAM(6);
    if (IN(7)) for (int rep = 0; rep < REPS(7); ++rep) {   REPSYNC();
        if (bx < 256) { ARGS(); const int u = bx; const int b = u >> 5, h4 = (u >> 3) & 3, qt = u & 7; const int pm = b * 8 + qt;
            bf16_t* QS = (bf16_t*)(ws + WS_P) + (size_t)u * 131072; bf16_t* PSb = QS + 65536;
            { pg8::Gemm g{(const bf16_t*)(ws + WS_ACTB), (const bf16_t*)(ws + WS_WQ), D, D, D}; pg8::OneUnit S{pm, h4};
              pg8::EpiStore<0, true> E{QS, 256, 0, 0, (const float*)(ws + WS_SQ1), 0.0625f}; pg8::gemm_phase<pg8::EpiStore<0, true>, pg8::OneUnit, true>(lds, g, S, E); }
            asm volatile("s_waitcnt vmcnt(0)" ::: "memory"); __syncthreads(); __builtin_amdgcn_fence(__ATOMIC_ACQUIRE, "agent"); asm volatile("s_waitcnt vmcnt(0)" ::: "memory"); __syncthreads();
            { pg8::Gemm g{QS, (const bf16_t*)(ws + WS_KM) + (size_t)(b * 256) * D + h4 * 256, 256, D, 256}; pg8::OneUnit S{0, 0};
              pg8::EpiSoftmax E{PSb}; pg8::gemm_phase<pg8::EpiSoftmax, pg8::OneUnit, false>(lds, g, S, E); }
            asm volatile("s_waitcnt vmcnt(0)" ::: "memory"); __syncthreads(); __builtin_amdgcn_fence(__ATOMIC_ACQUIRE, "agent"); asm volatile("s_waitcnt vmcnt(0)" ::: "memory"); __syncthreads();
            { pg8::Gemm g{PSb, (const bf16_t*)(ws + WS_VT) + (size_t)(h4 * 256) * MM + b * 256, 256, MM, 256}; pg8::OneUnit S{0, 0};
              pg8::EpiStore<0, false> E{(bf16_t*)(ws + WS_ACTA) + (size_t)(pm * 256) * D + h4 * 256, D, 0, 0, nullptr, 1.0f}; pg8::gemm_phase<pg8::EpiStore<0, false>, pg8::OneUnit, true>(lds, g, S, E); }
            __syncthreads();
        }
    }
    SEAM(7);
    if (IN(8)) {
        ARGS();
        pg8::Gemm g{(const bf16_t*)(ws + WS_ACTA), (const bf16_t*)(ws + WS_WO), D, D, D}; pg8::StaticOrder S; S.init(M, D, G, bx);
        pg8::EpiRes E{a.out, a.out, (bf16_t*)(ws + WS_ACTB), (float*)(ws + WS_SQ2)};
        pg8::gemm_phase<pg8::EpiRes, pg8::StaticOrder, true>(lds, g, S, E);
    }
    SEAM(8);
    if (IN(9)) for (int rep = 0; rep < REPS(9); ++rep) {   REPSYNC();
        ARGS();
        pg8::Gemm g{(const bf16_t*)(ws + WS_ACTB), (const bf16_t*)(ws + WS_WUP), D, D, D}; pg8::StaticOrder S; S.init(M, FF, G, bx);
        pg8::EpiStore<2, true> E{(bf16_t*)(ws + WS_P), FF, 1, 1, (const float*)(ws + WS_SQ2), 1.0f};
        pg8::gemm_phase<pg8::EpiStore<2, true>, pg8::StaticOrder, true>(lds, g, S, E);
    }
    SEAM(9);
    if (IN(10)) {
        ARGS();
        pg8::Gemm g{(const bf16_t*)(ws + WS_P), (const bf16_t*)(ws + WS_WDN), FF, FF, FF}; pg8::StaticOrder S; S.init(M, D, G, bx);
        pg8::EpiRes E{a.out, a.out, nullptr, (float*)(ws + WS_SQ3)};
        pg8::gemm_phase<pg8::EpiRes, pg8::StaticOrder, true>(lds, g, S, E);
    }
    SEAM(10);
    if (IN(11)) {
        ARGS(); TIDS();
        const float* sq = (const float*)(ws + WS_SQ3); const float* gf = (const float*)a.in[I_NFIN];
        const int gw = bx * NWAVES + wave, NGW = G * NWAVES;
        f32x4 gv[4];
#pragma unroll
        for (int j = 0; j < 4; ++j) gv[j] = ((const f32x4*)gf)[lane + 64 * j];
        for (int m = gw; m < M; m += NGW) { const f32x4* q4 = (const f32x4*)(sq + (size_t)m * 16); const f32x4 s = q4[0] + q4[1] + q4[2] + q4[3];
            const float rstd = 1.0f / sqrtf((s[0] + s[1] + s[2] + s[3]) * (1.f / 1024.f) + 1e-6f);
            f32x4* xr = (f32x4*)(a.out + (size_t)m * D) + lane;
#pragma unroll
            for (int j = 0; j < 4; ++j) xr[64 * j] = xr[64 * j] * rstd * gv[j]; }
    }
#undef IN
#undef SEAM
#undef ARGS
}

extern "C" void kernel_launch(void* const* d_in, const int* in_sizes, int n_in, void* d_out, int out_size, void* d_ws, size_t ws_size, hipStream_t stream) {
    static int grid = 0;
    if (grid == 0) {
        if (n_in != 28 || out_size != M * D || ws_size < WS_END) { fprintf(stderr, "kernel_launch: unexpected shapes (n_in %d out %d ws %zu)\n", n_in, out_size, ws_size); grid = -1; return; }
        int dev = 0, cus = 0, per_cu = 0;
        if (hipGetDevice(&dev) != hipSuccess || hipDeviceGetAttribute(&cus, hipDeviceAttributeMultiprocessorCount, dev) != hipSuccess) { grid = -1; return; }
        if (hipFuncSetAttribute((const void*)mega, hipFuncAttributeMaxDynamicSharedMemorySize, LDS_BYTES) != hipSuccess) { fprintf(stderr, "kernel_launch: hipFuncSetAttribute failed\n"); grid = -1; return; }
        if (hipOccupancyMaxActiveBlocksPerMultiprocessor(&per_cu, (const void*)mega, NWAVES * 64, LDS_BYTES) != hipSuccess || per_cu < 1) { fprintf(stderr, "kernel_launch: occupancy query says %d\n", per_cu); (void)hipGetLastError(); }
        grid = cus;
        if (grid != 256) fprintf(stderr, "kernel_launch: %d CUs (built for 256)\n", grid);
    }
    if (grid < 0) return;
    if (hipMemsetAsync(d_ws, 0, 65536, stream) != hipSuccess) { fprintf(stderr, "kernel_launch: memset failed\n"); return; }
    Args a{};
    for (int i = 0; i < 28; ++i) a.in[i] = d_in[i];
    a.out = (float*)d_out; a.ws = (unsigned char*)d_ws; a.ph_lo = 0; a.ph_hi = 12;
    void* args[] = {&a};
    hipError_t e = hipLaunchCooperativeKernel((const void*)mega, dim3(grid), dim3(NWAVES * 64), args, LDS_BYTES, stream);
    if (e != hipSuccess) fprintf(stderr, "cooperative launch failed: %s (grid %d)\n", hipGetErrorString(e), grid);
}
```

```cpp
#include <hip/hip_runtime.h>
#include <hip/hip_cooperative_groups.h>
#include <cstdio>
#include <cstdint>
namespace cg = cooperative_groups;
#define REPMASK 0
#define NSYNC_EXTRA 0
#define REP_SCAN 1
#define REP_RET 1

#define LAS __attribute__((address_space(3)))
typedef unsigned short bf16_t;
typedef short bf16x8 __attribute__((ext_vector_type(8)));
typedef float f32x4 __attribute__((ext_vector_type(4)));
typedef float f32x2 __attribute__((ext_vector_type(2)));
typedef unsigned u32x4 __attribute__((ext_vector_type(4)));
typedef unsigned u32x2 __attribute__((ext_vector_type(2)));

typedef __bf16 bf16x2_t __attribute__((ext_vector_type(2)));
__device__ __forceinline__ unsigned cvt_pk_bf16(float lo, float hi) { f32x2 v = {lo, hi}; bf16x2_t b = __builtin_convertvector(v, bf16x2_t); return __builtin_bit_cast(unsigned, b); }
__device__ __forceinline__ float bf2f(unsigned short b) { return __uint_as_float(((unsigned)b) << 16); }
__device__ __forceinline__ float bflo(unsigned w) { return __uint_as_float(w << 16); }
__device__ __forceinline__ float bfhi(unsigned w) { return __uint_as_float(w & 0xffff0000u); }
__device__ __forceinline__ float sigmoidf_(float x) { return __builtin_amdgcn_rcpf(1.0f + __expf(-x)); }
__device__ __forceinline__ float wave_sum(float v) {
#pragma unroll
    for (int o = 1; o < 64; o <<= 1) v += __shfl_xor(v, o);
    return v;
}

namespace pg8 {
constexpr int BM = 256, BK = 64, HALF = 128, HTB = HALF * BK * 2, STAGE_BYTES = 8 * HTB, NXCD = 8, WGM = 8;
__host__ __device__ __forceinline__ int lds_byte(int r, int c) { const int st = (r >> 4) * 2 + (c >> 5), rr = r & 15, cc = c & 31, ob = rr * 64 + cc * 2; return st * 1024 + (ob ^ (((ob >> 9) & 1) << 5)); }
__host__ __device__ __forceinline__ void stage_rc(int b, int& R, int& C) { const int st = b / 1024, sb = b % 1024, swz = sb ^ (((sb >> 9) & 1) << 5); R = (st >> 1) * 16 + swz / 64; C = (st & 1) * 32 + (swz % 64) / 2; }
__host__ __device__ __forceinline__ int perm32(int rho) { const int n = rho >> 4, i = rho & 15; return 8 * (i >> 2) + 4 * n + (i & 3); }

struct Unit { int pm, pn; };
struct Gemm { const bf16_t* A; const bf16_t* Bt; int lda, ldb, K; };

struct StaticOrder {
    int nM, nN, nwg, G, c;
    __device__ void init(int M, int N, int G_, int c_) { nM = M / BM; nN = N / BM; nwg = nM * nN; G = G_; c = c_; }
    __device__ bool next(int i, Unit& u) const {
        const long L = (long)i * G + c; if (L >= nwg) return false;
        int wgid = (int)L; { const int q = nwg / NXCD, r = nwg % NXCD, xcd = wgid % NXCD, off = wgid / NXCD; wgid = (xcd < r ? xcd * (q + 1) : r * (q + 1) + (xcd - r) * q) + off; }
        const int nig = WGM * nN, gid = wgid / nig, fm = gid * WGM, gsz = (nM - fm) < WGM ? (nM - fm) : WGM;
        u.pm = fm + ((wgid % nig) % gsz); u.pn = (wgid % nig) / gsz; return true;
    }
};
struct OneUnit {
    int pm, pn;
    __device__ bool next(int i, Unit& u) const { if (i) return false; u.pm = pm; u.pn = pn; return true; }
};


template <int ACT, bool RS> struct EpiStore {
    static constexpr bool PERM = true, AFTER_DRAIN = false;
    bf16_t* O; int ldc; int om, on; const float* sq; float cs;
    __device__ __forceinline__ void operator()(const f32x4 (&acc)[2][2][4][2], const Unit& u, int wr, int wc, int fr, int fq) const {
        int rl0 = wr * 64 + fr, cl0 = wc * 32 + 8 * fq; asm volatile("" : "+v"(rl0), "+v"(cl0));
        bf16_t* base = O + (size_t)(om * u.pm * BM) * ldc + on * u.pn * BM + cl0;
#pragma unroll
        for (int ai = 0; ai < 2; ++ai)
#pragma unroll
            for (int m = 0; m < 4; ++m) {
                const int rl = rl0 + ai * HALF + m * 16;
                float sc = cs;
                if (RS) { const f32x4* q4 = (const f32x4*)(sq + (size_t)(u.pm * BM + rl) * 16); f32x4 s = q4[0] + q4[1] + q4[2] + q4[3];
                    sc *= __builtin_amdgcn_rsqf((s[0] + s[1] + s[2] + s[3]) * (1.0f / 1024.0f) + 1e-6f); }
                bf16_t* rowp = base + (size_t)rl * ldc;
#pragma unroll
                for (int bj = 0; bj < 2; ++bj) { f32x4 v0 = acc[ai][bj][m][0] * sc, v1 = acc[ai][bj][m][1] * sc;
                    if (ACT == 2) {
#pragma unroll
                        for (int j = 0; j < 4; ++j) { float x = fmaxf(v0[j], 0.f); v0[j] = x * x; float y = fmaxf(v1[j], 0.f); v1[j] = y * y; } }
                    u32x4 w; w.x = cvt_pk_bf16(v0[0], v0[1]); w.y = cvt_pk_bf16(v0[2], v0[3]); w.z = cvt_pk_bf16(v1[0], v1[1]); w.w = cvt_pk_bf16(v1[2], v1[3]);
                    *(u32x4*)(rowp + bj * HALF) = w; } }
    }
};

struct EpiLora {
    static constexpr bool PERM = true, AFTER_DRAIN = false;
    float* LW; bf16_t* ASIG; bf16_t* GG; const float* w0; const float* a0;
    template <int SECT> __device__ __forceinline__ void run(const f32x4 (&acc)[2][2][4][2], int rl0, int c0) const {
        const float* cvec = SECT == 0 ? w0 : a0; bf16_t* ob = SECT == 1 ? ASIG : GG;
#pragma unroll
        for (int ai = 0; ai < 2; ++ai)
#pragma unroll
            for (int m = 0; m < 4; ++m) {
                const size_t row = (size_t)(rl0 + ai * HALF + m * 16);
#pragma unroll
                for (int bj = 0; bj < 2; ++bj) { const int c = c0 + bj * HALF; f32x4 v0 = acc[ai][bj][m][0], v1 = acc[ai][bj][m][1];
                    if (SECT < 2) { v0 += *(const f32x4*)(cvec + c); v1 += *(const f32x4*)(cvec + c + 4); }
                    if (SECT == 0) {
#pragma unroll
                        for (int j = 0; j < 4; ++j) { v0[j] = -0.60653065971f * sigmoidf_(v0[j]); v1[j] = -0.60653065971f * sigmoidf_(v1[j]); }
                        *(f32x4*)(LW + row * 512 + c) = v0; *(f32x4*)(LW + row * 512 + c + 4) = v1;
                    } else {
                        if (SECT == 1) {
#pragma unroll
                            for (int j = 0; j < 4; ++j) { v0[j] = sigmoidf_(v0[j]); v1[j] = sigmoidf_(v1[j]); } }
                        u32x4 w; w.x = cvt_pk_bf16(v0[0], v0[1]); w.y = cvt_pk_bf16(v0[2], v0[3]); w.z = cvt_pk_bf16(v1[0], v1[1]); w.w = cvt_pk_bf16(v1[2], v1[3]);
                        *(u32x4*)(ob + row * 512 + c) = w; } }
                asm volatile("" ::: "memory"); }
    }
    __device__ __forceinline__ void operator()(const f32x4 (&acc)[2][2][4][2], const Unit& u, int wr, int wc, int fr, int fq) const {
        int rl0 = u.pm * BM + wr * 64 + fr, c0 = (u.pn & 1) * BM + wc * 32 + 8 * fq; const int sect = u.pn >> 1; asm volatile("" : "+v"(rl0), "+v"(c0));
        if (sect == 0) run<0>(acc, rl0, c0); else if (sect == 1) run<1>(acc, rl0, c0); else run<2>(acc, rl0, c0);
    }
};

template <bool BB> struct EpiRes {
    static constexpr bool PERM = true, AFTER_DRAIN = false;
    const void* base; float* out; bf16_t* xb; float* sq;
    __device__ __forceinline__ void operator()(const f32x4 (&acc)[2][2][4][2], const Unit& u, int wr, int wc, int fr, int fq) const {
        int rl0 = u.pm * BM + wr * 64 + fr, c0 = u.pn * BM + wc * 32 + 8 * fq; asm volatile("" : "+v"(rl0), "+v"(c0));
#pragma unroll
        for (int ai = 0; ai < 2; ++ai)
#pragma unroll
            for (int m = 0; m < 4; ++m) {
                const size_t row = (size_t)(rl0 + ai * HALF + m * 16); float ss = 0.f;
#pragma unroll
                for (int bj = 0; bj < 2; ++bj) { const size_t off = row * 1024 + c0 + bj * HALF;
                    f32x4 b0, b1;
                    if (BB) { const u32x4 w = *(const u32x4*)((const bf16_t*)base + off); b0 = (f32x4){bflo(w.x), bfhi(w.x), bflo(w.y), bfhi(w.y)}; b1 = (f32x4){bflo(w.z), bfhi(w.z), bflo(w.w), bfhi(w.w)}; }
                    else { b0 = *(const f32x4*)((const float*)base + off); b1 = *(const f32x4*)((const float*)base + off + 4); }
                    const f32x4 o0 = b0 + acc[ai][bj][m][0], o1 = b1 + acc[ai][bj][m][1];
                    if (out) { *(f32x4*)(out + off) = o0; *(f32x4*)(out + off + 4) = o1; }
                    if (xb) { u32x4 w; w.x = cvt_pk_bf16(o0[0], o0[1]); w.y = cvt_pk_bf16(o0[2], o0[3]); w.z = cvt_pk_bf16(o1[0], o1[1]); w.w = cvt_pk_bf16(o1[2], o1[3]); *(u32x4*)(xb + off) = w; }
                    ss += (o0[0] * o0[0] + o0[1] * o0[1]) + (o0[2] * o0[2] + o0[3] * o0[3]) + (o1[0] * o1[0] + o1[1] * o1[1]) + (o1[2] * o1[2] + o1[3] * o1[3]); }
                ss += __shfl_xor(ss, 16); ss += __shfl_xor(ss, 32);
                if (fq == 0) sq[row * 16 + u.pn * 4 + wc] = ss;
                if (m & 1) asm volatile("" ::: "memory"); }
    }
};

struct EpiSoftmax {
    static constexpr bool PERM = true, AFTER_DRAIN = true;
    bf16_t* Pout;
    __device__ __forceinline__ void fused(f32x4 (&acc)[2][2][4][2], const Unit& u, int wr, int wc, int fr, int fq, LAS unsigned char* lds, int wid, int lane) const {
        LAS float* PM = (LAS float*)lds;
        LAS float* PS = (LAS float*)(lds + 4096);
        int rl0 = wr * 64 + fr; asm volatile("" : "+v"(rl0));
#pragma unroll
        for (int ai = 0; ai < 2; ++ai)
#pragma unroll
            for (int m = 0; m < 4; ++m) { float v = -3.0e38f;
#pragma unroll
                for (int bj = 0; bj < 2; ++bj)
#pragma unroll
                    for (int n = 0; n < 2; ++n) { const f32x4 x = acc[ai][bj][m][n]; v = fmaxf(v, fmaxf(fmaxf(x[0], x[1]), fmaxf(x[2], x[3]))); }
                v = fmaxf(v, __shfl_xor(v, 16)); v = fmaxf(v, __shfl_xor(v, 32));
                if (fq == 0) PM[(rl0 + ai * HALF + m * 16) * 4 + wc] = v; }
        asm volatile("s_waitcnt lgkmcnt(0)" ::: "memory"); __builtin_amdgcn_s_barrier(); asm volatile("" ::: "memory");
#pragma unroll
        for (int ai = 0; ai < 2; ++ai)
#pragma unroll
            for (int m = 0; m < 4; ++m) { const f32x4 p = *(const LAS f32x4*)(PM + (rl0 + ai * HALF + m * 16) * 4);
                const float rm = fmaxf(fmaxf(p[0], p[1]), fmaxf(p[2], p[3])) * 1.44269504089f; float s = 0.f;
#pragma unroll
                for (int bj = 0; bj < 2; ++bj)
#pragma unroll
                    for (int n = 0; n < 2; ++n) {
#pragma unroll
                        for (int j = 0; j < 4; ++j) { const float e = __builtin_amdgcn_exp2f(acc[ai][bj][m][n][j] * 1.44269504089f - rm); acc[ai][bj][m][n][j] = e; s += e; } }
                s += __shfl_xor(s, 16); s += __shfl_xor(s, 32);
                if (fq == 0) PS[(rl0 + ai * HALF + m * 16) * 4 + wc] = s; }
        asm volatile("s_waitcnt lgkmcnt(0)" ::: "memory"); __builtin_amdgcn_s_barrier(); asm volatile("" ::: "memory");
#pragma unroll
        for (int ai = 0; ai < 2; ++ai)
#pragma unroll
            for (int m = 0; m < 4; ++m) { const int rl = rl0 + ai * HALF + m * 16; const f32x4 p = *(const LAS f32x4*)(PS + rl * 4);
                const float inv = __builtin_amdgcn_rcpf((p[0] + p[1]) + (p[2] + p[3]));
#pragma unroll
                for (int bj = 0; bj < 2; ++bj) { const f32x4 v0 = acc[ai][bj][m][0] * inv, v1 = acc[ai][bj][m][1] * inv;
                    u32x4 w; w.x = cvt_pk_bf16(v0[0], v0[1]); w.y = cvt_pk_bf16(v0[2], v0[3]); w.z = cvt_pk_bf16(v1[0], v1[1]); w.w = cvt_pk_bf16(v1[2], v1[3]);
                    *(u32x4*)(Pout + (size_t)rl * 256 + wc * 32 + 8 * fq + bj * HALF) = w; } }
    }
};

template <class Epi, class Sched, bool ALIGN_EPI = false, bool SP2 = true>
__device__ __forceinline__ void gemm_phase(LAS unsigned char* lds, const Gemm g, const Sched& S, const Epi& E) {
    int tid = threadIdx.x; asm volatile("" : "+v"(tid));
    const int wid = __builtin_amdgcn_readfirstlane(tid >> 6), lane = tid & 63, wr = wid >> 2, wc = wid & 3, fr = lane & 15, fq = lane >> 4;
    const int K = g.K, nt = K / BK;
    unsigned voffA[2], voffB[2];
#pragma unroll
    for (int i = 0; i < 2; ++i) { int R, C; stage_rc(tid * 16 + i * 8192, R, C); const int Rb = Epi::PERM ? ((R & ~31) + perm32(R & 31)) : R;
        voffA[i] = (unsigned)(R * g.lda + C) * 2u; voffB[i] = (unsigned)(Rb * g.ldb + C) * 2u; }
    const size_t kstep = (size_t)(BK * 2);
    const size_t hstepA = (size_t)HALF * g.lda * 2, hstepB = (size_t)HALF * g.ldb * 2;
    const size_t tstepA = 2 * hstepA, tstepB = 2 * hstepB;
    const unsigned ldsw = (unsigned)wid * 1024u;
    const int aoff = lds_byte(wr * 64 + fr, fq * 8), boff = lds_byte(wc * 32 + fr, fq * 8);
#define PG8_SA(b, h) (((b) * 2 + (h)) * HTB)
#define PG8_SB(b, h) ((4 + (b) * 2 + (h)) * HTB)
#define PG8_STAGE(bufoff, gbase, voff) do { _Pragma("unroll") for (int _i = 0; _i < 2; ++_i) \
        __builtin_amdgcn_global_load_lds((const unsigned*)((const char*)(gbase) + (voff)[_i]), (LAS unsigned*)(lds + (bufoff) + ldsw + _i * 8192), 16, 0, 0); } while (0)
#define PG8_LDA(dst, b, h) do { _Pragma("unroll") for (int m = 0; m < 4; ++m) _Pragma("unroll") for (int k = 0; k < 2; ++k) dst[m][k] = *(const LAS bf16x8*)(lds + PG8_SA(b, h) + aoff + m * 2048 + k * 1024); } while (0)
#define PG8_LDB(dst, b, h) do { _Pragma("unroll") for (int n = 0; n < 2; ++n) _Pragma("unroll") for (int k = 0; k < 2; ++k) dst[n][k] = *(const LAS bf16x8*)(lds + PG8_SB(b, h) + boff + n * 2048 + k * 1024); } while (0)
#define PG8_MMA(ai, bj, At, Bt) do { __builtin_amdgcn_s_setprio(1); _Pragma("unroll") for (int m = 0; m < 4; ++m) _Pragma("unroll") for (int n = 0; n < 2; ++n) _Pragma("unroll") for (int k = 0; k < 2; ++k) \
        acc[ai][bj][m][n] = __builtin_amdgcn_mfma_f32_16x16x32_bf16(Bt[n][k], At[m][k], acc[ai][bj][m][n], 0, 0, 0); __builtin_amdgcn_s_setprio(0); } while (0)
#define PG8_WAIT_V(n) asm volatile("s_waitcnt vmcnt(" #n ")" ::: "memory")
#define PG8_WAIT_L(n) asm volatile("s_waitcnt lgkmcnt(" #n ")" ::: "memory")
#define PG8_BAR __builtin_amdgcn_s_barrier()
#define PG8_SCHED __builtin_amdgcn_sched_barrier(0)
    Unit cur, nxt; int ui = 0;
    if (!S.next(0, cur)) return;
    f32x4 acc[2][2][4][2];
#pragma unroll
    for (int a = 0; a < 2; ++a)
#pragma unroll
        for (int b = 0; b < 2; ++b)
#pragma unroll
            for (int m = 0; m < 4; ++m)
#pragma unroll
                for (int n = 0; n < 2; ++n) acc[a][b][m][n] = (f32x4){0.f, 0.f, 0.f, 0.f};
    bf16x8 At[4][2], B0[2][2], B1[2][2];
    const char* cA = (const char*)g.A + (size_t)cur.pm * tstepA; const char* cB = (const char*)g.Bt + (size_t)cur.pn * tstepB;
    static_assert(SP2, "only the two-super-phase loop is kept here");
    PG8_STAGE(PG8_SB(0, 0), cB, voffB); PG8_STAGE(PG8_SB(0, 1), cB + hstepB, voffB); PG8_STAGE(PG8_SA(0, 0), cA, voffA); PG8_STAGE(PG8_SA(0, 1), cA + hstepA, voffA);
    if (wr == 1) PG8_BAR;
    PG8_WAIT_V(2); PG8_BAR;
    PG8_STAGE(PG8_SB(1, 0), cB + kstep, voffB); PG8_STAGE(PG8_SA(1, 0), cA + kstep, voffA); PG8_STAGE(PG8_SB(1, 1), cB + hstepB + kstep, voffB);
    PG8_WAIT_V(6); PG8_BAR;
    for (;;) {
        const bool has_next = S.next(ui + 1, nxt);
        const char* nA = has_next ? (const char*)g.A + (size_t)nxt.pm * tstepA : cA; const char* nB = has_next ? (const char*)g.Bt + (size_t)nxt.pn * tstepB : cB;
        for (int t = 0; t < nt; t += 2) {
            const bool last = (t == nt - 2);
            const char* a1 = cA + (size_t)(t + 1) * kstep;
            const char* a2 = last ? nA : cA + (size_t)(t + 2) * kstep; const char* b2 = last ? nB : cB + (size_t)(t + 2) * kstep;
            const char* a3 = a2 + kstep; const char* b3 = b2 + kstep;
            PG8_LDB(B0, 0, 0); PG8_LDB(B1, 0, 1); PG8_SCHED; PG8_LDA(At, 0, 0); PG8_STAGE(PG8_SA(1, 1), a1 + hstepA, voffA);
            PG8_WAIT_V(8); PG8_WAIT_L(0); PG8_BAR; PG8_MMA(0, 0, At, B0); PG8_MMA(0, 1, At, B1); PG8_BAR; PG8_SCHED;
            PG8_LDA(At, 0, 1); PG8_STAGE(PG8_SB(0, 0), b2, voffB); PG8_STAGE(PG8_SB(0, 1), b2 + hstepB, voffB); PG8_STAGE(PG8_SA(0, 0), a2, voffA);
            PG8_WAIT_V(8); PG8_WAIT_L(0); PG8_BAR; PG8_MMA(1, 0, At, B0); PG8_MMA(1, 1, At, B1); PG8_BAR; PG8_SCHED;
            PG8_LDB(B0, 1, 0); PG8_LDB(B1, 1, 1); PG8_SCHED; PG8_LDA(At, 1, 0); PG8_STAGE(PG8_SA(0, 1), a2 + hstepA, voffA);
            PG8_WAIT_V(8); PG8_WAIT_L(0); PG8_BAR; PG8_MMA(0, 0, At, B0); PG8_MMA(0, 1, At, B1); PG8_BAR; PG8_SCHED;
            PG8_LDA(At, 1, 1); PG8_STAGE(PG8_SB(1, 0), b3, voffB); PG8_STAGE(PG8_SB(1, 1), b3 + hstepB, voffB); PG8_STAGE(PG8_SA(1, 0), a3, voffA);
            PG8_WAIT_V(8); PG8_WAIT_L(0); PG8_BAR; PG8_MMA(1, 0, At, B0); PG8_MMA(1, 1, At, B1); PG8_BAR; PG8_SCHED;
        }
        if constexpr (ALIGN_EPI) { if (wr == 0) PG8_BAR; }
        if constexpr (!Epi::AFTER_DRAIN) { E(acc, cur, wr, wc, fr, fq); }
        if (!has_next) break;
#pragma unroll
        for (int a = 0; a < 2; ++a)
#pragma unroll
            for (int b = 0; b < 2; ++b)
#pragma unroll
                for (int m = 0; m < 4; ++m)
#pragma unroll
                    for (int n = 0; n < 2; ++n) acc[a][b][m][n] = (f32x4){0.f, 0.f, 0.f, 0.f};
        cur = nxt; cA = nA; cB = nB; ++ui;
        if constexpr (ALIGN_EPI) { if (wr == 1) PG8_BAR; }
    }
    PG8_WAIT_V(0);
    if constexpr (!ALIGN_EPI) { if (wr == 0) PG8_BAR; }
    PG8_BAR;
    if constexpr (Epi::AFTER_DRAIN) { E.fused(acc, cur, wr, wc, fr, fq, lds, wid, lane); }
#undef PG8_SA
#undef PG8_SB
#undef PG8_STAGE
#undef PG8_LDA
#undef PG8_LDB
#undef PG8_MMA
#undef PG8_WAIT_V
#undef PG8_WAIT_L
#undef PG8_BAR
#undef PG8_SCHED
}
}

constexpr int BATCH = 8, SEQ = 2048, D = 1024, M = BATCH * SEQ, NMEM = 256, MM = BATCH * NMEM;
constexpr int NIN = 3872, NP = 4096, FF = 4096, LK = 384, LN = 1536;
constexpr int C_RK = 2048, C_LORA = 3584;
constexpr int NWAVES = 8, LDS_BYTES = 163840, MISC_OFF = 163840 - 256;
constexpr size_t MiB = 1u << 20;
constexpr size_t WS_WIN = 1 * MiB, WS_WOUT = 9 * MiB, WS_WQ = 11 * MiB, WS_WKV = 13 * MiB, WS_WO = 17 * MiB, WS_WUP = 19 * MiB, WS_WDN = 27 * MiB, WS_LORA = 35 * MiB;
constexpr size_t WS_MEMN = 37 * MiB, WS_KM = 41 * MiB, WS_VT = 45 * MiB, WS_ROPE = 49 * MiB, WS_SQ1 = 53 * MiB, WS_SQ2 = 54 * MiB, WS_SQ3 = 55 * MiB;
constexpr size_t WS_ACTA = 56 * MiB, WS_ACTB = 88 * MiB, WS_P = 120 * MiB, WS_KN = 248 * MiB  , WS_END = 249 * MiB;
constexpr size_t DO_LW = 0, DO_ASIG = 32 * MiB, DO_GG = 48 * MiB;

struct Args { const void* in[28]; float* out; unsigned char* ws; int ph_lo, ph_hi; };
typedef const __attribute__((address_space(4))) unsigned long long* CArgs;
__device__ __forceinline__ Args load_args() { CArgs p = (CArgs)__builtin_amdgcn_kernarg_segment_ptr(); asm volatile("" : "+s"(p)); Args a;
#pragma unroll
    for (int i = 0; i < 28; ++i) a.in[i] = (const void*)(const __attribute__((address_space(1))) void*)p[i];
    a.out = (float*)(__attribute__((address_space(1))) float*)p[28]; a.ws = (unsigned char*)(__attribute__((address_space(1))) unsigned char*)p[29]; a.ph_lo = (int)p[30]; a.ph_hi = (int)(p[30] >> 32); return a; }
#define TIDS() int tid = threadIdx.x; asm volatile("" : "+v"(tid)); const int lane = tid & 63, wave = __builtin_amdgcn_readfirstlane(tid >> 6); (void)lane; (void)wave
enum { I_X = 0, I_MEM, I_POS, I_NMIX, I_WIN, I_RGNW, I_RGNB, I_MU, I_W0, I_WUP, I_A0, I_AUP, I_GUP, I_KK, I_KA, I_RK, I_WGNW, I_WGNB, I_WOUT, I_NXA, I_NMEM, I_WQ, I_WKV, I_WO, I_NMLP, I_MUP, I_MDN, I_NFIN };

template <int CTRL> __device__ __forceinline__ float dpp_add(float v) { return v + __builtin_bit_cast(float, __builtin_amdgcn_update_dpp(0, __builtin_bit_cast(int, v), CTRL, 0xf, 0xf, false)); }
__device__ __forceinline__ float red16(float v) { v = dpp_add<0xB1>(v); v = dpp_add<0x4E>(v); v = dpp_add<0x141>(v); v = dpp_add<0x140>(v); return v; }
__device__ __forceinline__ void p0_transpose_item(const float* W, int K, int N, const float* gain, bf16_t* WT, int row_off, LAS float* scr, int item, int lane) {
    const int nblk = N / 32, kb = item / nblk, nb = item % nblk, k0 = 64 * kb, n0 = 32 * nb;
#pragma unroll 8
    for (int i = 0; i < 32; ++i) { const int kk = 2 * i + (lane >> 5); float v = W[(size_t)(k0 + kk) * N + n0 + (lane & 31)]; if (gain) v *= gain[k0 + kk]; scr[kk * 33 + (lane & 31)] = v; }
    asm volatile("s_waitcnt lgkmcnt(0)" ::: "memory");
    const int c = lane & 7;
#pragma unroll
    for (int j = 0; j < 4; ++j) { const int n = (lane >> 3) + 8 * j; const LAS float* s = scr + (8 * c) * 33 + n;
        u32x4 o; o.x = cvt_pk_bf16(s[0 * 33], s[1 * 33]); o.y = cvt_pk_bf16(s[2 * 33], s[3 * 33]); o.z = cvt_pk_bf16(s[4 * 33], s[5 * 33]); o.w = cvt_pk_bf16(s[6 * 33], s[7 * 33]);
        *(u32x4*)(WT + (size_t)(row_off + n0 + n) * K + k0 + 8 * c) = o; }
    asm volatile("s_waitcnt lgkmcnt(0)" ::: "memory");
}
__device__ __forceinline__ void rms_row_to_bf16(const float* xrow, bf16_t* orow, int lane) {
    const f32x4* xr = (const f32x4*)xrow + lane;
    f32x4 v[4]; float s = 0.f;
#pragma unroll
    for (int j = 0; j < 4; ++j) { v[j] = xr[64 * j]; s += (v[j][0] * v[j][0] + v[j][1] * v[j][1]) + (v[j][2] * v[j][2] + v[j][3] * v[j][3]); }
    const float rstd = 1.0f / sqrtf(wave_sum(s) * (1.f / 1024.f) + 1e-6f);
    u32x2* o8 = (u32x2*)orow + lane;
#pragma unroll
    for (int j = 0; j < 4; ++j) { u32x2 w; w.x = cvt_pk_bf16(v[j][0] * rstd, v[j][1] * rstd); w.y = cvt_pk_bf16(v[j][2] * rstd, v[j][3] * rstd); o8[64 * j] = w; }
}

__device__ __forceinline__ void phase0(LAS unsigned char* lds) {
    const Args a = load_args(); TIDS();
    unsigned char* ws = a.ws;
    LAS float* scr = (LAS float*)(lds + wave * 16384);
    const int gw = blockIdx.x * NWAVES + wave, NGW = gridDim.x * NWAVES;
    const int gt = blockIdx.x * 512 + tid, NGT = gridDim.x * 512;
    constexpr int I_IN = 16 * 121, I_KV = 16 * 64;
    constexpr int NITEMS = I_IN + I_KV;
    for (int it = gw; it < NITEMS; it += NGW) {
        int r = it;
        if (r < I_IN) { p0_transpose_item((const float*)a.in[I_WIN], D, NIN, (const float*)a.in[I_NMIX], (bf16_t*)(ws + WS_WIN), 0, scr, r, lane); continue; } r -= I_IN;
        p0_transpose_item((const float*)a.in[I_WKV], D, 2 * D, (const float*)a.in[I_NMEM], (bf16_t*)(ws + WS_WKV), 0, scr, r, lane);
    }
    { u32x4* z = (u32x4*)(ws + WS_WIN + (size_t)NIN * D * 2); const int nz = (NP - NIN) * D * 2 / 16; for (int i = gt; i < nz; i += NGT) z[i] = (u32x4){0u, 0u, 0u, 0u}; }
    { const float* wup = (const float*)a.in[I_WUP]; const float* aup = (const float*)a.in[I_AUP]; const float* gup = (const float*)a.in[I_GUP]; u32x4* LT = (u32x4*)(ws + WS_LORA);
      for (int i = gt; i < LN * (LK / 8); i += NGT) { const int n = i / (LK / 8), k0 = (i % (LK / 8)) * 8; float v[8];
#pragma unroll
          for (int j = 0; j < 8; ++j) { const int k = k0 + j; float x = 0.f;
              if (n < 512) { if (k < 64) x = wup[k * 512 + n]; }
              else if (n < 1024) { if (k >= 64 && k < 128) x = aup[(k - 64) * 512 + (n - 512)]; }
              else { if (k >= 128 && k < 288) x = gup[(k - 128) * 512 + (n - 1024)]; }
              v[j] = x; }
          u32x4 o; o.x = cvt_pk_bf16(v[0], v[1]); o.y = cvt_pk_bf16(v[2], v[3]); o.z = cvt_pk_bf16(v[4], v[5]); o.w = cvt_pk_bf16(v[6], v[7]); LT[i] = o; } }
    for (int m = gw; m < M + MM; m += NGW) {
        if (m < M) rms_row_to_bf16((const float*)a.in[I_X] + (size_t)m * D, (bf16_t*)(ws + WS_ACTA) + (size_t)m * D, lane);
        else rms_row_to_bf16((const float*)a.in[I_MEM] + (size_t)(m - M) * D, (bf16_t*)(ws + WS_MEMN) + (size_t)(m - M) * D, lane);
    }
    { const int* pos = (const int*)a.in[I_POS]; f32x2* T = (f32x2*)(ws + WS_ROPE);
      for (int i = gt; i < M * 32; i += NGT) { const int m = i >> 5, f = i & 31;
          const float inv = (float)exp2(-(double)f * (13.287712379549449 / 32.0));
          const float ang = (float)pos[m] * inv;
          double rev = (double)ang * 0.15915494309189535; rev -= rint(rev);
          const float rv = (float)rev;
          T[i] = (f32x2){__builtin_amdgcn_cosf(rv), __builtin_amdgcn_sinf(rv)}; } }
}

__device__ __forceinline__ void p0_late_weights(LAS unsigned char* lds, int wg, int nwg) {
    const Args a = load_args(); TIDS();
    unsigned char* ws = a.ws;
    LAS float* scr = (LAS float*)(lds + wave * 16384);
    const int gw = wg * NWAVES + wave, NGW = nwg * NWAVES;
    constexpr int I_SQ = 16 * 32, I_UP = 16 * 128, I_DN = 64 * 32;
    constexpr int NITEMS = 3 * I_SQ + I_UP + I_DN;
    for (int it = gw; it < NITEMS; it += NGW) {
        int r = it;
        if (r < I_SQ) { p0_transpose_item((const float*)a.in[I_WOUT], D, D, nullptr, (bf16_t*)(ws + WS_WOUT), 0, scr, r, lane); continue; } r -= I_SQ;
        if (r < I_SQ) { p0_transpose_item((const float*)a.in[I_WQ], D, D, (const float*)a.in[I_NXA], (bf16_t*)(ws + WS_WQ), 0, scr, r, lane); continue; } r -= I_SQ;
        if (r < I_SQ) { p0_transpose_item((const float*)a.in[I_WO], D, D, nullptr, (bf16_t*)(ws + WS_WO), 0, scr, r, lane); continue; } r -= I_SQ;
        if (r < I_UP) { p0_transpose_item((const float*)a.in[I_MUP], D, FF, (const float*)a.in[I_NMLP], (bf16_t*)(ws + WS_WUP), 0, scr, r, lane); continue; } r -= I_UP;
        p0_transpose_item((const float*)a.in[I_MDN], FF, D, nullptr, (bf16_t*)(ws + WS_WDN), 0, scr, r, lane);
    }
}

__device__ __forceinline__ void phase_lora_in() {
    const Args a = load_args(); TIDS();
    { const bf16_t* Pk = (const bf16_t*)(a.ws + WS_P) + C_RK + 512 + 8 * lane; float* KN = (float*)(a.ws + WS_KN);
      const float* muk = (const float*)a.in[I_MU] + 512 + 8 * lane; const float* kkp = (const float*)a.in[I_KK] + 8 * lane;
      const f32x4 mu0 = *(const f32x4*)muk, mu1 = *(const f32x4*)(muk + 4), kc0 = *(const f32x4*)kkp, kc1 = *(const f32x4*)(kkp + 4);
      for (int m = blockIdx.x * NWAVES + wave; m < M; m += gridDim.x * NWAVES) {
          const u32x4 cur = *(const u32x4*)(Pk + (size_t)m * NP); u32x4 prv = (u32x4){0u, 0u, 0u, 0u}; if ((m & (SEQ - 1)) != 0) prv = *(const u32x4*)(Pk + (size_t)(m - 1) * NP);
          float ss = 0.f;
#pragma unroll
          for (int j = 0; j < 4; ++j) { const float c0 = bflo(cur[j]), c1 = bfhi(cur[j]), p0 = bflo(prv[j]), p1 = bfhi(prv[j]);
              const float m0_ = j < 2 ? mu0[2 * j] : mu1[2 * j - 4], m1_ = j < 2 ? mu0[2 * j + 1] : mu1[2 * j - 3], k0_ = j < 2 ? kc0[2 * j] : kc1[2 * j - 4], k1_ = j < 2 ? kc0[2 * j + 1] : kc1[2 * j - 3];
              const float a0 = (c0 + (p0 - c0) * m0_) * k0_, a1 = (c1 + (p1 - c1) * m1_) * k1_; ss += a0 * a0 + a1 * a1; }
          ss = dpp_add<0xB1>(ss); ss = dpp_add<0x4E>(ss); ss = dpp_add<0x141>(ss);
          if ((lane & 7) == 0) KN[(size_t)m * 8 + (lane >> 3)] = __builtin_amdgcn_rsqf(fmaxf(ss, 1e-24f)); } }
    const bf16_t* P = (const bf16_t*)(a.ws + WS_P); bf16_t* L = (bf16_t*)(a.ws + WS_ACTB); const float* mu = (const float*)a.in[I_MU] + 1536;
    const int gt = blockIdx.x * 512 + tid, NGT = gridDim.x * 512;
    for (int i = gt; i < M * (LK / 8); i += NGT) { const int m = i / (LK / 8), c8 = i % (LK / 8), c = 8 * c8; u32x4 o = (u32x4){0u, 0u, 0u, 0u};
        if (c < 288) { const u32x4 cur = *(const u32x4*)(P + (size_t)m * NP + C_LORA + c); u32x4 prv = (u32x4){0u, 0u, 0u, 0u}; if ((m & (SEQ - 1)) != 0) prv = *(const u32x4*)(P + (size_t)(m - 1) * NP + C_LORA + c);
            const f32x4 mu0 = *(const f32x4*)(mu + c), mu1 = *(const f32x4*)(mu + c + 4); float v[8];
#pragma unroll
            for (int j = 0; j < 4; ++j) { const float c0 = bflo(cur[j]), c1 = bfhi(cur[j]), p0 = bflo(prv[j]), p1 = bfhi(prv[j]); const float m0 = j < 2 ? mu0[2 * j] : mu1[2 * j - 4], m1 = j < 2 ? mu0[2 * j + 1] : mu1[2 * j - 3];
                v[2 * j] = c0 + (p0 - c0) * m0; v[2 * j + 1] = c1 + (p1 - c1) * m1; }
            if (c < 64) {
#pragma unroll
                for (int j = 0; j < 8; ++j) v[j] = tanhf(v[j]); }
            else if (c >= 128) {
#pragma unroll
                for (int j = 0; j < 8; ++j) v[j] = sigmoidf_(v[j]); }
            o.x = cvt_pk_bf16(v[0], v[1]); o.y = cvt_pk_bf16(v[2], v[3]); o.z = cvt_pk_bf16(v[4], v[5]); o.w = cvt_pk_bf16(v[6], v[7]); }
        *(u32x4*)(L + (size_t)m * LK + c) = o; }
}

typedef short bf16x4 __attribute__((ext_vector_type(4)));
__device__ __forceinline__ float wave_sum_fast(float v) { v = red16(v);
    const int iv = __builtin_bit_cast(int, v);
    return (__builtin_bit_cast(float, __builtin_amdgcn_readlane(iv, 0)) + __builtin_bit_cast(float, __builtin_amdgcn_readlane(iv, 16))) + (__builtin_bit_cast(float, __builtin_amdgcn_readlane(iv, 32)) + __builtin_bit_cast(float, __builtin_amdgcn_readlane(iv, 48))); }
__device__ __forceinline__ bf16x4 pack4(const f32x4 v) { u32x2 w; w.x = cvt_pk_bf16(v[0], v[1]); w.y = cvt_pk_bf16(v[2], v[3]); return __builtin_bit_cast(bf16x4, w); }
__device__ __forceinline__ bf16x8 pack8(const f32x4 a, const f32x4 b) { u32x4 w; w.x = cvt_pk_bf16(a[0], a[1]); w.y = cvt_pk_bf16(a[2], a[3]); w.z = cvt_pk_bf16(b[0], b[1]); w.w = cvt_pk_bf16(b[2], b[3]); return __builtin_bit_cast(bf16x8, w); }
__device__ __forceinline__ unsigned short f2bf(float v) { return (unsigned short)(cvt_pk_bf16(v, 0.f) & 0xffffu); }

__device__ __forceinline__ f32x4 mfma16(const bf16x4 a, const bf16x4 b, const f32x4 c) {
    bf16x4 a_ = a, b_ = b; f32x4 c_ = c; asm volatile("s_nop 7" : "+v"(a_), "+v"(b_), "+v"(c_));
    return __builtin_amdgcn_mfma_f32_16x16x16bf16_1k(a_, b_, c_, 0, 0, 0);
}
__device__ __forceinline__ f32x4 mfma32p(const bf16x8 a, const bf16x8 b, const f32x4 c) {
    bf16x8 a_ = a, b_ = b; f32x4 c_ = c; asm volatile("s_nop 7" : "+v"(a_), "+v"(b_), "+v"(c_));
    return __builtin_amdgcn_mfma_f32_16x16x32_bf16(a_, b_, c_, 0, 0, 0);
}
__device__ __forceinline__ void rwkv_chunk_wg(LAS unsigned char* lds, int bh) {
    const Args a = load_args(); TIDS();
    const int b = bh >> 3, h = bh & 7;
    constexpr int RS = 144;
    constexpr int SLOT = 15168, O_GT = 13120  , O_AT = 0, O_RT = 2304, O_BHT = 4608, O_KHT = 6656, O_VT = 8704, O_CAK = 10752, O_TT = 11264, O_CBR = 11776, O_CKR = 12288, O_PL = 12800, O_RKB = 13056;
    constexpr int SCR0 = 8 * SLOT, SCR = 5632, O_BT = 0, O_KT = 2304, O_NF = 4608, O_RK = 0  ;
    constexpr int STAT0 = SCR0 + 4 * SCR;
    static_assert(STAT0 + 4096 <= MISC_OFF, "rwkv LDS map");
    constexpr int NCH = SEQ / 16, NST = NCH / 4;
    const size_t m0 = (size_t)b * SEQ;
    const int li = lane & 15, lq = lane >> 4;
    if (wave < 4) {
        const int rt = wave, vch = 64 * h + 16 * rt + li;
        const bf16_t* GG = (const bf16_t*)((const unsigned char*)a.out + DO_GG); bf16_t* Y = (bf16_t*)(a.ws + WS_ACTA);
        const float gw = ((const float*)a.in[I_WGNW])[vch], gb = ((const float*)a.in[I_WGNB])[vch];
        f32x4 S[4];
#pragma unroll
        for (int kt = 0; kt < 4; ++kt) S[kt] = (f32x4){0.f, 0.f, 0.f, 0.f};
        const f32x4 zero4 = (f32x4){0.f, 0.f, 0.f, 0.f};
        f32x4 ys[4], rkbs[4]; bf16x4 vts[4], gts[4];
#pragma unroll
        for (int q = 0; q < 4; ++q) { ys[q] = zero4; rkbs[q] = zero4; vts[q] = (bf16x4){0, 0, 0, 0}; gts[q] = (bf16x4){0, 0, 0, 0}; }
        for (int g = 0; g <= NST + 1; ++g) {
            if (g >= 2) {
#pragma unroll
                for (int q = 0; q < 4; ++q) { const int c = 4 * (g - 2) + q; const LAS float* st = (const LAS float*)(lds + STAT0 + ((g - 1) & 1) * 2048 + q * 512);
#pragma unroll
                    for (int r = 0; r < 4; ++r) { const int t = 4 * lq + r; const f32x4 p0 = *(const LAS f32x4*)(st + t * 8), p1 = *(const LAS f32x4*)(st + t * 8 + 4);
                        const float mean = ((p0[0] + p0[2]) + (p1[0] + p1[2])) * (1.f / 64.f), ex2 = ((p0[1] + p0[3]) + (p1[1] + p1[3])) * (1.f / 64.f);
                        const float rstd = __builtin_amdgcn_rsqf(fmaxf(ex2 - mean * mean, 0.f) + 64e-5f);
                        const float vv = bf2f((unsigned short)vts[q][r]);
                        const float o = ((ys[q][r] - mean) * rstd * gw + gb + rkbs[q][r] * vv) * bf2f((unsigned short)gts[q][r]);
                        Y[(m0 + 16 * c + t) * D + 512 + vch] = f2bf(o); } }
            }
            f32x4 yn[4], rkbn[4]; bf16x4 vtn[4], gtn[4];
#pragma unroll
            for (int q = 0; q < 4; ++q) { yn[q] = zero4; rkbn[q] = zero4; vtn[q] = (bf16x4){0, 0, 0, 0}; gtn[q] = (bf16x4){0, 0, 0, 0}; }
            if (g >= 1 && g <= NST) {
#pragma unroll
                for (int q = 0; q < 4; ++q) {
                    LAS unsigned char* sl = lds + (((g - 1) & 1) * 4 + q) * SLOT;
                    const bf16x8 sf0 = pack8(S[0], S[1]), sf1 = pack8(S[2], S[3]);
                    const bf16x8 a0 = *(const LAS bf16x8*)(sl + O_AT + li * RS + 16 * lq), a1 = *(const LAS bf16x8*)(sl + O_AT + li * RS + 64 + 16 * lq);
                    const bf16x8 r0 = *(const LAS bf16x8*)(sl + O_RT + li * RS + 16 * lq), r1 = *(const LAS bf16x8*)(sl + O_RT + li * RS + 64 + 16 * lq);
                    const bf16x4 cak = *(const LAS bf16x4*)(sl + O_CAK + li * 32 + 8 * lq), tt = *(const LAS bf16x4*)(sl + O_TT + li * 32 + 8 * lq);
                    const bf16x4 cbr = *(const LAS bf16x4*)(sl + O_CBR + li * 32 + 8 * lq), ckr = *(const LAS bf16x4*)(sl + O_CKR + li * 32 + 8 * lq);
                    const bf16x4 vt = *(const LAS bf16x4*)(sl + O_VT + (16 * rt + li) * 32 + 8 * lq);
                    rkbn[q] = *(const LAS f32x4*)(sl + O_RKB + 16 * lq);
                    f32x4 z = mfma16(cak, vt, zero4);
                    f32x4 y = mfma16(ckr, vt, zero4);
                    f32x4 accs[4];
#pragma unroll
                    for (int kt = 0; kt < 4; ++kt) { const f32x4 pl = *(const LAS f32x4*)(sl + O_PL + (16 * kt + 4 * lq) * 4);
                        const bf16x4 khf = *(const LAS bf16x4*)(sl + O_KHT + (16 * kt + li) * 32 + 8 * lq); accs[kt] = mfma16(khf, vt, S[kt] * pl); }
                    z = mfma32p(a0, sf0, z); z = mfma32p(a1, sf1, z);
                    y = mfma32p(r0, sf0, y); y = mfma32p(r1, sf1, y);
                    const bf16x4 zf = pack4(z);
                    const f32x4 u = mfma16(tt, zf, zero4);
                    const bf16x4 uf = pack4(u);
#pragma unroll
                    for (int kt = 0; kt < 4; ++kt) { const bf16x4 bhf = *(const LAS bf16x4*)(sl + O_BHT + (16 * kt + li) * 32 + 8 * lq); S[kt] = mfma16(bhf, uf, accs[kt]); }
                    y = mfma16(cbr, uf, y);
                    yn[q] = y; vtn[q] = vt; gtn[q] = *(const LAS bf16x4*)(sl + O_GT + (16 * rt + li) * 32 + 8 * lq);
                    LAS float* st = (LAS float*)(lds + STAT0 + (g & 1) * 2048 + q * 512);
#pragma unroll
                    for (int r = 0; r < 4; ++r) { const float s1 = red16(y[r]), s2 = red16(y[r] * y[r]); if (li == 0) { f32x2 w2 = {s1, s2}; *(LAS f32x2*)(st + (4 * lq + r) * 8 + 2 * rt) = w2; } }
                }
            }
#pragma unroll
            for (int q = 0; q < 4; ++q) { ys[q] = yn[q]; rkbs[q] = rkbn[q]; vts[q] = vtn[q]; gts[q] = gtn[q]; }
            __syncthreads();
        }
    } else {
        const int pw = wave - 4, ci = 64 * h + lane;
        const bf16_t* P = (const bf16_t*)(a.ws + WS_P);
        const float* LW = (const float*)((const unsigned char*)a.out + DO_LW); const bf16_t* ASIG = (const bf16_t*)((const unsigned char*)a.out + DO_ASIG);
        const float* mu = (const float*)a.in[I_MU];
        const float mu_r = mu[ci], mu_k = mu[512 + ci], mu_v = mu[1024 + ci], kkc = ((const float*)a.in[I_KK])[ci], kac = ((const float*)a.in[I_KA])[ci], rkc = ((const float*)a.in[I_RK])[ci];
        const int kpos = (lane & 32) + 8 * ((lane >> 2) & 3) + 4 * ((lane >> 4) & 1) + (lane & 3);
        LAS unsigned char* scr = lds + SCR0 + pw * SCR;
        unsigned short x_r[16], x_k[16], x_v[16], x_a[16], x_g[16]; float x_w[16]; unsigned short p_r, p_k, p_v;
        const __amdgpu_buffer_rsrc_t rsP = __builtin_amdgcn_make_buffer_rsrc((void*)(P + m0 * NP), 0, SEQ * NP * 2, 0x00020000);
        const __amdgpu_buffer_rsrc_t rsA = __builtin_amdgcn_make_buffer_rsrc((void*)(ASIG + m0 * 512), 0, SEQ * 512 * 2, 0x00020000);
        const __amdgpu_buffer_rsrc_t rsG = __builtin_amdgcn_make_buffer_rsrc((void*)((const bf16_t*)((const unsigned char*)a.out + DO_GG) + m0 * 512), 0, SEQ * 512 * 2, 0x00020000);
        const __amdgpu_buffer_rsrc_t rsW = __builtin_amdgcn_make_buffer_rsrc((void*)(LW + m0 * 512), 0, SEQ * 512 * 4, 0x00020000);
        const float* KN = (const float*)(a.ws + WS_KN) + m0 * 8 + h;
        const int voP = (C_RK + ci) * 2, voA = ci * 2, voW = ci * 4;
#define RW_LOAD(c) do { _Pragma("unroll") for (int t = 0; t < 16; ++t) { const int tk = 16 * (c) + t; \
            x_r[t] = __builtin_amdgcn_raw_buffer_load_b16(rsP, voP, tk * (NP * 2), 0); x_k[t] = __builtin_amdgcn_raw_buffer_load_b16(rsP, voP + 1024, tk * (NP * 2), 0); \
            x_v[t] = __builtin_amdgcn_raw_buffer_load_b16(rsP, voP + 2048, tk * (NP * 2), 0); x_a[t] = __builtin_amdgcn_raw_buffer_load_b16(rsA, voA, tk * 1024, 0); x_g[t] = __builtin_amdgcn_raw_buffer_load_b16(rsG, voA, tk * 1024, 0); \
            x_w[t] = __builtin_bit_cast(float, __builtin_amdgcn_raw_buffer_load_b32(rsW, voW, tk * 2048, 0)); } \
        if ((c) > 0) { const int tk = 16 * (c) - 1; p_r = __builtin_amdgcn_raw_buffer_load_b16(rsP, voP, tk * (NP * 2), 0); p_k = __builtin_amdgcn_raw_buffer_load_b16(rsP, voP + 1024, tk * (NP * 2), 0); \
            p_v = __builtin_amdgcn_raw_buffer_load_b16(rsP, voP + 2048, tk * (NP * 2), 0); } else { p_r = 0; p_k = 0; p_v = 0; } } while (0)
#define RW_LOADN(c) do { _Pragma("unroll") for (int t = 0; t < 16; ++t) { const int tk = 16 * (c) + t; \
            x_r[t] = __builtin_amdgcn_raw_buffer_load_b16(rsP, voP, tk * (NP * 2), 0); x_k[t] = __builtin_amdgcn_raw_buffer_load_b16(rsP, voP + 1024, tk * (NP * 2), 0); \
            x_v[t] = __builtin_amdgcn_raw_buffer_load_b16(rsP, voP + 2048, tk * (NP * 2), 0); x_a[t] = __builtin_amdgcn_raw_buffer_load_b16(rsA, voA, tk * 1024, 0); x_g[t] = __builtin_amdgcn_raw_buffer_load_b16(rsG, voA, tk * 1024, 0); \
            x_w[t] = __builtin_bit_cast(float, __builtin_amdgcn_raw_buffer_load_b32(rsW, voW, tk * 2048, 0)); } \
        { const int tk = 16 * (c) - 1; p_r = __builtin_amdgcn_raw_buffer_load_b16(rsP, voP, tk * (NP * 2), 0); p_k = __builtin_amdgcn_raw_buffer_load_b16(rsP, voP + 1024, tk * (NP * 2), 0); \
            p_v = __builtin_amdgcn_raw_buffer_load_b16(rsP, voP + 2048, tk * (NP * 2), 0); } } while (0)
        RW_LOAD(pw);
        for (int g = 0; g < NST; ++g) {
            {
                const int c = 4 * g + pw; LAS unsigned char* sl = lds + ((g & 1) * 4 + pw) * SLOT;
                float Bt[16], Kt[16], Vv[16], Rk[16];
                float cum = 0.f, ecp = 1.f, prr = bf2f(p_r), prk = bf2f(p_k), prv = bf2f(p_v);
#pragma unroll
                for (int t = 0; t < 16; ++t) {
                    const float cr = bf2f(x_r[t]), ck = bf2f(x_k[t]), cv = bf2f(x_v[t]);
                    const float r = cr + (prr - cr) * mu_r, k0 = ck + (prk - ck) * mu_k, v = cv + (prv - cv) * mu_v; prr = cr; prk = ck; prv = cv;
                    const float asg = bf2f(x_a[t]); const float kk = k0 * kkc * KN[(16 * c + t) * 8];
                    const float kx = k0 * (1.0f + (asg - 1.0f) * kac), bb = kk * asg;
                    cum += x_w[t]; const float ec = __expf(cum), eci = __builtin_amdgcn_rcpf(ec);
                    const float at = -kk * ecp, bt = bb * eci, kt = kx * eci, rtl = r * ec; ecp = ec;
                    *(LAS unsigned short*)(sl + O_AT + t * RS + 2 * kpos) = f2bf(at); *(LAS unsigned short*)(sl + O_RT + t * RS + 2 * kpos) = f2bf(rtl);
                    *(LAS unsigned short*)(scr + O_BT + t * RS + 2 * kpos) = f2bf(bt); *(LAS unsigned short*)(scr + O_KT + t * RS + 2 * kpos) = f2bf(kt);
                    Bt[t] = bt; Kt[t] = kt; Vv[t] = v; Rk[t] = rtl * rkc;
                }
                const float pl = ecp;
                *(LAS float*)(sl + O_PL + 4 * lane) = pl;
                { u32x4 w0, w1;
                  w0.x = cvt_pk_bf16(Bt[0] * pl, Bt[1] * pl); w0.y = cvt_pk_bf16(Bt[2] * pl, Bt[3] * pl); w0.z = cvt_pk_bf16(Bt[4] * pl, Bt[5] * pl); w0.w = cvt_pk_bf16(Bt[6] * pl, Bt[7] * pl);
                  w1.x = cvt_pk_bf16(Bt[8] * pl, Bt[9] * pl); w1.y = cvt_pk_bf16(Bt[10] * pl, Bt[11] * pl); w1.z = cvt_pk_bf16(Bt[12] * pl, Bt[13] * pl); w1.w = cvt_pk_bf16(Bt[14] * pl, Bt[15] * pl);
                  *(LAS u32x4*)(sl + O_BHT + lane * 32) = w0; *(LAS u32x4*)(sl + O_BHT + lane * 32 + 16) = w1;
                  w0.x = cvt_pk_bf16(Kt[0] * pl, Kt[1] * pl); w0.y = cvt_pk_bf16(Kt[2] * pl, Kt[3] * pl); w0.z = cvt_pk_bf16(Kt[4] * pl, Kt[5] * pl); w0.w = cvt_pk_bf16(Kt[6] * pl, Kt[7] * pl);
                  w1.x = cvt_pk_bf16(Kt[8] * pl, Kt[9] * pl); w1.y = cvt_pk_bf16(Kt[10] * pl, Kt[11] * pl); w1.z = cvt_pk_bf16(Kt[12] * pl, Kt[13] * pl); w1.w = cvt_pk_bf16(Kt[14] * pl, Kt[15] * pl);
                  *(LAS u32x4*)(sl + O_KHT + lane * 32) = w0; *(LAS u32x4*)(sl + O_KHT + lane * 32 + 16) = w1;
                  w0.x = cvt_pk_bf16(Vv[0], Vv[1]); w0.y = cvt_pk_bf16(Vv[2], Vv[3]); w0.z = cvt_pk_bf16(Vv[4], Vv[5]); w0.w = cvt_pk_bf16(Vv[6], Vv[7]);
                  w1.x = cvt_pk_bf16(Vv[8], Vv[9]); w1.y = cvt_pk_bf16(Vv[10], Vv[11]); w1.z = cvt_pk_bf16(Vv[12], Vv[13]); w1.w = cvt_pk_bf16(Vv[14], Vv[15]);
                  *(LAS u32x4*)(sl + O_VT + lane * 32) = w0; *(LAS u32x4*)(sl + O_VT + lane * 32 + 16) = w1;
                  w0.x = x_g[0] | ((unsigned)x_g[1] << 16); w0.y = x_g[2] | ((unsigned)x_g[3] << 16); w0.z = x_g[4] | ((unsigned)x_g[5] << 16); w0.w = x_g[6] | ((unsigned)x_g[7] << 16);
                  w1.x = x_g[8] | ((unsigned)x_g[9] << 16); w1.y = x_g[10] | ((unsigned)x_g[11] << 16); w1.z = x_g[12] | ((unsigned)x_g[13] << 16); w1.w = x_g[14] | ((unsigned)x_g[15] << 16);
                  *(LAS u32x4*)(sl + O_GT + lane * 32) = w0; *(LAS u32x4*)(sl + O_GT + lane * 32 + 16) = w1; }
                { const int cn = (g + 1 < NST) ? c + 4 : c; RW_LOADN(cn); }
                const bf16x8 af0 = *(const LAS bf16x8*)(sl + O_AT + li * RS + 16 * lq), af1 = *(const LAS bf16x8*)(sl + O_AT + li * RS + 64 + 16 * lq);
                const bf16x8 rf0 = *(const LAS bf16x8*)(sl + O_RT + li * RS + 16 * lq), rf1 = *(const LAS bf16x8*)(sl + O_RT + li * RS + 64 + 16 * lq);
                const bf16x8 bf0 = *(const LAS bf16x8*)(scr + O_BT + li * RS + 16 * lq), bf1 = *(const LAS bf16x8*)(scr + O_BT + li * RS + 64 + 16 * lq);
                const bf16x8 kf0 = *(const LAS bf16x8*)(scr + O_KT + li * RS + 16 * lq), kf1 = *(const LAS bf16x8*)(scr + O_KT + li * RS + 64 + 16 * lq);
                const f32x4 zero4 = (f32x4){0.f, 0.f, 0.f, 0.f};
                f32x4 nn = mfma32p(bf0, af0, zero4); nn = mfma32p(bf1, af1, nn);
                f32x4 ca = mfma32p(kf0, af0, zero4); ca = mfma32p(kf1, af1, ca);
                f32x4 cb = mfma32p(bf0, rf0, zero4); cb = mfma32p(bf1, rf1, cb);
                f32x4 ck = mfma32p(kf0, rf0, zero4); ck = mfma32p(kf1, rf1, ck);
#pragma unroll
                for (int t = 0; t < 16; ++t) *(LAS unsigned short*)(scr + O_RK + t * RS + 2 * kpos) = f2bf(Rk[t]);
                const bf16x8 qf0 = *(const LAS bf16x8*)(scr + O_RK + li * RS + 16 * lq), qf1 = *(const LAS bf16x8*)(scr + O_RK + li * RS + 64 + 16 * lq);
                f32x4 dk = mfma32p(kf0, qf0, zero4); dk = mfma32p(kf1, qf1, dk);
                if (lq == (li >> 2)) { const int e = li & 3; *(LAS float*)(sl + O_RKB + 4 * li) = e == 0 ? dk[0] : (e == 1 ? dk[1] : (e == 2 ? dk[2] : dk[3])); }
                f32x4 nt = mfma32p(af0, bf0, zero4); nt = mfma32p(af1, bf1, nt);
                f32x4 eye;
#pragma unroll
                for (int r = 0; r < 4; ++r) { const int i = 4 * lq + r; const bool lt = i < li, le = i <= li;
                    nn[r] = lt ? nn[r] : 0.f; ca[r] = lt ? ca[r] : 0.f; cb[r] = le ? cb[r] : 0.f; ck[r] = le ? ck[r] : 0.f; nt[r] = (li < i) ? nt[r] : 0.f; eye[r] = (i == li) ? 1.f : 0.f; }
                *(LAS bf16x4*)(sl + O_CAK + li * 32 + 8 * lq) = pack4(ca); *(LAS bf16x4*)(sl + O_CBR + li * 32 + 8 * lq) = pack4(cb); *(LAS bf16x4*)(sl + O_CKR + li * 32 + 8 * lq) = pack4(ck);
                { const bf16x4 nd_b = pack4(nn), nt_b = pack4(nt);
                  const f32x4 n2d = mfma16(nt_b, nd_b, zero4), n2t = mfma16(nd_b, nt_b, zero4);
                  const bf16x4 n2d_b = pack4(n2d), n2t_b = pack4(n2t);
                  const f32x4 n4d = mfma16(n2t_b, n2d_b, zero4), n4t = mfma16(n2d_b, n2t_b, zero4);
                  const f32x4 n8d = mfma16(pack4(n4t), pack4(n4d), zero4);
                  const f32x4 q1 = mfma16(pack4(n4t + eye), pack4(n8d + eye), zero4);
                  const f32x4 q2 = mfma16(pack4(n2t + eye), pack4(q1), zero4);
                  const f32x4 td = mfma16(pack4(nt + eye), pack4(q2), zero4);
                  *(LAS bf16x4*)(sl + O_TT + li * 32 + 8 * lq) = pack4(td); }
            }
            __syncthreads();
        }
        __syncthreads(); __syncthreads();
#undef RW_LOADN
#undef RW_LOAD
    }
}

__device__ __forceinline__ void retention_wg(LAS unsigned char* lds, int bh) {
    const Args a = load_args(); TIDS();
    const int b = bh >> 3, h = bh & 7;
    constexpr int QS_ = 72, TS_ = 136;
    LAS bf16_t* Qs = (LAS bf16_t*)lds;
    LAS bf16_t* Ks = Qs + 128 * QS_;
    LAS bf16_t* KzT = Ks + 128 * QS_;
    LAS bf16_t* VT = KzT + 64 * TS_;
    LAS bf16_t* Ps = VT + 64 * TS_;
    LAS bf16_t* RT = Ps + 128 * TS_;
    const bf16_t* P = (const bf16_t*)(a.ws + WS_P); const f32x2* ROPE = (const f32x2*)(a.ws + WS_ROPE); bf16_t* Y = (bf16_t*)(a.ws + WS_ACTA);
    const float* gnw = (const float*)a.in[I_RGNW]; const float* gnb = (const float*)a.in[I_RGNB];
    const float lg2 = log2f(1.0f - exp2f(-5.0f - (float)h));
    const float gch = exp2f(128.0f * lg2);
    for (int i = tid; i < 64 * QS_ / 2; i += 512) ((LAS unsigned*)RT)[i] = 0u;
    const int tk = tid >> 2, qd = tid & 3;
    const float zeta = exp2f((float)(127 - tk) * lg2);
    const int li = lane & 15, lq = lane >> 4, i0 = 16 * wave;
    const float xi = exp2f((float)(i0 + li + 1) * lg2);
    f32x4 Rst[2]; Rst[0] = (f32x4){0.f, 0.f, 0.f, 0.f}; Rst[1] = Rst[0];
    u32x4 gq1, gq2, gk1, gk2, gv1, gv2; f32x4 gr[4];
#define RT_LOAD(n) do { const size_t m = (size_t)b * SEQ + (n) * 128 + tk; const bf16_t* pr = P + m * NP + 64 * h; \
        gq1 = *(const u32x4*)(pr + 8 * qd); gq2 = *(const u32x4*)(pr + 32 + 8 * qd); gk1 = *(const u32x4*)(pr + 512 + 8 * qd); gk2 = *(const u32x4*)(pr + 544 + 8 * qd); \
        gv1 = *(const u32x4*)(pr + 1024 + 16 * qd); gv2 = *(const u32x4*)(pr + 1032 + 16 * qd); \
        const f32x4* rp = (const f32x4*)(ROPE + m * 32 + 8 * qd); gr[0] = rp[0]; gr[1] = rp[1]; gr[2] = rp[2]; gr[3] = rp[3]; } while (0)
    RT_LOAD(0);
    for (int n = 0; n < SEQ / 128; ++n) {
        { float q1[8], q2[8], k1[8], k2[8];
#pragma unroll
          for (int j = 0; j < 4; ++j) { q1[2 * j] = bflo(gq1[j]); q1[2 * j + 1] = bfhi(gq1[j]); q2[2 * j] = bflo(gq2[j]); q2[2 * j + 1] = bfhi(gq2[j]);
              k1[2 * j] = bflo(gk1[j]); k1[2 * j + 1] = bfhi(gk1[j]); k2[2 * j] = bflo(gk2[j]); k2[2 * j + 1] = bfhi(gk2[j]); }
          float oq1[8], oq2[8], ok1[8], ok2[8];
#pragma unroll
          for (int j = 0; j < 8; ++j) { const float cs = gr[j >> 1][2 * (j & 1)], sn = gr[j >> 1][2 * (j & 1) + 1];
              oq1[j] = q1[j] * cs - q2[j] * sn; oq2[j] = q2[j] * cs + q1[j] * sn;
              ok1[j] = (k1[j] * cs - k2[j] * sn) * 0.125f; ok2[j] = (k2[j] * cs + k1[j] * sn) * 0.125f; }
          u32x4 w;
          w.x = cvt_pk_bf16(oq1[0], oq1[1]); w.y = cvt_pk_bf16(oq1[2], oq1[3]); w.z = cvt_pk_bf16(oq1[4], oq1[5]); w.w = cvt_pk_bf16(oq1[6], oq1[7]); *(LAS u32x4*)(Qs + tk * QS_ + 8 * qd) = w;
          w.x = cvt_pk_bf16(oq2[0], oq2[1]); w.y = cvt_pk_bf16(oq2[2], oq2[3]); w.z = cvt_pk_bf16(oq2[4], oq2[5]); w.w = cvt_pk_bf16(oq2[6], oq2[7]); *(LAS u32x4*)(Qs + tk * QS_ + 32 + 8 * qd) = w;
          w.x = cvt_pk_bf16(ok1[0], ok1[1]); w.y = cvt_pk_bf16(ok1[2], ok1[3]); w.z = cvt_pk_bf16(ok1[4], ok1[5]); w.w = cvt_pk_bf16(ok1[6], ok1[7]); *(LAS u32x4*)(Ks + tk * QS_ + 8 * qd) = w;
          w.x = cvt_pk_bf16(ok2[0], ok2[1]); w.y = cvt_pk_bf16(ok2[2], ok2[3]); w.z = cvt_pk_bf16(ok2[4], ok2[5]); w.w = cvt_pk_bf16(ok2[6], ok2[7]); *(LAS u32x4*)(Ks + tk * QS_ + 32 + 8 * qd) = w;
#pragma unroll
          for (int j = 0; j < 8; ++j) { KzT[(8 * qd + j) * TS_ + tk] = (bf16_t)(cvt_pk_bf16(ok1[j] * zeta, 0.f) & 0xffffu); KzT[(32 + 8 * qd + j) * TS_ + tk] = (bf16_t)(cvt_pk_bf16(ok2[j] * zeta, 0.f) & 0xffffu); }
#pragma unroll
          for (int j = 0; j < 4; ++j) { VT[(16 * qd + 2 * j) * TS_ + tk] = (bf16_t)(gv1[j] & 0xffffu); VT[(16 * qd + 2 * j + 1) * TS_ + tk] = (bf16_t)(gv1[j] >> 16);
              VT[(16 * qd + 8 + 2 * j) * TS_ + tk] = (bf16_t)(gv2[j] & 0xffffu); VT[(16 * qd + 8 + 2 * j + 1) * TS_ + tk] = (bf16_t)(gv2[j] >> 16); } }
        if (n + 1 < SEQ / 128) RT_LOAD(n + 1);
        __syncthreads();
        bf16x8 qf[2];
        qf[0] = *(const LAS bf16x8*)(Qs + (i0 + li) * QS_ + 8 * lq); qf[1] = *(const LAS bf16x8*)(Qs + (i0 + li) * QS_ + 32 + 8 * lq);
        const int nks = (wave + 2) >> 1;
        for (int jt = 0; jt < 2 * nks; ++jt) {
            f32x4 s = (f32x4){0.f, 0.f, 0.f, 0.f};
            if (jt <= wave) {
                const bf16x8 kf0 = *(const LAS bf16x8*)(Ks + (16 * jt + li) * QS_ + 8 * lq), kf1 = *(const LAS bf16x8*)(Ks + (16 * jt + li) * QS_ + 32 + 8 * lq);
                s = __builtin_amdgcn_mfma_f32_16x16x32_bf16(kf0, qf[0], s, 0, 0, 0); s = __builtin_amdgcn_mfma_f32_16x16x32_bf16(kf1, qf[1], s, 0, 0, 0);
#pragma unroll
                for (int r = 0; r < 4; ++r) { const int dj = (i0 + li) - (16 * jt + 4 * lq + r); s[r] = dj >= 0 ? s[r] * exp2f((float)dj * lg2) : 0.f; }
            }
            u32x2 w; w.x = cvt_pk_bf16(s[0], s[1]); w.y = cvt_pk_bf16(s[2], s[3]);
            *(LAS u32x2*)(Ps + (i0 + li) * TS_ + 16 * jt + 4 * lq) = w;
        }
        f32x4 ai_[4], ax_[4];
#pragma unroll
        for (int et = 0; et < 4; ++et) { ai_[et] = (f32x4){0.f, 0.f, 0.f, 0.f}; ax_[et] = (f32x4){0.f, 0.f, 0.f, 0.f}; }
        for (int kk = 0; kk < nks; ++kk) { const bf16x8 pf = *(const LAS bf16x8*)(Ps + (i0 + li) * TS_ + 32 * kk + 8 * lq);
#pragma unroll
            for (int et = 0; et < 4; ++et) { const bf16x8 vf = *(const LAS bf16x8*)(VT + (16 * et + li) * TS_ + 32 * kk + 8 * lq); ai_[et] = __builtin_amdgcn_mfma_f32_16x16x32_bf16(vf, pf, ai_[et], 0, 0, 0); } }
#pragma unroll
        for (int kk = 0; kk < 2; ++kk)
#pragma unroll
            for (int et = 0; et < 4; ++et) { const bf16x8 rf = *(const LAS bf16x8*)(RT + (16 * et + li) * QS_ + 32 * kk + 8 * lq); ax_[et] = __builtin_amdgcn_mfma_f32_16x16x32_bf16(rf, qf[kk], ax_[et], 0, 0, 0); }
#pragma unroll
        for (int t2 = 0; t2 < 2; ++t2) { const int id = 2 * wave + t2, dt = id >> 2, et = id & 3; f32x4 kv = (f32x4){0.f, 0.f, 0.f, 0.f};
#pragma unroll
            for (int kk = 0; kk < 4; ++kk) { const bf16x8 kz = *(const LAS bf16x8*)(KzT + (16 * dt + li) * TS_ + 32 * kk + 8 * lq), vf = *(const LAS bf16x8*)(VT + (16 * et + li) * TS_ + 32 * kk + 8 * lq);
                kv = __builtin_amdgcn_mfma_f32_16x16x32_bf16(kz, vf, kv, 0, 0, 0); }
            Rst[t2] = Rst[t2] * gch + kv; }
        __syncthreads();
#pragma unroll
        for (int t2 = 0; t2 < 2; ++t2) { const int id = 2 * wave + t2, dt = id >> 2, et = id & 3; u32x2 w; w.x = cvt_pk_bf16(Rst[t2][0], Rst[t2][1]); w.y = cvt_pk_bf16(Rst[t2][2], Rst[t2][3]);
            *(LAS u32x2*)(RT + (16 * et + li) * QS_ + 16 * dt + 4 * lq) = w; }
        { float y[4][4]; float s = 0.f;
#pragma unroll
          for (int et = 0; et < 4; ++et)
#pragma unroll
              for (int r = 0; r < 4; ++r) { y[et][r] = ai_[et][r] + xi * ax_[et][r]; s += y[et][r]; }
          s += __shfl_xor(s, 16); s += __shfl_xor(s, 32); const float mean = s * (1.f / 64.f); float q = 0.f;
#pragma unroll
          for (int et = 0; et < 4; ++et)
#pragma unroll
              for (int r = 0; r < 4; ++r) { const float d = y[et][r] - mean; q += d * d; }
          q += __shfl_xor(q, 16); q += __shfl_xor(q, 32); const float rstd = 1.0f / sqrtf(q * (1.f / 64.f) + 1e-5f);
          const size_t m = (size_t)b * SEQ + n * 128 + i0 + li;
#pragma unroll
          for (int et = 0; et < 4; ++et) { const int e0 = 64 * h + 16 * et + 4 * lq; const u32x2 g2 = *(const u32x2*)(P + m * NP + 1536 + e0);
              const f32x4 gw4 = *(const f32x4*)(gnw + e0), gb4 = *(const f32x4*)(gnb + e0); float o[4];
              const float gg[4] = {bflo(g2.x), bfhi(g2.x), bflo(g2.y), bfhi(g2.y)};
#pragma unroll
              for (int r = 0; r < 4; ++r) { const float gn = (y[et][r] - mean) * rstd * gw4[r] + gb4[r]; o[r] = gg[r] * sigmoidf_(gg[r]) * gn; }
              u32x2 w; w.x = cvt_pk_bf16(o[0], o[1]); w.y = cvt_pk_bf16(o[2], o[3]); *(u32x2*)(Y + m * D + e0) = w; } }
    }
#undef RT_LOAD
}

__device__ __forceinline__ void phase_rwkv_fin() {
    const Args a = load_args(); TIDS();
    const bf16_t* P = (const bf16_t*)(a.ws + WS_P); const float* YRAW = (const float*)(a.ws + WS_ACTB); bf16_t* Y = (bf16_t*)(a.ws + WS_ACTA);
    const bf16_t* ASIG = (const bf16_t*)((const unsigned char*)a.out + DO_ASIG); const bf16_t* GG = (const bf16_t*)((const unsigned char*)a.out + DO_GG);
    const float* mu = (const float*)a.in[I_MU]; const float* ka = (const float*)a.in[I_KA]; const float* rk = (const float*)a.in[I_RK];
    const float* gnw = (const float*)a.in[I_WGNW]; const float* gnb = (const float*)a.in[I_WGNB];
    const int gw = blockIdx.x * NWAVES + wave, NGW = gridDim.x * NWAVES;
    for (int it = gw; it < M * 8; it += NGW) { const int m = it >> 3, h = it & 7, ci = 64 * h + lane;
        const float y = YRAW[(size_t)m * 512 + ci];
        const float mean = wave_sum(y) * (1.f / 64.f); const float d = y - mean; const float var = wave_sum(d * d) * (1.f / 64.f);
        const float yn = d * (1.0f / sqrtf(var + 64e-5f)) * gnw[ci] + gnb[ci];
        const bf16_t* pc = P + (size_t)m * NP + C_RK + ci;
        const float cr = bf2f(pc[0]), ck = bf2f(pc[512]), cv = bf2f(pc[1024]); float pr = 0.f, pk = 0.f, pv = 0.f;
        if ((m & (SEQ - 1)) != 0) { pr = bf2f(pc[-NP]); pk = bf2f(pc[512 - NP]); pv = bf2f(pc[1024 - NP]); }
        const float r = cr + (pr - cr) * mu[ci], k0 = ck + (pk - ck) * mu[512 + ci], v = cv + (pv - cv) * mu[1024 + ci];
        const float asg = bf2f(ASIG[(size_t)m * 512 + ci]); const float kx = k0 * (1.0f + (asg - 1.0f) * ka[ci]);
        const float bonus = wave_sum(r * kx * rk[ci]) * v;
        const float g = bf2f(GG[(size_t)m * 512 + ci]);
        Y[(size_t)m * D + 512 + ci] = (bf16_t)(cvt_pk_bf16((yn + bonus) * g, 0.f) & 0xffffu); }
}

#define XB_TMO      128
#define XB_XCNT(j)  (256  + 64 * (j))
#define XB_XSUB(j)  (1280 + 64 * (j))
#define XB_XGEN(j)  (2304 + 64 * (j))
#define XB_TOP      3328
#define XB_TOPGEN   3392
#define XCD_BAR_WORDS 3456
#define XB_SPIN_CAP (1u << 18)
__device__ __forceinline__ unsigned xb_ld(unsigned* p)              { return __hip_atomic_load(p, __ATOMIC_RELAXED, __HIP_MEMORY_SCOPE_AGENT); }
__device__ __forceinline__ unsigned xb_add(unsigned* p, unsigned v) { return __hip_atomic_fetch_add(p, v, __ATOMIC_RELAXED, __HIP_MEMORY_SCOPE_AGENT); }
__device__ __forceinline__ unsigned xb_xcc_id() { return (unsigned)__builtin_amdgcn_s_getreg((3 << 11) | 20) & 0xFu; }
#define XB_SPIN(cond, bar) do { unsigned _sp = 0; while (cond) { __builtin_amdgcn_s_sleep(1); \
    if ((++_sp & 255u) == 0u) { if (xb_ld(&(bar)[XB_TMO])) break; if (_sp > XB_SPIN_CAP) { atomicAdd(&(bar)[XB_TMO], 1u); break; } } } } while (0)
struct XcdBarrier { unsigned* bar; unsigned x; volatile LAS unsigned* st; };
__device__ __forceinline__ XcdBarrier xcd_barrier_post(unsigned* bar, volatile LAS unsigned* st) {
    XcdBarrier b; b.bar = bar; b.x = xb_xcc_id(); b.st = st;
    if (threadIdx.x == 0) (void)xb_add(&bar[XB_XCNT(b.x)], 1u);
    return b;
}
__device__ __forceinline__ void xcd_barrier_complete(unsigned* bar, unsigned x, unsigned& nloc, unsigned& nx) {
    const unsigned G = gridDim.x * gridDim.y * gridDim.z;
    unsigned sum, cnt, mine, sp = 0u;
    for (;;) {
        sum = 0u; cnt = 0u; mine = 0u;
#pragma unroll
        for (unsigned j = 0; j < 16; ++j) { const unsigned c = xb_ld(&bar[XB_XCNT(j)]); sum += c; cnt += (c > 0u) ? 1u : 0u; mine = (j == x) ? c : mine; }
        if (sum == G) break;
        __builtin_amdgcn_s_sleep(1);
        if ((++sp & 255u) == 0u) { if (xb_ld(&bar[XB_TMO])) break; if (sp > XB_SPIN_CAP) { atomicAdd(&bar[XB_TMO], 1u); break; } }
    }
    nloc = mine > 0u ? mine : 1u; nx = cnt > 0u ? cnt : 1u;
}
__device__ __forceinline__ void xcd_barrier(const XcdBarrier& b) {
    asm volatile("s_waitcnt vmcnt(0)" ::: "memory");
    __syncthreads();
    if (threadIdx.x == 0) {
        unsigned* bar = b.bar;
        __builtin_amdgcn_s_waitcnt(0);
        unsigned nloc = b.st[0], nx = b.st[1];
        if (nloc == 0u) { xcd_barrier_complete(bar, b.x, nloc, nx); b.st[0] = nloc; b.st[1] = nx; }
        const unsigned old = xb_add(&bar[XB_XSUB(b.x)], 1u);
        const unsigned gen = old / nloc;
        if (old + 1u == (gen + 1u) * nloc) {
            __builtin_amdgcn_fence(__ATOMIC_RELEASE, "agent");
            asm volatile("s_waitcnt vmcnt(0)" ::: "memory");
            const unsigned og = xb_add(&bar[XB_TOP], 1u);
            const unsigned tg = og / nx;
            if (og + 1u == (tg + 1u) * nx) xb_add(&bar[XB_TOPGEN], 1u);
            else XB_SPIN(xb_ld(&bar[XB_TOPGEN]) == tg, bar);
            __builtin_amdgcn_fence(__ATOMIC_ACQUIRE, "agent");
            xb_add(&bar[XB_XGEN(b.x)], 1u);
            asm volatile("s_waitcnt vmcnt(0)" ::: "memory");
        } else {
            XB_SPIN(xb_ld(&bar[XB_XGEN(b.x)]) == gen, bar);
            __builtin_amdgcn_fence(__ATOMIC_ACQUIRE, "agent");
            asm volatile("s_waitcnt vmcnt(0)" ::: "memory");
        }
    }
    __syncthreads();
}

__global__ void __launch_bounds__(NWAVES * 64, 2) mega(Args a_) {
    extern __shared__ __attribute__((aligned(16))) unsigned char lds_raw[];
    LAS unsigned char* lds = (LAS unsigned char*)lds_raw;
    cg::grid_group grid = cg::this_grid();
    const int G = gridDim.x, bx = blockIdx.x;
    volatile LAS unsigned* MISC = (volatile LAS unsigned*)(lds + MISC_OFF);
    if (threadIdx.x < 16) MISC[threadIdx.x] = 0u;
    __syncthreads();
    (void)xcd_barrier_post((unsigned*)a_.ws + 4096, MISC + 8);
    if (a_.ph_lo == 0x7fffffff) grid.sync();
#ifndef PHMASK
#define PHMASK 0xfff
#endif
#define IN(k) ((PHMASK >> (k)) & 1)
#define GSYNC() do { XcdBarrier xb_; xb_.bar = (unsigned*)load_args().ws + 4096; xb_.x = xb_xcc_id(); xb_.st = (volatile LAS unsigned*)(lds + MISC_OFF) + 8; xcd_barrier(xb_); } while (0)
#define SEAM(k) do { if (IN(k) && IN((k) + 1)) GSYNC(); } while (0)
#define ARGS() const Args a = load_args(); unsigned char* ws = a.ws; (void)ws
#ifndef REPMASK
#define REPMASK 0
#endif
#ifndef NSYNC_EXTRA
#define NSYNC_EXTRA 0
#endif
#define REPS(k) (((REPMASK >> (k)) & 1) ? 2 : 1)
#define REPSYNC() do { if (rep) GSYNC(); } while (0)

    for (int i = 0; i < NSYNC_EXTRA; ++i) GSYNC();
    if (IN(0)) for (int rep = 0; rep < REPS(0); ++rep) { REPSYNC(); phase0(lds); }
    SEAM(0);
    if (IN(1)) for (int rep = 0; rep < REPS(1); ++rep) {   REPSYNC();
        ARGS();
        pg8::Gemm g{(const bf16_t*)(ws + WS_ACTA), (const bf16_t*)(ws + WS_WIN), D, D, D}; pg8::StaticOrder S; S.init(M, NP, G, bx);
        pg8::EpiStore<0, false> E{(bf16_t*)(ws + WS_P), NP, 1, 1, nullptr, 1.0f};
        pg8::gemm_phase<pg8::EpiStore<0, false>, pg8::StaticOrder, true>(lds, g, S, E);
    }
    SEAM(1);
    if (IN(2)) for (int rep = 0; rep < REPS(2); ++rep) { REPSYNC(); phase_lora_in(); }
    SEAM(2);
    if (IN(3)) for (int rep = 0; rep < REPS(3); ++rep) {   REPSYNC();
        ARGS();
        pg8::Gemm g{(const bf16_t*)(ws + WS_ACTB), (const bf16_t*)(ws + WS_LORA), LK, LK, LK}; pg8::StaticOrder S; S.init(M, LN, G, bx);
        pg8::EpiLora E{(float*)((unsigned char*)a.out + DO_LW), (bf16_t*)((unsigned char*)a.out + DO_ASIG), (bf16_t*)((unsigned char*)a.out + DO_GG), (const float*)a.in[I_W0], (const float*)a.in[I_A0]};
        pg8::gemm_phase<pg8::EpiLora, pg8::StaticOrder, true>(lds, g, S, E);
    }
    SEAM(3);
    if (IN(4)) for (int rep = 0; rep < REPS(4); ++rep) {   REPSYNC();
#ifndef REP_SCAN
#define REP_SCAN 1
#endif
#ifndef REP_RET
#define REP_RET 1
#endif
        if (bx < 64) { for (int r2 = 0; r2 < REP_SCAN; ++r2) { if (r2) __syncthreads(); rwkv_chunk_wg(lds, bx); } }
        else if (bx < 128) { for (int r2 = 0; r2 < REP_RET; ++r2) { if (r2) __syncthreads(); retention_wg(lds, bx - 64); } }
        else if (bx < 192) { ARGS(); const int idx = bx - 128;
            if (idx < 32) { pg8::Gemm g{(const bf16_t*)(ws + WS_MEMN), (const bf16_t*)(ws + WS_WKV), D, D, D}; pg8::OneUnit S{idx >> 2, idx & 3};
                pg8::EpiStore<0, false> E{(bf16_t*)(ws + WS_KM), D, 1, 1, nullptr, 1.0f}; pg8::gemm_phase<pg8::EpiStore<0, false>, pg8::OneUnit, true>(lds, g, S, E); }
            else { const int j = idx - 32; pg8::Gemm g{(const bf16_t*)(ws + WS_WKV) + (size_t)D * D, (const bf16_t*)(ws + WS_MEMN), D, D, D}; pg8::OneUnit S{j >> 3, j & 7};
                pg8::EpiStore<0, false> E{(bf16_t*)(ws + WS_VT), MM, 1, 1, nullptr, 1.0f}; pg8::gemm_phase<pg8::EpiStore<0, false>, pg8::OneUnit, true>(lds, g, S, E); } }
        else p0_late_weights(lds, bx - 192, G - 192);
    }
    SEAM(4);
    if (IN(6)) for (int rep = 0; rep < REPS(6); ++rep) {   REPSYNC();
        ARGS();
        pg8::Gemm g{(const bf16_t*)(ws + WS_ACTA), (const bf16_t*)(ws + WS_WOUT), D, D, D}; pg8::StaticOrder S; S.init(M, D, G, bx);
        pg8::EpiRes<false> E{a.in[I_X], nullptr, (bf16_t*)(ws + WS_ACTB), (float*)(ws + WS_SQ1)};
        pg8::gemm_phase<pg8::EpiRes<false>, pg8::StaticOrder, true>(lds, g, S, E);
    }
    SEAM(6);
    if (IN(7)) for (int rep = 0; rep < REPS(7); ++rep) {   REPSYNC();
        if (bx < 256) { ARGS(); const int u = bx; const int b = u >> 5, h4 = (u >> 3) & 3, qt = u & 7; const int pm = b * 8 + qt;
            bf16_t* QS = (bf16_t*)(ws + WS_P) + (size_t)u * 131072; bf16_t* PSb = QS + 65536;
            { pg8::Gemm g{(const bf16_t*)(ws + WS_ACTB), (const bf16_t*)(ws + WS_WQ), D, D, D}; pg8::OneUnit S{pm, h4};
              pg8::EpiStore<0, true> E{QS, 256, 0, 0, (const float*)(ws + WS_SQ1), 0.0625f}; pg8::gemm_phase<pg8::EpiStore<0, true>, pg8::OneUnit, true>(lds, g, S, E); }
            asm volatile("s_waitcnt vmcnt(0)" ::: "memory"); __syncthreads(); __builtin_amdgcn_fence(__ATOMIC_ACQUIRE, "agent"); asm volatile("s_waitcnt vmcnt(0)" ::: "memory"); __syncthreads();
            { pg8::Gemm g{QS, (const bf16_t*)(ws + WS_KM) + (size_t)(b * 256) * D + h4 * 256, 256, D, 256}; pg8::OneUnit S{0, 0};
              pg8::EpiSoftmax E{PSb}; pg8::gemm_phase<pg8::EpiSoftmax, pg8::OneUnit, false>(lds, g, S, E); }
            asm volatile("s_waitcnt vmcnt(0)" ::: "memory"); __syncthreads(); __builtin_amdgcn_fence(__ATOMIC_ACQUIRE, "agent"); asm volatile("s_waitcnt vmcnt(0)" ::: "memory"); __syncthreads();
            { pg8::Gemm g{PSb, (const bf16_t*)(ws + WS_VT) + (size_t)(h4 * 256) * MM + b * 256, 256, MM, 256}; pg8::OneUnit S{0, 0};
              pg8::EpiStore<0, false> E{(bf16_t*)(ws + WS_ACTA) + (size_t)(pm * 256) * D + h4 * 256, D, 0, 0, nullptr, 1.0f}; pg8::gemm_phase<pg8::EpiStore<0, false>, pg8::OneUnit, true>(lds, g, S, E); }
            __syncthreads();
        }
    }
    SEAM(7);
    if (IN(8)) {
        ARGS();
        pg8::Gemm g{(const bf16_t*)(ws + WS_ACTA), (const bf16_t*)(ws + WS_WO), D, D, D}; pg8::StaticOrder S; S.init(M, D, G, bx);
        pg8::EpiRes<true> E{ws + WS_ACTB, nullptr, (bf16_t*)(ws + WS_ACTB), (float*)(ws + WS_SQ2)};
        pg8::gemm_phase<pg8::EpiRes<true>, pg8::StaticOrder, true>(lds, g, S, E);
    }
    SEAM(8);
    if (IN(9)) for (int rep = 0; rep < REPS(9); ++rep) {   REPSYNC();
        ARGS();
        pg8::Gemm g{(const bf16_t*)(ws + WS_ACTB), (const bf16_t*)(ws + WS_WUP), D, D, D}; pg8::StaticOrder S; S.init(M, FF, G, bx);
        pg8::EpiStore<2, true> E{(bf16_t*)(ws + WS_P), FF, 1, 1, (const float*)(ws + WS_SQ2), 1.0f};
        pg8::gemm_phase<pg8::EpiStore<2, true>, pg8::StaticOrder, true>(lds, g, S, E);
    }
    SEAM(9);
    if (IN(10)) {
        ARGS();
        pg8::Gemm g{(const bf16_t*)(ws + WS_P), (const bf16_t*)(ws + WS_WDN), FF, FF, FF}; pg8::StaticOrder S; S.init(M, D, G, bx);
        pg8::EpiRes<true> E{ws + WS_ACTB, a.out, nullptr, (float*)(ws + WS_SQ3)};
        pg8::gemm_phase<pg8::EpiRes<true>, pg8::StaticOrder, true>(lds, g, S, E);
    }
    SEAM(10);
    if (IN(11)) {
        ARGS(); TIDS();
        const float* sq = (const float*)(ws + WS_SQ3); const float* gf = (const float*)a.in[I_NFIN];
        const int gw = bx * NWAVES + wave, NGW = G * NWAVES;
        f32x4 gv[4];
#pragma unroll
        for (int j = 0; j < 4; ++j) gv[j] = ((const f32x4*)gf)[lane + 64 * j];
        for (int m = gw; m < M; m += NGW) { const f32x4* q4 = (const f32x4*)(sq + (size_t)m * 16); const f32x4 s = q4[0] + q4[1] + q4[2] + q4[3];
            const float rstd = 1.0f / sqrtf((s[0] + s[1] + s[2] + s[3]) * (1.f / 1024.f) + 1e-6f);
            f32x4* xr = (f32x4*)(a.out + (size_t)m * D) + lane;
#pragma unroll
            for (int j = 0; j < 4; ++j) xr[64 * j] = xr[64 * j] * rstd * gv[j]; }
    }
#undef IN
#undef SEAM
#undef ARGS
}

extern "C" void kernel_launch(void* const* d_in, const int* in_sizes, int n_in, void* d_out, int out_size, void* d_ws, size_t ws_size, hipStream_t stream) {
    static int grid = 0;
    if (grid == 0) {
        if (n_in != 28 || out_size != M * D || ws_size < WS_END) { fprintf(stderr, "kernel_launch: unexpected shapes (n_in %d out %d ws %zu)\n", n_in, out_size, ws_size); grid = -1; return; }
        int dev = 0, cus = 0, per_cu = 0;
        if (hipGetDevice(&dev) != hipSuccess || hipDeviceGetAttribute(&cus, hipDeviceAttributeMultiprocessorCount, dev) != hipSuccess) { grid = -1; return; }
        if (hipFuncSetAttribute((const void*)mega, hipFuncAttributeMaxDynamicSharedMemorySize, LDS_BYTES) != hipSuccess) { fprintf(stderr, "kernel_launch: hipFuncSetAttribute failed\n"); grid = -1; return; }
        if (hipOccupancyMaxActiveBlocksPerMultiprocessor(&per_cu, (const void*)mega, NWAVES * 64, LDS_BYTES) != hipSuccess || per_cu < 1) { fprintf(stderr, "kernel_launch: occupancy query says %d\n", per_cu); (void)hipGetLastError(); }
        grid = cus;
        if (grid != 256) fprintf(stderr, "kernel_launch: %d CUs (built for 256)\n", grid);
    }
    if (grid < 0) return;
    if (hipMemsetAsync(d_ws, 0, 65536, stream) != hipSuccess) { fprintf(stderr, "kernel_launch: memset failed\n"); return; }
    Args a{};
    for (int i = 0; i < 28; ++i) a.in[i] = d_in[i];
    a.out = (float*)d_out; a.ws = (unsigned char*)d_ws; a.ph_lo = 0; a.ph_hi = 12;
    void* args[] = {&a};
    hipError_t e = hipLaunchCooperativeKernel((const void*)mega, dim3(grid), dim3(NWAVES * 64), args, LDS_BYTES, stream);
    if (e != hipSuccess) fprintf(stderr, "cooperative launch failed: %s (grid %d)\n", hipGetErrorString(e), grid);
}
```
